# Optimizing an MI355X kernel written in HIP

```python
import jax
import jax.numpy as jnp
from jax import lax
import numpy as np

D_MODEL = 1024
BATCH = 32
SEQ = 2048
DEPTH = 4

GRID_W = 64
CTX_LEN = 256
EPS = 1e-6
N_MOD = 6

MIX_WIDTH = D_MODEL
LRU_WIDTH = 3 * MIX_WIDTH // 8
LRU_HEADS = 6
LRU_HEAD_DIM = LRU_WIDTH // LRU_HEADS
LRU_CONV = 4
LRU_C = 8.0
RET_WIDTH = 3 * MIX_WIDTH // 8
RET_HEADS = 6
RET_HEAD_DIM = RET_WIDTH // RET_HEADS
RET_CHUNK = 128
ROPE_BASE = 100.0
ROPE_PAIRS = RET_HEAD_DIM // 4
CM_WIDTH = MIX_WIDTH - LRU_WIDTH - RET_WIDTH
CM_GROUPS = 4
CM_GROUP_DIM = CM_WIDTH // CM_GROUPS
CM_CHUNK = 128
IN_WIDTH = 2 * LRU_WIDTH + 4 * RET_WIDTH + 2 * CM_WIDTH
SPLIT_POINTS = (LRU_WIDTH, 2 * LRU_WIDTH, 2 * LRU_WIDTH + RET_WIDTH, 2 * LRU_WIDTH + 2 * RET_WIDTH,
                2 * LRU_WIDTH + 3 * RET_WIDTH, 2 * LRU_WIDTH + 4 * RET_WIDTH)
D_FF = -(-(8 * D_MODEL // 3) // 128) * 128
N_EXPERTS = 8
TOP_K = 2

kernel_name = "hybrid_lru_retention_gmlp_moe_dit"


def rms_norm(x, g):
    xf = x.astype(jnp.float32)
    y = xf * lax.rsqrt(jnp.mean(xf * xf, axis=-1, keepdims=True) + EPS)
    return (y * g.astype(jnp.float32)).astype(x.dtype)


def layer_norm(x, g, b):
    xf = x.astype(jnp.float32)
    mu = jnp.mean(xf, axis=-1, keepdims=True)
    xc = xf - mu
    y = xc * lax.rsqrt(jnp.mean(xc * xc, axis=-1, keepdims=True) + EPS)
    return (y * g.astype(jnp.float32) + b.astype(jnp.float32)).astype(x.dtype)


def head_rms(o):
    return o * lax.rsqrt(jnp.mean(o * o, axis=-1, keepdims=True) + EPS)


def modulate(h, shift, scale):
    return h * (1 + scale) + shift


def apply_rope(x, cos, sin):
    xp = x.reshape(x.shape[:-1] + (-1, 2))
    x0, x1 = xp[..., 0], xp[..., 1]
    c = cos[None, :, None, :]
    s = sin[None, :, None, :]
    return jnp.stack([x0 * c - x1 * s, x0 * s + x1 * c], axis=-1).reshape(x.shape)


def dwconv_centred(x, w, b):
    y = lax.conv_general_dilated(
        x, w[:, None, :].astype(x.dtype), window_strides=(1,),
        padding=[(LRU_CONV // 2, LRU_CONV - 1 - LRU_CONV // 2)],
        dimension_numbers=('NWC', 'WIO', 'NWC'), feature_group_count=x.shape[-1])
    return y + b


def _linear_combine(left, right):
    a_l, b_l = left
    a_r, b_r = right
    return a_l * a_r, a_r * b_l + b_r


def rglru_scan(x, w_a, b_a, w_x, b_x, lam, h0):
    r = jax.nn.sigmoid(jnp.einsum('blhi,hij->blhj', x, w_a) + b_a)
    i = jax.nn.sigmoid(jnp.einsum('blhi,hij->blhj', x, w_x) + b_x)
    log_a = -LRU_C * r * jax.nn.softplus(-lam)
    a = jnp.exp(log_a)
    u = jnp.sqrt(-jnp.expm1(2.0 * log_a)) * (i * x)
    a_cum, h = lax.associative_scan(_linear_combine, (a, u), axis=1)
    h = h + a_cum * h0[:, None]
    return h, h[:, -1]


def rglru_bidir(x_ctx, x_lat, wa, ba, wx, bx, lam, want_ctx):
    zeros = jnp.zeros((x_ctx.shape[0], LRU_HEADS, LRU_HEAD_DIM), jnp.float32)
    hc_f, s_f = rglru_scan(x_ctx, wa[0], ba[0], wx[0], bx[0], lam[0], zeros)
    hc_b, s_b = rglru_scan(x_ctx[:, ::-1], wa[1], ba[1], wx[1], bx[1], lam[1], zeros)
    hl_f, _ = rglru_scan(x_lat, wa[0], ba[0], wx[0], bx[0], lam[0], s_f)
    hl_b, _ = rglru_scan(x_lat[:, ::-1], wa[1], ba[1], wx[1], bx[1], lam[1], s_b)
    lat = hl_f + hl_b[:, ::-1]
    ctx = hc_f + hc_b[:, ::-1] if want_ctx else None
    return lat, ctx


def retention_chunkwise(q, k, v, log_gamma, s0):
    B, L, H, d = q.shape
    n = L // RET_CHUNK
    qc = q.reshape(B, n, RET_CHUNK, H, d)
    kc = k.reshape(B, n, RET_CHUNK, H, d)
    vc = v.reshape(B, n, RET_CHUNK, H, d)
    pos = jnp.arange(RET_CHUNK, dtype=jnp.float32)
    diff = pos[:, None] - pos[None, :]
    decay_intra = jnp.where(diff >= 0, jnp.exp(log_gamma[:, None, None] * jnp.maximum(diff, 0.0)), 0.0)
    scores = jnp.einsum('bnihd,bnjhd->bnhij', qc, kc) * decay_intra
    intra = jnp.einsum('bnhij,bnjhd->bnihd', scores, vc)
    k_decay = jnp.exp(log_gamma[None, :] * (RET_CHUNK - 1 - pos)[:, None])
    chunk_kv = jnp.einsum('bnjhd,jh,bnjhe->bnhde', kc, k_decay, vc)
    chunk_decay = jnp.exp(log_gamma * RET_CHUNK)[None, :, None, None]

    def step(s, kv):
        return chunk_decay * s + kv, s

    s_final, s_before = lax.scan(step, s0, jnp.moveaxis(chunk_kv, 1, 0))
    s_before = jnp.moveaxis(s_before, 0, 1)
    q_decay = jnp.exp(log_gamma[None, :] * (pos + 1)[:, None])
    inter = jnp.einsum('bnihd,ih,bnhde->bnihe', qc, q_decay, s_before)
    return (intra + inter).reshape(B, L, H, d), s_final


def retention_final_state(k, v, log_gamma):
    L = k.shape[1]
    w = jnp.exp(log_gamma[None, :] * (L - 1 - jnp.arange(L, dtype=jnp.float32))[:, None])
    return jnp.einsum('blhd,lh,blhe->bhde', k, w, v)


def retention_bidir(q_c, k_c, v_c, q_l, k_l, v_l, theta, want_ctx):
    lg_f = jax.nn.log_sigmoid(theta[0].astype(jnp.float32))
    lg_b = jax.nn.log_sigmoid(theta[1].astype(jnp.float32))
    flip = lambda t: t[:, ::-1]
    if want_ctx:
        zeros = jnp.zeros((q_c.shape[0], RET_HEADS, RET_HEAD_DIM, RET_HEAD_DIM), jnp.float32)
        oc_f, s_f = retention_chunkwise(q_c, k_c, v_c, lg_f, zeros)
        oc_b, s_b = retention_chunkwise(flip(q_c), flip(k_c), flip(v_c), lg_b, zeros)
        o_ctx = oc_f + flip(oc_b)
    else:
        s_f = retention_final_state(k_c, v_c, lg_f)
        s_b = retention_final_state(flip(k_c), flip(v_c), lg_b)
        o_ctx = None
    ol_f, _ = retention_chunkwise(q_l, k_l, v_l, lg_f, s_f)
    ol_b, _ = retention_chunkwise(flip(q_l), flip(k_l), flip(v_l), lg_b, s_b)
    return ol_f + flip(ol_b), o_ctx


def chunk_mlp(z, ln_g, ln_b, ws, bs):
    z = jax.nn.gelu(z)
    u, v = jnp.split(z, 2, axis=-1)
    B, L, _ = v.shape
    v = v.reshape(B, L // CM_CHUNK, CM_CHUNK, CM_GROUPS, CM_GROUP_DIM)
    v = layer_norm(v, ln_g, ln_b)
    s = jnp.einsum('gij,bnjgc->bnigc', ws, v) + jnp.transpose(bs)[None, None, :, :, None]
    return u * s.reshape(B, L, CM_WIDTH)


def project(h, w_in, conv_w, conv_b):
    B, L, _ = h.shape
    p = h @ w_in
    lx, ly, q, k, v, g, z = jnp.split(p, SPLIT_POINTS, axis=-1)
    lx = dwconv_centred(lx, conv_w, conv_b).reshape(B, L, LRU_HEADS, LRU_HEAD_DIM).astype(jnp.float32)
    heads = lambda t: t.reshape(B, L, RET_HEADS, RET_HEAD_DIM).astype(jnp.float32)
    return lx, ly, heads(q) * (RET_HEAD_DIM ** -0.5), heads(k), heads(v), g, z


def merge(ly, lru, g, ret, z, w_out, ln_g, ln_b, ws, bs):
    B, L, _ = ly.shape
    lru_out = jax.nn.gelu(ly) * lru.reshape(B, L, LRU_WIDTH).astype(ly.dtype)
    ret_out = jax.nn.silu(g) * head_rms(ret).reshape(B, L, RET_WIDTH).astype(g.dtype)
    cm_out = chunk_mlp(z, ln_g, ln_b, ws, bs)
    return jnp.concatenate([lru_out, ret_out, cm_out], axis=-1) @ w_out


def hybrid_mixer(h_lat, h_ctx, cos, sin, w_in, w_out, conv_w, conv_b, wa, ba, wx, bx, lam, theta,
                 ln_g, ln_b, ws, bs, want_ctx):
    lx_c, ly_c, q_c, k_c, v_c, g_c, z_c = project(h_ctx, w_in, conv_w, conv_b)
    lx_l, ly_l, q_l, k_l, v_l, g_l, z_l = project(h_lat, w_in, conv_w, conv_b)
    q_l = apply_rope(q_l, cos, sin)
    k_l = apply_rope(k_l, cos, sin)
    lru_l, lru_c = rglru_bidir(lx_c, lx_l, wa, ba, wx, bx, lam, want_ctx)
    ret_l, ret_c = retention_bidir(q_c, k_c, v_c, q_l, k_l, v_l, theta, want_ctx)
    y_lat = merge(ly_l, lru_l, g_l, ret_l, z_l, w_out, ln_g, ln_b, ws, bs)
    y_ctx = merge(ly_c, lru_c, g_c, ret_c, z_c, w_out, ln_g, ln_b, ws, bs) if want_ctx else None
    return y_lat, y_ctx


def swiglu(h, w1, w3, w2):
    return (jax.nn.silu(h @ w1) * (h @ w3)) @ w2


def moe_swiglu(h, router_w, w1, w3, w2):
    shp = h.shape
    t = h.reshape(-1, shp[-1])
    logits = (t @ router_w).astype(jnp.float32)
    top_logit, top_idx = lax.top_k(logits, TOP_K)
    top_w = jax.nn.softmax(top_logit, axis=-1)
    combine = jnp.sum(jax.nn.one_hot(top_idx, N_EXPERTS, dtype=jnp.float32) * top_w[..., None], axis=1)
    y = jnp.zeros_like(t)
    for e in range(N_EXPERTS):
        y = y + combine[:, e:e + 1].astype(t.dtype) * swiglu(t, w1[e], w3[e], w2[e])
    return y.reshape(shp)


def setup_inputs(seed: int = 0) -> dict:
    key = jax.random.key(seed)
    ks = jax.random.split(key, 32)
    f32 = jnp.float32
    n_dense = (DEPTH + 1) // 2
    n_moe = DEPTH // 2

    def nrm(k, shape, scale):
        return jax.random.normal(k, shape, f32) * scale

    lam_u = jax.random.uniform(ks[18], (DEPTH, 2, LRU_HEADS, LRU_HEAD_DIM), f32, 0.9, 0.999)
    lam_s = lam_u ** (1.0 / LRU_C)
    gam = 1.0 - jnp.exp2(-5.0 - jnp.arange(RET_HEADS, dtype=f32))
    theta0 = jnp.log(gam) - jnp.log1p(-gam)
    return {
        "x": nrm(ks[0], (BATCH, SEQ, D_MODEL), 1.0),
        "c": nrm(ks[1], (BATCH, D_MODEL), 1.0),
        "ctx": nrm(ks[2], (BATCH, CTX_LEN, D_MODEL), 1.0),
        "c_ctx": nrm(ks[3], (D_MODEL,), 1.0),
        "w_mod": nrm(ks[4], (DEPTH, D_MODEL, N_MOD * D_MODEL), 0.5 * D_MODEL ** -0.5),
        "b_mod": nrm(ks[5], (DEPTH, N_MOD * D_MODEL), 0.02),
        "g_mix_pre": 1.0 + nrm(ks[6], (DEPTH, D_MODEL), 0.05),
        "g_mix_post": 1.0 + nrm(ks[7], (DEPTH, D_MODEL), 0.05),
        "g_ffn_pre": 1.0 + nrm(ks[8], (DEPTH, D_MODEL), 0.05),
        "g_ffn_post": 1.0 + nrm(ks[9], (DEPTH, D_MODEL), 0.05),
        "w_in": nrm(ks[10], (DEPTH, D_MODEL, IN_WIDTH), D_MODEL ** -0.5),
        "w_out": nrm(ks[11], (DEPTH, MIX_WIDTH, D_MODEL), MIX_WIDTH ** -0.5),
        "lru_conv_w": nrm(ks[12], (DEPTH, LRU_CONV, LRU_WIDTH), LRU_CONV ** -0.5),
        "lru_conv_b": nrm(ks[13], (DEPTH, LRU_WIDTH), 0.02),
        "lru_wa": nrm(ks[14], (DEPTH, 2, LRU_HEADS, LRU_HEAD_DIM, LRU_HEAD_DIM), LRU_HEAD_DIM ** -0.5),
        "lru_ba": nrm(ks[15], (DEPTH, 2, LRU_HEADS, LRU_HEAD_DIM), 0.02),
        "lru_wx": nrm(ks[16], (DEPTH, 2, LRU_HEADS, LRU_HEAD_DIM, LRU_HEAD_DIM), LRU_HEAD_DIM ** -0.5),
        "lru_bx": nrm(ks[17], (DEPTH, 2, LRU_HEADS, LRU_HEAD_DIM), 0.02),
        "lru_lam": jnp.log(lam_s) - jnp.log1p(-lam_s),
        "ret_theta": theta0 + nrm(ks[19], (DEPTH, 2, RET_HEADS), 0.05),
        "cm_ln_g": 1.0 + nrm(ks[20], (DEPTH, CM_GROUPS, CM_GROUP_DIM), 0.05),
        "cm_ln_b": nrm(ks[21], (DEPTH, CM_GROUPS, CM_GROUP_DIM), 0.02),
        "cm_ws": nrm(ks[22], (DEPTH, CM_GROUPS, CM_CHUNK, CM_CHUNK), CM_CHUNK ** -0.5),
        "cm_bs": 1.0 + nrm(ks[23], (DEPTH, CM_GROUPS, CM_CHUNK), 0.05),
        "ffn_w1": nrm(ks[24], (n_dense, D_MODEL, D_FF), D_MODEL ** -0.5),
        "ffn_w3": nrm(ks[25], (n_dense, D_MODEL, D_FF), D_MODEL ** -0.5),
        "ffn_w2": nrm(ks[26], (n_dense, D_FF, D_MODEL), D_FF ** -0.5),
        "router_w": nrm(ks[27], (n_moe, D_MODEL, N_EXPERTS), D_MODEL ** -0.5),
        "moe_w1": nrm(ks[28], (n_moe, N_EXPERTS, D_MODEL, D_FF), D_MODEL ** -0.5),
        "moe_w3": nrm(ks[29], (n_moe, N_EXPERTS, D_MODEL, D_FF), D_MODEL ** -0.5),
        "moe_w2": nrm(ks[30], (n_moe, N_EXPERTS, D_FF, D_MODEL), D_FF ** -0.5),
    }


def reference(x, c, ctx, c_ctx, w_mod, b_mod, g_mix_pre, g_mix_post, g_ffn_pre, g_ffn_post, w_in, w_out,
              lru_conv_w, lru_conv_b, lru_wa, lru_ba, lru_wx, lru_bx, lru_lam, ret_theta,
              cm_ln_g, cm_ln_b, cm_ws, cm_bs, ffn_w1, ffn_w3, ffn_w2, router_w, moe_w1, moe_w3, moe_w2):
    L = x.shape[1]
    n_rows = L // GRID_W
    rows = jnp.repeat(jnp.arange(n_rows, dtype=jnp.float32), GRID_W)
    cols = jnp.tile(jnp.arange(GRID_W, dtype=jnp.float32), n_rows)
    freqs = ROPE_BASE ** (-jnp.arange(ROPE_PAIRS, dtype=jnp.float32) / ROPE_PAIRS)
    ang = jnp.concatenate([rows[:, None] * freqs, cols[:, None] * freqs], axis=-1)
    cos, sin = jnp.cos(ang), jnp.sin(ang)
    s_lat = jax.nn.silu(c)
    s_ctx = jax.nn.silu(c_ctx)
    for l in range(DEPTH):
        want_ctx = l < DEPTH - 1
        mod_l = (s_lat @ w_mod[l] + b_mod[l])[:, None, :]
        mod_c = s_ctx @ w_mod[l] + b_mod[l]
        sh_m, sc_m, gt_m, sh_f, sc_f, gt_f = jnp.split(mod_l, N_MOD, axis=-1)
        csh_m, csc_m, cgt_m, csh_f, csc_f, cgt_f = jnp.split(mod_c, N_MOD, axis=-1)
        h_lat = modulate(rms_norm(x, g_mix_pre[l]), sh_m, sc_m)
        h_ctx = modulate(rms_norm(ctx, g_mix_pre[l]), csh_m, csc_m)
        y_lat, y_ctx = hybrid_mixer(h_lat, h_ctx, cos, sin, w_in[l], w_out[l], lru_conv_w[l], lru_conv_b[l],
                                    lru_wa[l], lru_ba[l], lru_wx[l], lru_bx[l], lru_lam[l], ret_theta[l],
                                    cm_ln_g[l], cm_ln_b[l], cm_ws[l], cm_bs[l], want_ctx)
        x = x + gt_m * rms_norm(y_lat, g_mix_post[l])
        if want_ctx:
            ctx = ctx + cgt_m * rms_norm(y_ctx, g_mix_post[l])
        j = l // 2
        if l % 2 == 0:
            ffn = lambda h, j=j: swiglu(h, ffn_w1[j], ffn_w3[j], ffn_w2[j])
        else:
            ffn = lambda h, j=j: moe_swiglu(h, router_w[j], moe_w1[j], moe_w3[j], moe_w2[j])
        h_lat = modulate(rms_norm(x, g_ffn_pre[l]), sh_f, sc_f)
        x = x + gt_f * rms_norm(ffn(h_lat), g_ffn_post[l])
        if want_ctx:
            h_ctx = modulate(rms_norm(ctx, g_ffn_pre[l]), csh_f, csc_f)
            ctx = ctx + cgt_f * rms_norm(ffn(h_ctx), g_ffn_post[l])
    return x
```

```cpp
#include <hip/hip_runtime.h>
#include <cstdio>
#include <cstdint>

#ifndef NREP_G
#define NREP_G 1
#endif
#ifndef NREP_IN
#define NREP_IN NREP_G
#endif
#ifndef NREP_OUT
#define NREP_OUT NREP_G
#endif
#ifndef NREP_DG1
#define NREP_DG1 NREP_G
#endif
#ifndef NREP_DG2
#define NREP_DG2 NREP_G
#endif
#ifndef NREP_MG1
#define NREP_MG1 NREP_G
#endif
#ifndef NREP_MG2
#define NREP_MG2 NREP_G
#endif
#ifndef NREP_MB
#define NREP_MB 1
#endif
#ifndef NREP_MA
#define NREP_MA 1
#endif
#ifndef NREP_LRU
#define NREP_LRU NREP_MA
#endif
#ifndef NREP_RP1
#define NREP_RP1 NREP_MA
#endif
#ifndef NREP_GM
#define NREP_GM NREP_MA
#endif
#ifndef NREP_P0
#define NREP_P0 1
#endif
#ifndef NREP_N0
#define NREP_N0 1
#endif
#ifndef MK_PER_PHASE
#define MK_PER_PHASE 0
#endif

namespace pg8 {
#define PG8_LAS __attribute__((address_space(3)))
typedef unsigned short bf16_t;
typedef short bf16x8 __attribute__((ext_vector_type(8)));
typedef float f32x4 __attribute__((ext_vector_type(4)));
typedef float f32x2 __attribute__((ext_vector_type(2)));
typedef unsigned u32x4 __attribute__((ext_vector_type(4)));
typedef unsigned u32x2 __attribute__((ext_vector_type(2)));
constexpr int BM = 256, BK = 64, HALF = 128, HTB = HALF * BK * 2, STAGE_BYTES = 8 * HTB, NXCD = 8, WGM = 4;

__host__ __device__ __forceinline__ int lds_byte(int r, int c) { const int st = (r >> 4) * 2 + (c >> 5), rr = r & 15, cc = c & 31, ob = rr * 64 + cc * 2; return st * 1024 + (ob ^ (((ob >> 9) & 1) << 5)); }
__host__ __device__ __forceinline__ void stage_rc(int b, int& R, int& C) { const int st = b / 1024, sb = b % 1024, swz = sb ^ (((sb >> 9) & 1) << 5); R = (st >> 1) * 16 + swz / 64; C = (st & 1) * 32 + (swz % 64) / 2; }
__host__ __device__ __forceinline__ int perm32(int rho) { const int n = rho >> 4, i = rho & 15; return 8 * (i >> 2) + 4 * n + (i & 3); }

struct Unit { int pm, pn, e; };
struct Gemm { const void* A; const void* Bt; int M, N, Kb; size_t bstride; const int* rowidx; };

struct StaticOrder {
    int nM, nN, nwg, G, c;
    __host__ __device__ void init(int M, int N, int G_, int c_) { nM = M / BM; nN = N / BM; nwg = nM * nN; G = G_; c = c_; }
    __host__ __device__ bool next(int i, Unit& u) const {
        const long L = (long)i * G + c; if (L >= nwg) return false;
        int wgid = (int)L; { const int q = nwg / NXCD, r = nwg % NXCD, xcd = wgid % NXCD, off = wgid / NXCD; wgid = (xcd < r ? xcd * (q + 1) : r * (q + 1) + (xcd - r) * q) + off; }
        const int nig = WGM * nN, gid = wgid / nig, fm = gid * WGM, gsz = (nM - fm) < WGM ? (nM - fm) : WGM;
        u.pm = fm + ((wgid % nig) % gsz); u.pn = (wgid % nig) / gsz; u.e = 0; return true;
    }
    __device__ __forceinline__ void a_ready(const Unit&) const {}
    __device__ __forceinline__ void done(const Unit&) const {}
};
struct MoeOrder {
    int nM, nN, nwg, G, c, t0; const PG8_LAS int* segt;
    __device__ __forceinline__ bool next(int i, Unit& u) const {
        const long L = (long)i * G + c; if (L >= nwg) return false;
        int wgid = (int)L; { const int q = nwg / NXCD, r = nwg % NXCD, xcd = wgid % NXCD, off = wgid / NXCD; wgid = (xcd < r ? xcd * (q + 1) : r * (q + 1) + (xcd - r) * q) + off; }
        const int nig = WGM * nN, gid = wgid / nig, fm = gid * WGM, gsz = (nM - fm) < WGM ? (nM - fm) : WGM;
        u.pm = t0 + fm + ((wgid % nig) % gsz); u.pn = (wgid % nig) / gsz;
        int e = 0;
#pragma unroll
        for (int k = 1; k < 8; ++k) e += (u.pm >= segt[k]) ? 1 : 0;
        u.e = __builtin_amdgcn_readfirstlane(e); return true;
    }
    __device__ __forceinline__ void a_ready(const Unit&) const {}
    __device__ __forceinline__ void done(const Unit&) const {}
};

__device__ __forceinline__ unsigned cvt_pk_bf16(float lo, float hi) { unsigned r; asm volatile("v_cvt_pk_bf16_f32 %0, %1, %2" : "=v"(r) : "v"(lo), "v"(hi)); return r; }

struct EpiBf16 {
    static constexpr bool PERM = true, AFTER_DRAIN = false; static constexpr int NST = 16;
    bf16_t* O; int ldc; float scale;
    static constexpr bool SCALES = false;
    __device__ __forceinline__ void operator()(const f32x4 (&acc)[2][2][4][2], const Unit& u, int wr, int wc, int fr, int fq, const PG8_LAS unsigned char*) const {
        const int row0 = u.pm * BM + wr * 64 + fr; const int col0 = u.pn * BM + wc * 32 + 8 * fq;
#pragma unroll
        for (int ai = 0; ai < 2; ++ai)
#pragma unroll
            for (int m = 0; m < 4; ++m) { bf16_t* rowp = O + (size_t)(row0 + ai * HALF + m * 16) * ldc + col0;
#pragma unroll
                for (int bj = 0; bj < 2; ++bj) { const f32x4 v0 = acc[ai][bj][m][0] * scale, v1 = acc[ai][bj][m][1] * scale;
                    u32x4 w; w.x = cvt_pk_bf16(v0[0], v0[1]); w.y = cvt_pk_bf16(v0[2], v0[3]); w.z = cvt_pk_bf16(v1[0], v1[1]); w.w = cvt_pk_bf16(v1[2], v1[3]);
                    *(u32x4*)(rowp + bj * HALF) = w; } }
    }
};
struct EpiInProj {
    static constexpr bool PERM = true, AFTER_DRAIN = false; static constexpr int NST = 16;
    bf16_t* O; int ldc; const float* cs; const float* sa; const float* sw;
    static constexpr bool SCALES = true;
    __device__ __forceinline__ void prefetch(PG8_LAS unsigned char* sl, const Unit& u, int wr, int wc, int lane) const {
        const float* sap = sa + u.pm * BM + wr * 64 + lane;
        __builtin_amdgcn_global_load_lds((const unsigned*)sap, (PG8_LAS unsigned*)sl, 4, 0, 0); __builtin_amdgcn_global_load_lds((const unsigned*)(sap + HALF), (PG8_LAS unsigned*)(sl + 256), 4, 0, 0);
        const float* swp = sw + u.pn * BM + wc * 32 + (lane & 31) + (lane >> 5) * HALF;
        __builtin_amdgcn_global_load_lds((const unsigned*)swp, (PG8_LAS unsigned*)(sl + 512), 4, 0, 0);
    }
    __device__ __forceinline__ void operator()(const f32x4 (&acc)[2][2][4][2], const Unit& u, int wr, int wc, int fr, int fq, const PG8_LAS unsigned char* sl) const {
        const int row0 = u.pm * BM + wr * 64 + fr; const int col0 = u.pn * BM + wc * 32 + 8 * fq;
        const bool qk = (u.pn >= 3 && u.pn <= 5); const bool rope = qk && (u.pm >= 32);
        f32x4 swv[2][2];
#pragma unroll
        for (int bj = 0; bj < 2; ++bj) { swv[bj][0] = *(const PG8_LAS f32x4*)(sl + 512 + (bj * 32 + 8 * fq) * 4); swv[bj][1] = *(const PG8_LAS f32x4*)(sl + 512 + (bj * 32 + 8 * fq + 4) * 4); }
#pragma unroll
        for (int ai = 0; ai < 2; ++ai)
#pragma unroll
            for (int m = 0; m < 4; ++m) { const int row = row0 + ai * HALF + m * 16; bf16_t* rowp = O + (size_t)row * ldc + col0;
                const int pos = (row - 8192) & 2047; const float sar = *(const PG8_LAS float*)(sl + ai * 256 + (m * 16 + fr) * 4);
#pragma unroll
                for (int bj = 0; bj < 2; ++bj) { f32x4 v0 = acc[ai][bj][m][0] * swv[bj][0] * sar, v1 = acc[ai][bj][m][1] * swv[bj][1] * sar;
                    if (qk) { const float sc = (u.pn == 3 || (u.pn == 4 && bj == 0)) ? 0.125f : 1.0f; v0 = v0 * sc; v1 = v1 * sc; }
                    if (rope) { const int pr = ((col0 + bj * HALF) & 63) >> 1;
                        const f32x4 c0 = *(const f32x4*)(cs + ((size_t)pos * 32 + pr) * 2), c1 = *(const f32x4*)(cs + ((size_t)pos * 32 + pr) * 2 + 4);
                        f32x4 r0, r1;
                        r0[0] = v0[0] * c0[0] - v0[1] * c0[1]; r0[1] = v0[0] * c0[1] + v0[1] * c0[0]; r0[2] = v0[2] * c0[2] - v0[3] * c0[3]; r0[3] = v0[2] * c0[3] + v0[3] * c0[2];
                        r1[0] = v1[0] * c1[0] - v1[1] * c1[1]; r1[1] = v1[0] * c1[1] + v1[1] * c1[0]; r1[2] = v1[2] * c1[2] - v1[3] * c1[3]; r1[3] = v1[2] * c1[3] + v1[3] * c1[2];
                        v0 = r0; v1 = r1; }
                    u32x4 w; w.x = cvt_pk_bf16(v0[0], v0[1]); w.y = cvt_pk_bf16(v0[2], v0[3]); w.z = cvt_pk_bf16(v1[0], v1[1]); w.w = cvt_pk_bf16(v1[2], v1[3]);
                    *(u32x4*)(rowp + bj * HALF) = w; } }
    }
};
struct EpiSwiGLU {
    static constexpr bool PERM = true, AFTER_DRAIN = false; static constexpr int NST = 8;
    unsigned char* O; int ldc; const float* sa; const float* sw; float outscale;
    static constexpr bool SCALES = true;
    __device__ __forceinline__ void prefetch(PG8_LAS unsigned char* sl, const Unit& u, int wr, int wc, int lane) const {
        const float* sap = sa + u.pm * BM + wr * 64 + lane;
        __builtin_amdgcn_global_load_lds((const unsigned*)sap, (PG8_LAS unsigned*)sl, 4, 0, 0); __builtin_amdgcn_global_load_lds((const unsigned*)(sap + HALF), (PG8_LAS unsigned*)(sl + 256), 4, 0, 0);
        const float* swp = sw + (size_t)u.e * (2 * 2816) + u.pn * BM + wc * 32 + (lane & 31) + (lane >> 5) * HALF;
        __builtin_amdgcn_global_load_lds((const unsigned*)swp, (PG8_LAS unsigned*)(sl + 512), 4, 0, 0);
    }
    __device__ __forceinline__ void operator()(const f32x4 (&acc)[2][2][4][2], const Unit& u, int wr, int wc, int fr, int fq, const PG8_LAS unsigned char* sl) const {
        const int row0 = u.pm * BM + wr * 64 + fr; const int col0 = u.pn * HALF + wc * 32 + 8 * fq;
        f32x4 sw1[2], sw3[2];
#pragma unroll
        for (int n = 0; n < 2; ++n) { const f32x4 s1 = *(const PG8_LAS f32x4*)(sl + 512 + (8 * fq + 4 * n) * 4); sw3[n] = s1 * (*(const PG8_LAS f32x4*)(sl + 512 + (32 + 8 * fq + 4 * n) * 4) * outscale); sw1[n] = s1 * -1.44269504f; }
#pragma unroll
        for (int ai = 0; ai < 2; ++ai)
#pragma unroll
            for (int m = 0; m < 4; ++m) { unsigned char* rowp = O + (size_t)(row0 + ai * HALF + m * 16) * ldc + col0; const float sar = *(const PG8_LAS float*)(sl + ai * 256 + (m * 16 + fr) * 4);
                f32x4 h[2];
#pragma unroll
                for (int n = 0; n < 2; ++n) { const f32x4 w = acc[ai][0][m][n] * sar;
                    const f32x4 tt = w * sw1[n], q = (w * acc[ai][1][m][n]) * sw3[n];
#pragma unroll
                    for (int j = 0; j < 4; ++j) { const float rs = __builtin_amdgcn_rcpf(1.0f + __builtin_amdgcn_exp2f(tt[j])) * sar; h[n][j] = __builtin_amdgcn_fmed3f(q[j] * rs, -448.0f, 448.0f); } }
                u32x2 w; unsigned t = 0u;
                t = __builtin_amdgcn_cvt_pk_fp8_f32(h[0][0], h[0][1], t, false); t = __builtin_amdgcn_cvt_pk_fp8_f32(h[0][2], h[0][3], t, true); w.x = t;
                t = __builtin_amdgcn_cvt_pk_fp8_f32(h[1][0], h[1][1], t, false); t = __builtin_amdgcn_cvt_pk_fp8_f32(h[1][2], h[1][3], t, true); w.y = t;
                *(u32x2*)rowp = w; }
    }
};

typedef int v4i_t __attribute__((ext_vector_type(4)));
typedef int v8i_t __attribute__((ext_vector_type(8)));
template <class Epi, class Sched, bool ALIGN_EPI, bool GATHER, int DT>
__device__ __forceinline__ void gemm_phase(PG8_LAS unsigned char* lds, const Gemm g, const Sched& S, const Epi& E, const int tid) {
    const int wid = __builtin_amdgcn_readfirstlane(tid >> 6), lane = tid & 63, wr = wid >> 2, wc = wid & 3, fr = lane & 15, fq = lane >> 4;
    const int Kb = g.Kb, nt = Kb / 128;
    unsigned voffA[2], voffB[2];
#pragma unroll
    for (int i = 0; i < 2; ++i) { int R, C; stage_rc(tid * 16 + i * 8192, R, C); const int Rb = Epi::PERM ? ((R & ~31) + perm32(R & 31)) : R;
        voffA[i] = (unsigned)(R * Kb + C * 2); voffB[i] = (unsigned)(Rb * Kb + C * 2); }
    const size_t kstep = (size_t)(BK * 2);
    const size_t hstep = (size_t)HALF * Kb;
    const size_t tstep = 2 * hstep;
    const unsigned ldsw = (unsigned)wid * 1024u;
    const int aoff = lds_byte(wr * 64 + fr, fq * 8), boff = lds_byte(wc * 32 + fr, fq * 8);
#define PG8_SA(b, h) (((b) * 2 + (h)) * HTB)
#define PG8_SB(b, h) ((4 + (b) * 2 + (h)) * HTB)
#define PG8_STAGE(bufoff, gbase, voff) do { _Pragma("unroll") for (int _i = 0; _i < 2; ++_i) \
        __builtin_amdgcn_global_load_lds((const unsigned*)((const char*)(gbase) + (voff)[_i]), (PG8_LAS unsigned*)(lds + (bufoff) + ldsw + _i * 8192), 16, 0, 0); } while (0)
#define PG8_STAGE_A(bufoff, ptr, h, AO0, AO1) do { if constexpr (GATHER) { if ((h) == 0) PG8_STAGE(bufoff, ptr, AO0); else PG8_STAGE(bufoff, ptr, AO1); } else PG8_STAGE(bufoff, (ptr) + (h) * hstep, voffA); } while (0)
#define PG8_LD8(p) __builtin_shufflevector(*(const PG8_LAS v4i_t*)(p), *(const PG8_LAS v4i_t*)((p) + 1024), 0, 1, 2, 3, 4, 5, 6, 7)
#define PG8_LO(x) __builtin_bit_cast(bf16x8, __builtin_shufflevector(x, x, 0, 1, 2, 3))
#define PG8_HI(x) __builtin_bit_cast(bf16x8, __builtin_shufflevector(x, x, 4, 5, 6, 7))
#define PG8_LDA(dst, b, h) do { _Pragma("unroll") for (int m = 0; m < 4; ++m) dst[m] = PG8_LD8(lds + PG8_SA(b, h) + aoff + m * 2048); } while (0)
#define PG8_LDB(dst, b, h) do { _Pragma("unroll") for (int n = 0; n < 2; ++n) dst[n] = PG8_LD8(lds + PG8_SB(b, h) + boff + n * 2048); } while (0)
#define PG8_MMA(ai, bj, At, Bt) do { __builtin_amdgcn_s_setprio(1); \
        if constexpr (DT == 1) { _Pragma("unroll") for (int m = 0; m < 4; ++m) _Pragma("unroll") for (int n = 0; n < 2; ++n) \
            asm volatile("v_mfma_scale_f32_16x16x128_f8f6f4 %0, %1, %2, %0, %3, %3 op_sel_hi:[0,0,0]" : "+v"(acc[ai][bj][m][n]) : "v"(Bt[n]), "v"(At[m]), "v"(f8one)); } \
        else if constexpr (DT == 2) { \
            _Pragma("unroll") for (int m = 0; m < 4; ++m) _Pragma("unroll") for (int n = 0; n < 2; ++n) \
                asm volatile("v_mfma_i32_16x16x64_i8 %0, %1, %2, %0" : "+v"(acc[ai][bj][m][n]) : "v"(__builtin_shufflevector(Bt[n], Bt[n], 0, 1, 2, 3)), "v"(__builtin_shufflevector(At[m], At[m], 0, 1, 2, 3))); \
            _Pragma("unroll") for (int m = 0; m < 4; ++m) _Pragma("unroll") for (int n = 0; n < 2; ++n) \
                asm volatile("v_mfma_i32_16x16x64_i8 %0, %1, %2, %0" : "+v"(acc[ai][bj][m][n]) : "v"(__builtin_shufflevector(Bt[n], Bt[n], 4, 5, 6, 7)), "v"(__builtin_shufflevector(At[m], At[m], 4, 5, 6, 7))); } \
        else { _Pragma("unroll") for (int m = 0; m < 4; ++m) _Pragma("unroll") for (int n = 0; n < 2; ++n) { \
               acc[ai][bj][m][n] = __builtin_amdgcn_mfma_f32_16x16x32_bf16(PG8_LO(Bt[n]), PG8_LO(At[m]), acc[ai][bj][m][n], 0, 0, 0); \
               acc[ai][bj][m][n] = __builtin_amdgcn_mfma_f32_16x16x32_bf16(PG8_HI(Bt[n]), PG8_HI(At[m]), acc[ai][bj][m][n], 0, 0, 0); } } \
        __builtin_amdgcn_s_setprio(0); } while (0)
#define PG8_WAIT_V(n) asm volatile("s_waitcnt vmcnt(" #n ")" ::: "memory")
#define PG8_WAIT_VN(n) asm volatile("s_waitcnt vmcnt(%0)" :: "n"(n) : "memory")
#define PG8_WAIT_L(n) asm volatile("s_waitcnt lgkmcnt(" #n ")" ::: "memory")
#define PG8_BAR __builtin_amdgcn_s_barrier()
#define PG8_SCHED __builtin_amdgcn_sched_barrier(0)
    Unit cur, nxt; int ui = 0;
    if (!S.next(0, cur)) return;
    f32x4 acc[2][2][4][2];
#pragma unroll
    for (int a = 0; a < 2; ++a)
#pragma unroll
        for (int b = 0; b < 2; ++b)
#pragma unroll
            for (int m = 0; m < 4; ++m)
#pragma unroll
                for (int n = 0; n < 2; ++n) { acc[a][b][m][n] = (f32x4){0.f, 0.f, 0.f, 0.f}; asm volatile("" : "+v"(acc[a][b][m][n])); }
    v8i_t At[4], B0[2], B1[2];
    const int f8one = 0x7f7f7f7f;
    unsigned aoC0[2] = {0u, 0u}, aoC1[2] = {0u, 0u};
    PG8_LAS unsigned char* idx_lds = lds + STAGE_BYTES + wid * 1024;
    if constexpr (GATHER) {
#pragma unroll
        for (int i = 0; i < 2; ++i) { int R, C; stage_rc(tid * 16 + i * 8192, R, C); const int r0 = g.rowidx[cur.pm * BM + R], r1 = g.rowidx[cur.pm * BM + HALF + R];
            aoC0[i] = (unsigned)r0 * (unsigned)Kb + (unsigned)(C * 2); aoC1[i] = (unsigned)r1 * (unsigned)Kb + (unsigned)(C * 2); }
    }
    const char* cA = GATHER ? (const char*)g.A : (const char*)g.A + (size_t)cur.pm * tstep; const char* cB = (const char*)g.Bt + (size_t)cur.e * g.bstride + (size_t)cur.pn * tstep;
    S.a_ready(cur);
    PG8_STAGE(PG8_SB(0, 0), cB, voffB); PG8_STAGE(PG8_SB(0, 1), cB + hstep, voffB); PG8_STAGE_A(PG8_SA(0, 0), cA, 0, aoC0, aoC1); PG8_STAGE_A(PG8_SA(0, 1), cA, 1, aoC0, aoC1);
    if (wr == 1) PG8_BAR;
    PG8_WAIT_V(2); PG8_BAR;
    PG8_STAGE(PG8_SB(1, 0), cB + kstep, voffB); PG8_STAGE_A(PG8_SA(1, 0), cA + kstep, 0, aoC0, aoC1); PG8_STAGE(PG8_SB(1, 1), cB + hstep + kstep, voffB);
    PG8_WAIT_V(6); PG8_BAR;
    PG8_LAS unsigned char* scal_lds = lds + STAGE_BYTES + 8192 + wid * 1024;
    for (;;) {
        const bool has_next = S.next(ui + 1, nxt);
        if constexpr (Epi::SCALES) E.prefetch(scal_lds, cur, wr, wc, lane);
        const char* nA = GATHER ? (const char*)g.A : (has_next ? (const char*)g.A + (size_t)nxt.pm * tstep : cA);
        const char* nB = has_next ? (const char*)g.Bt + (size_t)nxt.e * g.bstride + (size_t)nxt.pn * tstep : cB;
        if constexpr (GATHER) { if (has_next) {
#pragma unroll
            for (int i = 0; i < 2; ++i) { int R, C; stage_rc(tid * 16 + i * 8192, R, C);
                __builtin_amdgcn_global_load_lds((const unsigned*)(g.rowidx + nxt.pm * BM + R), (PG8_LAS unsigned*)(idx_lds + (2 * i) * 256), 4, 0, 0);
                __builtin_amdgcn_global_load_lds((const unsigned*)(g.rowidx + nxt.pm * BM + HALF + R), (PG8_LAS unsigned*)(idx_lds + (2 * i + 1) * 256), 4, 0, 0); } } }
#define PG8_TRIP(t, W1, W2, W3, NOSP1) do { \
            const bool last = ((t) == nt - 2); \
            const char* a1 = cA + (size_t)((t) + 1) * kstep; \
            const char* a2 = last ? nA : cA + (size_t)((t) + 2) * kstep; const char* b2 = last ? nB : cB + (size_t)((t) + 2) * kstep; \
            const char* a3 = a2 + kstep; const char* b3 = b2 + kstep; \
            if (last && has_next) S.a_ready(nxt); \
            PG8_LDB(B0, 0, 0); PG8_LDB(B1, 0, 1); PG8_SCHED; PG8_LDA(At, 0, 0); if (!(NOSP1)) PG8_STAGE_A(PG8_SA(1, 1), a1, 1, aoC0, aoC1); \
            if constexpr (GATHER) { if (last && has_next) { \
                _Pragma("unroll") for (int i = 0; i < 2; ++i) { int R, C; stage_rc(tid * 16 + i * 8192, R, C); \
                    const unsigned i0 = *(const PG8_LAS unsigned*)(idx_lds + (2 * i) * 256 + lane * 4), i1 = *(const PG8_LAS unsigned*)(idx_lds + (2 * i + 1) * 256 + lane * 4); \
                    aoC0[i] = i0 * (unsigned)Kb + (unsigned)(C * 2); aoC1[i] = i1 * (unsigned)Kb + (unsigned)(C * 2); } } } \
            PG8_WAIT_VN(W1); PG8_WAIT_L(0); PG8_BAR; PG8_MMA(0, 0, At, B0); PG8_MMA(0, 1, At, B1); PG8_BAR; PG8_SCHED; \
            PG8_LDA(At, 0, 1); PG8_STAGE(PG8_SB(0, 0), b2, voffB); PG8_STAGE(PG8_SB(0, 1), b2 + hstep, voffB); PG8_STAGE_A(PG8_SA(0, 0), a2, 0, aoC0, aoC1); \
            PG8_WAIT_VN(W2); PG8_WAIT_L(0); PG8_BAR; PG8_MMA(1, 0, At, B0); PG8_MMA(1, 1, At, B1); PG8_BAR; PG8_SCHED; \
            PG8_LDB(B0, 1, 0); PG8_LDB(B1, 1, 1); PG8_SCHED; PG8_LDA(At, 1, 0); PG8_STAGE_A(PG8_SA(0, 1), a2, 1, aoC0, aoC1); \
            PG8_WAIT_VN(W3); PG8_WAIT_L(0); PG8_BAR; PG8_MMA(0, 0, At, B0); PG8_MMA(0, 1, At, B1); PG8_BAR; PG8_SCHED; \
            PG8_LDA(At, 1, 1); PG8_STAGE(PG8_SB(1, 0), b3, voffB); PG8_STAGE(PG8_SB(1, 1), b3 + hstep, voffB); PG8_STAGE_A(PG8_SA(1, 0), a3, 0, aoC0, aoC1); \
            PG8_WAIT_VN(8); PG8_WAIT_L(0); PG8_BAR; PG8_MMA(1, 0, At, B0); PG8_MMA(1, 1, At, B1); PG8_BAR; PG8_SCHED; \
            if (last && has_next) PG8_STAGE_A(PG8_SA(1, 1), a3, 1, aoC0, aoC1);        \
        } while (0)
        int tbeg = 0;
        if (ui > 0) { PG8_TRIP(0, 8 + Epi::NST, 8 + Epi::NST, 8 + Epi::NST, true); tbeg = 2; }
#pragma clang loop unroll(disable)
        for (int t = tbeg; t < nt; t += 2) { PG8_TRIP(t, 8, 8, 8, false); }
#undef PG8_TRIP
        if constexpr (ALIGN_EPI) { if (wr == 0) PG8_BAR; }
        if constexpr (DT != 0) asm volatile("s_nop 15\n\ts_nop 15" ::: "memory");
        if constexpr (DT == 2) {
#pragma unroll
            for (int a = 0; a < 2; ++a)
#pragma unroll
                for (int b = 0; b < 2; ++b)
#pragma unroll
                    for (int m = 0; m < 4; ++m)
#pragma unroll
                        for (int n = 0; n < 2; ++n) { const v4i_t ci = __builtin_bit_cast(v4i_t, acc[a][b][m][n]); acc[a][b][m][n] = (f32x4){(float)ci[0], (float)ci[1], (float)ci[2], (float)ci[3]}; } }
        if constexpr (!Epi::AFTER_DRAIN) { E(acc, cur, wr, wc, fr, fq, scal_lds); S.done(cur); }
        if (!has_next) break;
#pragma unroll
        for (int a = 0; a < 2; ++a)
#pragma unroll
            for (int b = 0; b < 2; ++b)
#pragma unroll
                for (int m = 0; m < 4; ++m)
#pragma unroll
                    for (int n = 0; n < 2; ++n) { acc[a][b][m][n] = (f32x4){0.f, 0.f, 0.f, 0.f}; asm volatile("" : "+v"(acc[a][b][m][n])); }
        cur = nxt; cA = nA; cB = nB; ++ui;
        if constexpr (DT != 0) asm volatile("s_nop 7" ::: "memory");
        if constexpr (ALIGN_EPI) { if (wr == 1) PG8_BAR; }
    }
    PG8_WAIT_V(0);
    if constexpr (!ALIGN_EPI) { if (wr == 0) PG8_BAR; }
    PG8_BAR;
#undef PG8_SA
#undef PG8_SB
#undef PG8_STAGE
#undef PG8_STAGE_A
#undef PG8_LDA
#undef PG8_LDB
#undef PG8_MMA
#undef PG8_LD8
#undef PG8_LO
#undef PG8_HI
#undef PG8_WAIT_V
#undef PG8_WAIT_VN
#undef PG8_WAIT_L
#undef PG8_BAR
#undef PG8_SCHED
}
}

using pg8::bf16x8; using pg8::f32x4; using pg8::f32x2; using pg8::u32x4; using pg8::u32x2;
typedef unsigned short bf16;
#define LAS __attribute__((address_space(3)))
constexpr int D = 1024, NB = 32, SEQ = 2048, CTXL = 256, DEPTH = 4;
constexpr int MC = NB * CTXL, ML = NB * SEQ, MT = MC + ML;
constexpr int INW = 2816, DFF = 2816, NE = 8;
constexpr int NWAVES = 8, NTHR = 512;
constexpr float EPS = 1e-6f;
constexpr int NPH = 10;
constexpr int SLAB_TILES = 292;
constexpr float CSC = 8.0f, WSCO = 64.0f;
constexpr float WSC2 = 64.0f, HSC = 4.0f;
constexpr int MAX_SLOTS = 2 * MT + 8 * 256;

constexpr size_t MiB = 1u << 20;
constexpr size_t WS_CTL = 0, CTL_BYTES = 2 * MiB;
constexpr size_t WS_MOD = 2 * MiB;
constexpr size_t WS_ROPE = 6 * MiB;
constexpr size_t WS_SMALLW = 7 * MiB;
constexpr size_t WS_TOKINFO = 9 * MiB;
constexpr size_t WS_TOKSLOT = 11 * MiB;
constexpr size_t WS_SLOTTOK = 12 * MiB;
constexpr size_t WS_XCTX = 13 * MiB;
constexpr size_t WS_W = 45 * MiB;
constexpr size_t W_WIN = 0, W_WOUT = 3 * MiB, W_FFN = 5 * MiB;
constexpr size_t W13_BYTES = (size_t)2 * DFF * D, W2_BYTES = (size_t)D * DFF;
constexpr size_t WS_A = 119 * MiB;
constexpr size_t WS_XL = 191 * MiB;
constexpr size_t WS_A_OLD_UNUSED = 0;
constexpr size_t WS_R = 319 * MiB;
constexpr size_t WS_B = 715 * MiB;
constexpr size_t WS_Y = 859 * MiB;
constexpr size_t WS_END = 1003 * MiB;
constexpr size_t Y_SBUF = 0, Y_TLRU = 56 * MiB;
constexpr size_t MOE_YSLOT = WS_R, MOE_HID = WS_R + 292 * MiB;
static_assert(W_FFN + 8 * (W13_BYTES + W2_BYTES) <= WS_A - WS_W, "weights region");
static_assert((size_t)MAX_SLOTS * D * 2 <= 292 * MiB && MOE_HID + (size_t)SLAB_TILES * 256 * DFF <= WS_END, "moe scratch");
static_assert((size_t)NB * 6 * 2 * 18 * 4096 * 2 <= 56 * MiB && Y_TLRU + (size_t)MT * 384 * 2 <= 144 * MiB, "mixer scratch in Y");

constexpr int CW_QUEUE = 64;
constexpr int CW_GCNT = 3072;
constexpr int CW_GPOS = 3328;
constexpr int CW_BAR = 4096;

constexpr int RING_BYTES = 131072;
constexpr int LDS_BYTES = 155648;
constexpr int MISC_OFF = LDS_BYTES - 512;

__device__ __forceinline__ float bf_lo(unsigned w) { return __uint_as_float(w << 16); }
__device__ __forceinline__ float bf_hi(unsigned w) { return __uint_as_float(w & 0xffff0000u); }
__device__ __forceinline__ unsigned pk2(float lo, float hi) { return pg8::cvt_pk_bf16(lo, hi); }
__device__ __forceinline__ float fexp2(float x) { return __builtin_amdgcn_exp2f(x); }
__device__ __forceinline__ float fexp(float x) { return __builtin_amdgcn_exp2f(1.44269504f * x); }
__device__ __forceinline__ float sigm(float x) { return __builtin_amdgcn_rcpf(1.0f + fexp(-x)); }
__device__ __forceinline__ float silu_f(float x) { return x * sigm(x); }
__device__ __forceinline__ float gelu_t(float x) { const float u = 0.7978845608f * (x + 0.044715f * x * x * x); return x * sigm(2.0f * u); }
__device__ __forceinline__ unsigned pk4f8(float a, float b, float c, float d, float sc) {
    unsigned t = 0u;
    t = __builtin_amdgcn_cvt_pk_fp8_f32(__builtin_amdgcn_fmed3f(a * sc, -448.0f, 448.0f), __builtin_amdgcn_fmed3f(b * sc, -448.0f, 448.0f), t, false);
    t = __builtin_amdgcn_cvt_pk_fp8_f32(__builtin_amdgcn_fmed3f(c * sc, -448.0f, 448.0f), __builtin_amdgcn_fmed3f(d * sc, -448.0f, 448.0f), t, true);
    return t;
}
template <int CTRL> __device__ __forceinline__ float dpp_mov(float v) { return __builtin_bit_cast(float, __builtin_amdgcn_update_dpp(0, __builtin_bit_cast(int, v), CTRL, 0xF, 0xF, false)); }
__device__ __forceinline__ float lane_rd(float v, int l) { return __builtin_bit_cast(float, __builtin_amdgcn_readlane(__builtin_bit_cast(int, v), l)); }
__device__ __forceinline__ float wave_sum(float v) {
    v += dpp_mov<0xB1>(v); v += dpp_mov<0x4E>(v); v += dpp_mov<0x141>(v); v += dpp_mov<0x140>(v);
    return (lane_rd(v, 0) + lane_rd(v, 16)) + (lane_rd(v, 32) + lane_rd(v, 48));
}
__device__ __forceinline__ float wave_max(float v) {
    v = fmaxf(v, dpp_mov<0xB1>(v)); v = fmaxf(v, dpp_mov<0x4E>(v)); v = fmaxf(v, dpp_mov<0x141>(v)); v = fmaxf(v, dpp_mov<0x140>(v));
    return fmaxf(fmaxf(lane_rd(v, 0), lane_rd(v, 16)), fmaxf(lane_rd(v, 32), lane_rd(v, 48)));
}
__device__ __forceinline__ f32x4 mfma16(bf16x8 a, bf16x8 b, f32x4 c) { return __builtin_amdgcn_mfma_f32_16x16x32_bf16(a, b, c, 0, 0, 0); }
__device__ __forceinline__ bf16x8 ld16g(const bf16* p) { return __builtin_bit_cast(bf16x8, *(const u32x4*)p); }
__device__ __forceinline__ bf16x8 ld16l(const LAS bf16* p) { return __builtin_bit_cast(bf16x8, *(const LAS u32x4*)p); }

#define XB_TMO      128
#define XB_XCNT(j)  (256  + 64 * (j))
#define XB_XSUB(j)  (1280 + 64 * (j))
#define XB_XGEN(j)  (2304 + 64 * (j))
#define XB_TOP      3328
#define XB_TOPGEN   3392
#define XCD_BAR_WORDS 3456
#define XB_SPIN_CAP (1u << 18)
__device__ __forceinline__ unsigned xb_ld(unsigned* p)              { return __hip_atomic_load(p, __ATOMIC_RELAXED, __HIP_MEMORY_SCOPE_AGENT); }
__device__ __forceinline__ unsigned xb_add(unsigned* p, unsigned v) { return __hip_atomic_fetch_add(p, v, __ATOMIC_RELAXED, __HIP_MEMORY_SCOPE_AGENT); }
__device__ __forceinline__ unsigned xb_xcc_id() { return (unsigned)__builtin_amdgcn_s_getreg((3 << 11) | 20) & 0xFu; }
#define XB_SPIN(cond, bar) do { unsigned _sp = 0; while (cond) { __builtin_amdgcn_s_sleep(1); \
    if ((++_sp & 255u) == 0u) { if (xb_ld(&(bar)[XB_TMO])) break; if (_sp > XB_SPIN_CAP) { atomicAdd(&(bar)[XB_TMO], 1u); break; } } } } while (0)
struct XcdBarrier { unsigned* bar; unsigned x; volatile LAS unsigned* st; };
__device__ __forceinline__ bool fresh_t0(int wave0) { int l; asm volatile("v_mbcnt_lo_u32_b32 %0, -1, 0\n\tv_mbcnt_hi_u32_b32 %0, -1, %0" : "=v"(l)); return wave0 == 0 && l == 0; }
__device__ __forceinline__ XcdBarrier xcd_barrier_post(unsigned* bar, volatile LAS unsigned* st) {
    XcdBarrier b; b.bar = bar; b.x = xb_xcc_id(); b.st = st;
    if (threadIdx.x == 0) (void)xb_add(&bar[XB_XCNT(b.x)], 1u);
    return b;
}
__device__ __forceinline__ void xcd_barrier_complete(unsigned* bar, unsigned x, unsigned& nloc, unsigned& nx) {
    const unsigned G = gridDim.x * gridDim.y * gridDim.z;
    unsigned sum, cnt, mine, sp = 0u;
    for (;;) {
        sum = 0u; cnt = 0u; mine = 0u;
#pragma unroll
        for (unsigned j = 0; j < 16; ++j) { const unsigned c = xb_ld(&bar[XB_XCNT(j)]); sum += c; cnt += (c > 0u) ? 1u : 0u; mine = (j == x) ? c : mine; }
        if (sum == G) break;
        __builtin_amdgcn_s_sleep(1);
        if ((++sp & 255u) == 0u) { if (xb_ld(&bar[XB_TMO])) break; if (sp > XB_SPIN_CAP) { atomicAdd(&bar[XB_TMO], 1u); break; } }
    }
    nloc = mine > 0u ? mine : 1u; nx = cnt > 0u ? cnt : 1u;
}
__device__ __forceinline__ void xcd_barrier(const XcdBarrier& b, const bool t0) {
    asm volatile("s_waitcnt vmcnt(0)" ::: "memory");
    __syncthreads();
    if (t0) {
        unsigned* bar = b.bar;
        __builtin_amdgcn_s_waitcnt(0);
        unsigned nloc = b.st[0], nx = b.st[1];
        if (nloc == 0u) { xcd_barrier_complete(bar, b.x, nloc, nx); b.st[0] = nloc; b.st[1] = nx; }
        const unsigned old = xb_add(&bar[XB_XSUB(b.x)], 1u);
        const unsigned gen = old / nloc;
        if (old + 1u == (gen + 1u) * nloc) {
            __builtin_amdgcn_fence(__ATOMIC_RELEASE, "agent");
            asm volatile("s_waitcnt vmcnt(0)" ::: "memory");
            const unsigned og = xb_add(&bar[XB_TOP], 1u);
            const unsigned tg = og / nx;
            if (og + 1u == (tg + 1u) * nx) xb_add(&bar[XB_TOPGEN], 1u);
            else XB_SPIN(xb_ld(&bar[XB_TOPGEN]) == tg, bar);
            __builtin_amdgcn_fence(__ATOMIC_ACQUIRE, "agent");
            xb_add(&bar[XB_XGEN(b.x)], 1u);
            asm volatile("s_waitcnt vmcnt(0)" ::: "memory");
        } else {
            XB_SPIN(xb_ld(&bar[XB_XGEN(b.x)]) == gen, bar);
            __builtin_amdgcn_fence(__ATOMIC_ACQUIRE, "agent");
            asm volatile("s_waitcnt vmcnt(0)" ::: "memory");
        }
    }
    __syncthreads();
}

__device__ __forceinline__ void transpose_item(const float* W, int N, bf16* WT, int Kp, int k0, int n0, int drow0, LAS float* scr, int lane) {
    { f32x4 v[8];
#pragma unroll
      for (int i = 0; i < 8; ++i) v[i] = *(const f32x4*)(W + (size_t)(k0 + 8 * i + (lane >> 3)) * N + n0 + 4 * (lane & 7));
#pragma unroll
      for (int i = 0; i < 8; ++i) { LAS float* d = scr + (8 * i + (lane >> 3)) * 33 + 4 * (lane & 7); d[0] = v[i][0]; d[1] = v[i][1]; d[2] = v[i][2]; d[3] = v[i][3]; } }
    asm volatile("s_waitcnt lgkmcnt(0)" ::: "memory");
    const int c = lane & 7;
#pragma unroll
    for (int j = 0; j < 4; ++j) { const int n = (lane >> 3) + 8 * j; const LAS float* s = scr + (8 * c) * 33 + n;
        u32x4 o; o.x = pk2(s[0 * 33], s[1 * 33]); o.y = pk2(s[2 * 33], s[3 * 33]); o.z = pk2(s[4 * 33], s[5 * 33]); o.w = pk2(s[6 * 33], s[7 * 33]);
        *(u32x4*)(WT + (size_t)(drow0 + n) * Kp + k0 + 8 * c) = o; }
    asm volatile("s_waitcnt lgkmcnt(0)" ::: "memory");
}
__device__ __forceinline__ void transpose_item8(const float* W, int N, unsigned char* WT, int Kp, int k0, int n0, int drow0, float sc, LAS float* scr, int lane) {
    { f32x4 v[8];
#pragma unroll
      for (int i = 0; i < 8; ++i) v[i] = *(const f32x4*)(W + (size_t)(k0 + 8 * i + (lane >> 3)) * N + n0 + 4 * (lane & 7));
#pragma unroll
      for (int i = 0; i < 8; ++i) { LAS float* d = scr + (8 * i + (lane >> 3)) * 33 + 4 * (lane & 7); d[0] = v[i][0]; d[1] = v[i][1]; d[2] = v[i][2]; d[3] = v[i][3]; } }
    asm volatile("s_waitcnt lgkmcnt(0)" ::: "memory");
    const int c = lane & 7;
#pragma unroll
    for (int j = 0; j < 4; ++j) { const int n = (lane >> 3) + 8 * j; const LAS float* sp = scr + (8 * c) * 33 + n;
        u32x2 o; unsigned t = 0u;
        float q8[8];
#pragma unroll
        for (int k = 0; k < 8; ++k) q8[k] = __builtin_amdgcn_fmed3f(sp[k * 33] * sc, -448.0f, 448.0f);
        t = __builtin_amdgcn_cvt_pk_fp8_f32(q8[0], q8[1], t, false); t = __builtin_amdgcn_cvt_pk_fp8_f32(q8[2], q8[3], t, true); o.x = t;
        t = __builtin_amdgcn_cvt_pk_fp8_f32(q8[4], q8[5], t, false); t = __builtin_amdgcn_cvt_pk_fp8_f32(q8[6], q8[7], t, true); o.y = t;
        *(u32x2*)(WT + (size_t)(drow0 + n) * Kp + k0 + 8 * c) = o; }
    asm volatile("s_waitcnt lgkmcnt(0)" ::: "memory");
}
__device__ __forceinline__ void conv_i8_item(const float* W, int N, signed char* WT, float* SW, int n0, int drow0, LAS float* scr, int lane) {
    const int cg = lane & 7, rg = lane >> 3;
    const float* wp = W + n0 + 4 * cg;
    f32x4 mx = (f32x4){0.f, 0.f, 0.f, 0.f};
#pragma unroll 16
    for (int i = 0; i < D / 8; ++i) { const f32x4 v = *(const f32x4*)(wp + (size_t)(8 * i + rg) * N); mx[0] = fmaxf(mx[0], fabsf(v[0])); mx[1] = fmaxf(mx[1], fabsf(v[1])); mx[2] = fmaxf(mx[2], fabsf(v[2])); mx[3] = fmaxf(mx[3], fabsf(v[3])); }
#pragma unroll
    for (int o = 8; o < 64; o <<= 1) { mx[0] = fmaxf(mx[0], __shfl_xor(mx[0], o)); mx[1] = fmaxf(mx[1], __shfl_xor(mx[1], o)); mx[2] = fmaxf(mx[2], __shfl_xor(mx[2], o)); mx[3] = fmaxf(mx[3], __shfl_xor(mx[3], o)); }
    f32x4 inv;
#pragma unroll
    for (int j = 0; j < 4; ++j) inv[j] = mx[j] > 0.f ? 127.0f / mx[j] : 0.f;
    if (lane < 8) *(f32x4*)(SW + drow0 + 4 * lane) = mx * (1.0f / 127.0f);
    for (int kb2 = 0; kb2 < D / 64; kb2 += 2) {
        f32x4 v[2][8];
#pragma unroll
        for (int h = 0; h < 2; ++h)
#pragma unroll
            for (int i = 0; i < 8; ++i) v[h][i] = *(const f32x4*)(wp + (size_t)(64 * (kb2 + h) + 8 * i + rg) * N);
#pragma unroll
        for (int h = 0; h < 2; ++h) { const int kb = kb2 + h;
#pragma unroll
            for (int i = 0; i < 8; ++i) { LAS float* d = scr + (8 * i + rg) * 33 + 4 * cg; d[0] = v[h][i][0] * inv[0]; d[1] = v[h][i][1] * inv[1]; d[2] = v[h][i][2] * inv[2]; d[3] = v[h][i][3] * inv[3]; }
            asm volatile("s_waitcnt lgkmcnt(0)" ::: "memory");
            const int c = lane & 7;
#pragma unroll
            for (int j = 0; j < 4; ++j) { const int n = (lane >> 3) + 8 * j; const LAS float* sp = scr + (8 * c) * 33 + n;
                unsigned q[8];
#pragma unroll
                for (int t = 0; t < 8; ++t) q[t] = (unsigned)(int)rintf(sp[t * 33]) & 0xffu;
                u32x2 o; o.x = q[0] | (q[1] << 8) | (q[2] << 16) | (q[3] << 24); o.y = q[4] | (q[5] << 8) | (q[6] << 16) | (q[7] << 24);
                *(u32x2*)(WT + (size_t)(drow0 + n) * D + 64 * kb + 8 * c) = o; }
            asm volatile("s_waitcnt lgkmcnt(0)" ::: "memory"); }
    }
}
__device__ __forceinline__ void conv_i8_item_wg(const float* W, int N, signed char* WT, float* SW, int n0, int drow0, LAS float* scr, LAS float* mxs, int wave, int lane) {
    const int cg = lane & 7, rg = lane >> 3;
    const float* wp = W + n0 + 4 * cg;
    f32x4 mx = (f32x4){0.f, 0.f, 0.f, 0.f};
#pragma unroll
    for (int i = 0; i < 16; ++i) { const f32x4 v = *(const f32x4*)(wp + (size_t)(128 * wave + 8 * i + rg) * N); mx[0] = fmaxf(mx[0], fabsf(v[0])); mx[1] = fmaxf(mx[1], fabsf(v[1])); mx[2] = fmaxf(mx[2], fabsf(v[2])); mx[3] = fmaxf(mx[3], fabsf(v[3])); }
#pragma unroll
    for (int o = 8; o < 64; o <<= 1) { mx[0] = fmaxf(mx[0], __shfl_xor(mx[0], o)); mx[1] = fmaxf(mx[1], __shfl_xor(mx[1], o)); mx[2] = fmaxf(mx[2], __shfl_xor(mx[2], o)); mx[3] = fmaxf(mx[3], __shfl_xor(mx[3], o)); }
    if (lane < 8) *(LAS f32x4*)(mxs + wave * 32 + 4 * lane) = mx;
    __syncthreads();
#pragma unroll
    for (int w = 0; w < 8; ++w) { const f32x4 o = *(const LAS f32x4*)(mxs + w * 32 + 4 * cg); mx[0] = fmaxf(mx[0], o[0]); mx[1] = fmaxf(mx[1], o[1]); mx[2] = fmaxf(mx[2], o[2]); mx[3] = fmaxf(mx[3], o[3]); }
    f32x4 inv;
#pragma unroll
    for (int j = 0; j < 4; ++j) inv[j] = mx[j] > 0.f ? 127.0f / mx[j] : 0.f;
    if (wave == 0 && lane < 8) *(f32x4*)(SW + drow0 + 4 * lane) = mx * (1.0f / 127.0f);
    f32x4 v[2][8];
#pragma unroll
    for (int h = 0; h < 2; ++h)
#pragma unroll
        for (int i = 0; i < 8; ++i) v[h][i] = *(const f32x4*)(wp + (size_t)(64 * (2 * wave + h) + 8 * i + rg) * N);
#pragma unroll
    for (int h = 0; h < 2; ++h) { const int kb = 2 * wave + h;
#pragma unroll
        for (int i = 0; i < 8; ++i) { LAS float* d = scr + (8 * i + rg) * 33 + 4 * cg; d[0] = v[h][i][0] * inv[0]; d[1] = v[h][i][1] * inv[1]; d[2] = v[h][i][2] * inv[2]; d[3] = v[h][i][3] * inv[3]; }
        asm volatile("s_waitcnt lgkmcnt(0)" ::: "memory");
        const int c = lane & 7;
#pragma unroll
        for (int j = 0; j < 4; ++j) { const int n = (lane >> 3) + 8 * j; const LAS float* sp = scr + (8 * c) * 33 + n;
            unsigned q[8];
#pragma unroll
            for (int t = 0; t < 8; ++t) q[t] = (unsigned)(int)rintf(sp[t * 33]) & 0xffu;
            u32x2 o; o.x = q[0] | (q[1] << 8) | (q[2] << 16) | (q[3] << 24); o.y = q[4] | (q[5] << 8) | (q[6] << 16) | (q[7] << 24);
            *(u32x2*)(WT + (size_t)(drow0 + n) * D + 64 * kb + 8 * c) = o; }
        asm volatile("s_waitcnt lgkmcnt(0)" ::: "memory");
    }
    __syncthreads();
}
template <bool FP8>
__device__ __forceinline__ void transpose_quad(const float* W, int N, void* WTv, int Kp, int k0, int n0, int drow0, float sc, LAS float* scr, int lane) {
    f32x4 v[4][8];
#pragma unroll
    for (int q = 0; q < 4; ++q)
#pragma unroll
        for (int i = 0; i < 8; ++i) v[q][i] = *(const f32x4*)(W + (size_t)(k0 + 8 * i + (lane >> 3)) * N + n0 + 32 * q + 4 * (lane & 7));
    const int c = lane & 7;
#pragma unroll
    for (int q = 0; q < 4; ++q) {
#pragma unroll
        for (int i = 0; i < 8; ++i) { LAS float* d = scr + (8 * i + (lane >> 3)) * 33 + 4 * (lane & 7); d[0] = v[q][i][0]; d[1] = v[q][i][1]; d[2] = v[q][i][2]; d[3] = v[q][i][3]; }
        asm volatile("s_waitcnt lgkmcnt(0)" ::: "memory");
#pragma unroll
        for (int j = 0; j < 4; ++j) { const int n = (lane >> 3) + 8 * j; const LAS float* sp = scr + (8 * c) * 33 + n;
            if constexpr (FP8) {
                u32x2 o; unsigned t = 0u; float q8[8];
#pragma unroll
                for (int k = 0; k < 8; ++k) q8[k] = __builtin_amdgcn_fmed3f(sp[k * 33] * sc, -448.0f, 448.0f);
                t = __builtin_amdgcn_cvt_pk_fp8_f32(q8[0], q8[1], t, false); t = __builtin_amdgcn_cvt_pk_fp8_f32(q8[2], q8[3], t, true); o.x = t;
                t = __builtin_amdgcn_cvt_pk_fp8_f32(q8[4], q8[5], t, false); t = __builtin_amdgcn_cvt_pk_fp8_f32(q8[6], q8[7], t, true); o.y = t;
                *(u32x2*)((unsigned char*)WTv + (size_t)(drow0 + 32 * q + n) * Kp + k0 + 8 * c) = o;
            } else {
                u32x4 o; o.x = pk2(sp[0 * 33], sp[1 * 33]); o.y = pk2(sp[2 * 33], sp[3 * 33]); o.z = pk2(sp[4 * 33], sp[5 * 33]); o.w = pk2(sp[6 * 33], sp[7 * 33]);
                *(u32x4*)((bf16*)WTv + (size_t)(drow0 + 32 * q + n) * Kp + k0 + 8 * c) = o; } }
        asm volatile("s_waitcnt lgkmcnt(0)" ::: "memory");
    }
}
__device__ __forceinline__ void conv_plain(const float* W, int K, int N, bf16* WT, int item, LAS float* scr, int lane) {
    const int nblk = N / 32, kb = item / nblk, nb = item % nblk;
    transpose_item(W, N, WT, K, 64 * kb, 32 * nb, 32 * nb, scr, lane);
}
__device__ __forceinline__ void conv_w2(const float* W, unsigned char* WT, int item, LAS float* scr, int lane) {
    const int nblk = D / 32, kb = item / nblk, nb = item % nblk;
    transpose_item8(W, D, WT, DFF, 64 * kb, 32 * nb, 32 * nb, WSC2, scr, lane);
}

struct Params {
    const float* in[31];
    float* out;
    unsigned char* ws;
    int l_lo, l_hi, ph_lo, ph_hi, bar_region, slab_cap;
};

template <int MODE, bool XIN32>
__device__ __forceinline__ void row_issue(int m, const void* xin_ctx, const void* xin_lat, const bf16* Y, const bf16* yslot, int2 sl, int lane, f32x4 (&x)[4], u32x2 (&xb)[4], u32x2 (&ya)[4], u32x2 (&yb)[4]) {
    if (XIN32) { const float* xi = (m < MC) ? (const float*)xin_ctx + (size_t)m * D : (const float*)xin_lat + (size_t)(m - MC) * D;
#pragma unroll
        for (int j = 0; j < 4; ++j) x[j] = __builtin_nontemporal_load((const f32x4*)(xi + 4 * lane + 256 * j)); }
    else { const bf16* xi = (m < MC) ? (const bf16*)xin_ctx + (size_t)m * D : (const bf16*)xin_lat + (size_t)(m - MC) * D;
#pragma unroll
        for (int j = 0; j < 4; ++j) xb[j] = __builtin_nontemporal_load((const u32x2*)(xi + 4 * lane + 256 * j)); }
    if (MODE == 1) { const bf16* yr = Y + (size_t)m * D;
#pragma unroll
        for (int j = 0; j < 4; ++j) ya[j] = __builtin_nontemporal_load((const u32x2*)(yr + 4 * lane + 256 * j)); }
    if (MODE == 2) { const bf16* y1 = yslot + (size_t)sl.x * D; const bf16* y2 = yslot + (size_t)sl.y * D;
#pragma unroll
        for (int j = 0; j < 4; ++j) { ya[j] = __builtin_nontemporal_load((const u32x2*)(y1 + 4 * lane + 256 * j)); yb[j] = __builtin_nontemporal_load((const u32x2*)(y2 + 4 * lane + 256 * j)); } }
}
template <int MODE, bool ROUTER, bool WRITE_H, bool XIN32, bool XOUT32>
__device__ __forceinline__ void row_phase(float* SA, const void* xin_ctx, const void* xin_lat, void* xo_ctx, void* xo_lat,
                                          const bf16* Y, const bf16* yslot, const uint4* tokinfo, const int2* tokslot,
                                          const float* gpost, const float* gpre, const float* modl, int o_gt, int o_sh, int o_sc,
                                          bf16* Aout, const float* router_w, uint4* tokinfo_out, LAS unsigned* lcnt, unsigned* gcnt,
                                          int m_lo, int m_hi, int G, int bid, int wave, int lane, int tid, LAS unsigned char* rw_lds = nullptr) {
    const int nw = G * NWAVES, gw = bid * NWAVES + wave;
    const int per = (m_hi - m_lo) / nw;
    const int mbase = m_lo + gw * per;
    f32x4 gq[4], gp[4];
#pragma unroll
    for (int j = 0; j < 4; ++j) { gp[j] = *(const f32x4*)(gpre + 4 * lane + 256 * j); if (MODE != 0) gq[j] = *(const f32x4*)(gpost + 4 * lane + 256 * j); else gq[j] = (f32x4){0.f, 0.f, 0.f, 0.f}; }
    LAS float* RW = (LAS float*)rw_lds;
    if (ROUTER) { if (tid < 8) lcnt[tid] = 0u;
        for (int i = tid; i < D * 8; i += NTHR) RW[(i & 7) * D + (i >> 3)] = router_w[i];
        __syncthreads(); }
    int mrow_cur = -1; f32x4 vgt[4], vsh[4], vsc[4];
#pragma unroll
    for (int j = 0; j < 4; ++j) { vgt[j] = (f32x4){0.f, 0.f, 0.f, 0.f}; vsh[j] = vgt[j]; vsc[j] = vgt[j]; }
    f32x4 xn[4]; u32x2 xbn[4], yan[4], ybn[4]; int2 sl_n2 = make_int2(0, 0); uint4 ti_c = make_uint4(0, 0, 0, 0), ti_n = ti_c;
#pragma unroll
    for (int j = 0; j < 4; ++j) { xn[j] = (f32x4){0.f, 0.f, 0.f, 0.f}; yan[j] = (u32x2){0u, 0u}; ybn[j] = yan[j]; xbn[j] = yan[j]; }
    { int2 sl0 = make_int2(0, 0); if (MODE == 2) { sl0 = tokslot[mbase]; ti_n = tokinfo[mbase]; if (per > 1) sl_n2 = tokslot[mbase + 1]; }
      row_issue<MODE, XIN32>(mbase, xin_ctx, xin_lat, Y, yslot, sl0, lane, xn, xbn, yan, ybn); }
    for (int i = 0; i < per; ++i) {
        const int m = mbase + i;
        f32x4 x[4]; u32x2 ya[4], yb[4];
#pragma unroll
        for (int j = 0; j < 4; ++j) { if (XIN32) x[j] = xn[j]; else x[j] = (f32x4){bf_lo(xbn[j].x), bf_hi(xbn[j].x), bf_lo(xbn[j].y), bf_hi(xbn[j].y)}; ya[j] = yan[j]; yb[j] = ybn[j]; }
        ti_c = ti_n;
        if (i + 1 < per) { const int2 sl1 = sl_n2; if (MODE == 2) { ti_n = tokinfo[m + 1]; if (i + 2 < per) sl_n2 = tokslot[m + 2]; }
            row_issue<MODE, XIN32>(m + 1, xin_ctx, xin_lat, Y, yslot, sl1, lane, xn, xbn, yan, ybn); }
        const bool isctx = m < MC;
        const int mrow = isctx ? 32 : ((m - MC) >> 11);
        if (mrow != mrow_cur) { mrow_cur = mrow; const float* mp = modl + (size_t)mrow * 6144;
#pragma unroll
            for (int j = 0; j < 4; ++j) { if (MODE != 0) vgt[j] = *(const f32x4*)(mp + o_gt + 4 * lane + 256 * j); vsh[j] = *(const f32x4*)(mp + o_sh + 4 * lane + 256 * j); vsc[j] = *(const f32x4*)(mp + o_sc + 4 * lane + 256 * j); } }
        if (MODE != 0) {
            f32x4 y[4];
            if (MODE == 1) {
#pragma unroll
                for (int j = 0; j < 4; ++j) y[j] = (f32x4){bf_lo(ya[j].x), bf_hi(ya[j].x), bf_lo(ya[j].y), bf_hi(ya[j].y)};
            } else {
                const float w1 = __uint_as_float(ti_c.z), w2 = __uint_as_float(ti_c.w);
#pragma unroll
                for (int j = 0; j < 4; ++j) y[j] = (f32x4){w1 * bf_lo(ya[j].x) + w2 * bf_lo(yb[j].x), w1 * bf_hi(ya[j].x) + w2 * bf_hi(yb[j].x), w1 * bf_lo(ya[j].y) + w2 * bf_lo(yb[j].y), w1 * bf_hi(ya[j].y) + w2 * bf_hi(yb[j].y)};
            }
            float ss = 0.f;
#pragma unroll
            for (int j = 0; j < 4; ++j) ss += (y[j][0] * y[j][0] + y[j][1] * y[j][1]) + (y[j][2] * y[j][2] + y[j][3] * y[j][3]);
            const float rs = 1.0f / sqrtf(wave_sum(ss) * (1.0f / D) + EPS);
#pragma unroll
            for (int j = 0; j < 4; ++j) x[j] = x[j] + vgt[j] * (y[j] * rs * gq[j]);
            if (XOUT32) { float* xo = isctx ? (float*)xo_ctx + (size_t)m * D : (float*)xo_lat + (size_t)(m - MC) * D;
#pragma unroll
                for (int j = 0; j < 4; ++j) __builtin_nontemporal_store(x[j], (f32x4*)(xo + 4 * lane + 256 * j)); }
            else { bf16* xo = isctx ? (bf16*)xo_ctx + (size_t)m * D : (bf16*)xo_lat + (size_t)(m - MC) * D;
#pragma unroll
                for (int j = 0; j < 4; ++j) { u32x2 w; w.x = pk2(x[j][0], x[j][1]); w.y = pk2(x[j][2], x[j][3]); __builtin_nontemporal_store(w, (u32x2*)(xo + 4 * lane + 256 * j));
                    x[j] = (f32x4){bf_lo(w.x), bf_hi(w.x), bf_lo(w.y), bf_hi(w.y)}; } }
        }
        if (WRITE_H) {
            float s2 = 0.f;
#pragma unroll
            for (int j = 0; j < 4; ++j) s2 += (x[j][0] * x[j][0] + x[j][1] * x[j][1]) + (x[j][2] * x[j][2] + x[j][3] * x[j][3]);
            const float r2 = 1.0f / sqrtf(wave_sum(s2) * (1.0f / D) + EPS);
            f32x4 h[4]; float amax = 0.f;
#pragma unroll
            for (int j = 0; j < 4; ++j) { h[j] = (x[j] * r2 * gp[j]) * (vsc[j] + 1.0f) + vsh[j]; amax = fmaxf(fmaxf(amax, fmaxf(fabsf(h[j][0]), fabsf(h[j][1]))), fmaxf(fabsf(h[j][2]), fabsf(h[j][3]))); }
            amax = wave_max(amax);
            const float qinv = amax > 0.f ? 127.0f / amax : 0.f;
            if (lane == 0) SA[m] = amax * (1.0f / 127.0f);
#pragma unroll
            for (int j = 0; j < 4; ++j) { const unsigned q0 = (unsigned)(int)rintf(h[j][0] * qinv) & 0xffu, q1 = (unsigned)(int)rintf(h[j][1] * qinv) & 0xffu, q2 = (unsigned)(int)rintf(h[j][2] * qinv) & 0xffu, q3 = (unsigned)(int)rintf(h[j][3] * qinv) & 0xffu;
                __builtin_nontemporal_store(q0 | (q1 << 8) | (q2 << 16) | (q3 << 24), (unsigned*)((unsigned char*)Aout + (size_t)m * D + 4 * lane + 256 * j)); }
            if (ROUTER) {
                float lg[8];
#pragma unroll
                for (int e = 0; e < 8; ++e) lg[e] = 0.f;
#pragma unroll
                for (int j = 0; j < 4; ++j)
#pragma unroll
                    for (int e = 0; e < 8; ++e) { const f32x4 r = *(const LAS f32x4*)(RW + e * D + 4 * lane + 256 * j);
                        lg[e] += (h[j][0] * r[0] + h[j][1] * r[1]) + (h[j][2] * r[2] + h[j][3] * r[3]); }
#pragma unroll
                for (int e = 0; e < 8; ++e) lg[e] = wave_sum(lg[e]);
                int e1 = 0; float l1 = lg[0];
#pragma unroll
                for (int e = 1; e < 8; ++e) if (lg[e] > l1) { l1 = lg[e]; e1 = e; }
                int e2 = -1; float l2 = -3.0e38f;
#pragma unroll
                for (int e = 0; e < 8; ++e) if (e != e1 && lg[e] > l2) { l2 = lg[e]; e2 = e; }
                const float w1 = 1.0f / (1.0f + expf(l2 - l1)), w2 = 1.0f - w1;
                if (lane == 0) { tokinfo_out[m] = make_uint4((unsigned)e1, (unsigned)e2, __float_as_uint(w1), __float_as_uint(w2));
                    __hip_atomic_fetch_add(lcnt + e1, 1u, __ATOMIC_RELAXED, __HIP_MEMORY_SCOPE_WORKGROUP); __hip_atomic_fetch_add(lcnt + e2, 1u, __ATOMIC_RELAXED, __HIP_MEMORY_SCOPE_WORKGROUP); }
            }
        }
    }
    if (ROUTER) {
        __syncthreads();
        if (tid < 8) { const unsigned c = lcnt[tid]; if (c) __hip_atomic_fetch_add(gcnt + tid, c, __ATOMIC_RELAXED, __HIP_MEMORY_SCOPE_AGENT); }
    }
}

__device__ __forceinline__ void lru_blk(int half, int s, int& isctx, int& bi) { isctx = s < 4; bi = (half == 0) ? (isctx ? s : s - 4) : (isctx ? 3 - s : 35 - s); }
__device__ __forceinline__ void lru_unit(LAS unsigned char* lds, const bf16* P, bf16* CAT, bf16* TL, const bf16* WaT, const bf16* WxT,
                                         const float* ba, const float* bx, const float* lam, const float* convw, const float* convb,
                                         int b, int hh, bool want_ctx, int tid) {
    const int wave = __builtin_amdgcn_readfirstlane(tid >> 6), lane = tid & 63, fr = lane & 15, fg = lane >> 4;
    const int half = wave >> 2, w4 = wave & 3, tidh = tid & 255;
    LAS unsigned char* hb = lds + half * 59136;
    LAS bf16* Xr = (LAS bf16*)hb;
    LAS bf16* Xc = (LAS bf16*)(hb + 17152);
    LAS f32x2* AU = (LAS f32x2*)(hb + 17152 + 9216);
    LAS float* CW = (LAS float*)(lds + 118272);
    if (tid < 320) CW[tid] = (tid < 256) ? convw[(tid >> 6) * 384 + hh * 64 + (tid & 63)] : convb[hh * 64 + (tid - 256)];
    const bf16* wa = WaT + (size_t)(half * 6 + hh) * 4096; const bf16* wx = WxT + (size_t)(half * 6 + hh) * 4096;
    bf16x8 Ba[4][2], Bx[4][2]; float bav[4], bxv[4], spv[4];
#pragma unroll
    for (int nt = 0; nt < 4; ++nt) {
#pragma unroll
        for (int ks = 0; ks < 2; ++ks) { Ba[nt][ks] = ld16g(wa + (nt * 16 + fr) * 64 + ks * 32 + fg * 8); Bx[nt][ks] = ld16g(wx + (nt * 16 + fr) * 64 + ks * 32 + fg * 8); }
        const int ch = (half * 6 + hh) * 64 + nt * 16 + fr;
        bav[nt] = -1.44269504f * ba[ch]; bxv[nt] = -1.44269504f * bx[ch]; const float lm = lam[ch]; spv[nt] = -8.0f * 1.44269504f * ((lm > 15.f) ? expf(-lm) : log1pf(expf(-lm)));
    }
    float hstate = 0.f;
    u32x4 rr[3];
#define LRU_RAW_LOAD(ISCTX, BI) do { const int seqlen_ = (ISCTX) ? CTXL : SEQ; const size_t m0_ = (ISCTX) ? (size_t)b * CTXL : (size_t)MC + (size_t)b * SEQ; \
        _Pragma("unroll") for (int k = 0; k < 3; ++k) { const int q = tidh + 256 * k, tp = (BI) * 64 - 2 + (q >> 3); rr[k] = (u32x4){0u, 0u, 0u, 0u}; \
            if (q < 536 && tp >= 0 && tp < seqlen_) rr[k] = *(const u32x4*)(P + (m0_ + tp) * INW + hh * 64 + (q & 7) * 8); } } while (0)
#define LRU_RAW_STORE(BUF) do { _Pragma("unroll") for (int k = 0; k < 3; ++k) { const int q = tidh + 256 * k; if (q < 536) *(LAS u32x4*)(Xr + (BUF) * 4288 + q * 8) = rr[k]; } } while (0)
    { int ic, bb; lru_blk(half, 0, ic, bb); LRU_RAW_LOAD(ic, bb); LRU_RAW_STORE(0); }
    __syncthreads();
    for (int s = 0; s < 36; ++s) {
        int isctx, bi; lru_blk(half, s, isctx, bi);
        const size_t m0 = isctx ? (size_t)b * CTXL : (size_t)MC + (size_t)b * SEQ;
        if (s + 1 < 36) { int ic, bb; lru_blk(half, s + 1, ic, bb); LRU_RAW_LOAD(ic, bb); }
        { const int pos = tidh >> 2, cq = tidh & 3; f32x2 acc[8]; const LAS bf16* xr = Xr + (s & 1) * 4288;
#pragma unroll
            for (int c = 0; c < 8; ++c) acc[c] = *(const LAS f32x2*)(CW + 256 + cq * 16 + 2 * c);
#pragma unroll
            for (int j = 0; j < 4; ++j) { const u32x4 a = *(const LAS u32x4*)(xr + (pos + j) * 64 + cq * 16), c2 = *(const LAS u32x4*)(xr + (pos + j) * 64 + cq * 16 + 8);
                const unsigned ww[8] = {a.x, a.y, a.z, a.w, c2.x, c2.y, c2.z, c2.w};
#pragma unroll
                for (int q = 0; q < 8; ++q) acc[q] += *(const LAS f32x2*)(CW + j * 64 + cq * 16 + 2 * q) * (f32x2){bf_lo(ww[q]), bf_hi(ww[q])}; }
            u32x4 o0, o1; o0.x = pk2(acc[0].x, acc[0].y); o0.y = pk2(acc[1].x, acc[1].y); o0.z = pk2(acc[2].x, acc[2].y); o0.w = pk2(acc[3].x, acc[3].y);
            o1.x = pk2(acc[4].x, acc[4].y); o1.y = pk2(acc[5].x, acc[5].y); o1.z = pk2(acc[6].x, acc[6].y); o1.w = pk2(acc[7].x, acc[7].y);
            *(LAS u32x4*)(Xc + pos * 72 + cq * 16) = o0; *(LAS u32x4*)(Xc + pos * 72 + cq * 16 + 8) = o1; }
        __syncthreads();
        const int nb_half = isctx ? 2 : 16; const bool second = (half == 0) ? (bi >= nb_half) : (bi < nb_half);
        const bool emit = want_ctx || !isctx;
        const int opos = tidh >> 2, ocq = tidh & 3; const size_t om = m0 + bi * 64 + opos;
        bf16* tp = TL + om * 384 + hh * 64 + ocq * 16;
        u32x4 t0 = (u32x4){0u, 0u, 0u, 0u}, t1 = t0, y0 = t0, y1 = t0;
        if (emit && second) { t0 = *(const u32x4*)tp; t1 = *(const u32x4*)(tp + 8); const bf16* lp = P + om * INW + 384 + hh * 64 + ocq * 16; y0 = *(const u32x4*)lp; y1 = *(const u32x4*)(lp + 8); }
        { const bf16x8 A0 = ld16l(Xc + (w4 * 16 + fr) * 72 + fg * 8), A1 = ld16l(Xc + (w4 * 16 + fr) * 72 + 32 + fg * 8);
#pragma unroll
            for (int nt = 0; nt < 4; ++nt) {
                f32x4 ga = (f32x4){0.f, 0.f, 0.f, 0.f}, gx = ga;
                ga = mfma16(A0, Ba[nt][0], ga); ga = mfma16(A1, Ba[nt][1], ga); gx = mfma16(A0, Bx[nt][0], gx); gx = mfma16(A1, Bx[nt][1], gx);
#pragma unroll
                for (int pr = 0; pr < 2; ++pr) { const int pos = w4 * 16 + fg * 4 + 2 * pr, ch = nt * 16 + fr;
                    const f32x2 ta = (f32x2){ga[2 * pr], ga[2 * pr + 1]} * (f32x2){-1.44269504f, -1.44269504f} + (f32x2){bav[nt], bav[nt]};
                    const f32x2 tx = (f32x2){gx[2 * pr], gx[2 * pr + 1]} * (f32x2){-1.44269504f, -1.44269504f} + (f32x2){bxv[nt], bxv[nt]};
                    const f32x2 e1 = (f32x2){fexp2(ta.x), fexp2(ta.y)} + (f32x2){1.0f, 1.0f}, e2 = (f32x2){fexp2(tx.x), fexp2(tx.y)} + (f32x2){1.0f, 1.0f};
                    const f32x2 rg = (f32x2){__builtin_amdgcn_rcpf(e1.x), __builtin_amdgcn_rcpf(e1.y)}, ig = (f32x2){__builtin_amdgcn_rcpf(e2.x), __builtin_amdgcn_rcpf(e2.y)};
                    const f32x2 la2 = rg * (f32x2){spv[nt], spv[nt]};
                    const f32x2 a = (f32x2){fexp2(la2.x), fexp2(la2.y)};
                    const f32x2 om1 = (f32x2){1.0f, 1.0f} - a * a;
                    const f32x2 xc = (f32x2){__uint_as_float(((unsigned)Xc[pos * 72 + ch]) << 16), __uint_as_float(((unsigned)Xc[(pos + 1) * 72 + ch]) << 16)};
                    const f32x2 u = (f32x2){__builtin_amdgcn_sqrtf(om1.x), __builtin_amdgcn_sqrtf(om1.y)} * (ig * xc);
                    AU[pos * 64 + ch] = (f32x2){a.x, u.x}; AU[(pos + 1) * 64 + ch] = (f32x2){a.y, u.y}; } } }
        __syncthreads();
        if (w4 == 0) {
            LAS f32x2* aup = AU + lane;
#define LRU_SCAN(POS) do { \
                _Pragma("unroll") for (int bb = 0; bb < 4; ++bb) { f32x2 cu[16]; float hs[16]; \
                    _Pragma("unroll") for (int k = 0; k < 16; ++k) cu[k] = aup[(POS(16 * bb + k)) * 64]; \
                    _Pragma("unroll") for (int k = 0; k < 16; ++k) { hstate = cu[k].x * hstate + cu[k].y; hs[k] = hstate; } \
                    _Pragma("unroll") for (int k = 0; k < 16; ++k) ((LAS float*)(aup + (POS(16 * bb + k)) * 64))[1] = hs[k]; } } while (0)
#define LRU_POS_F(k) (k)
#define LRU_POS_B(k) (63 - (k))
            if (half == 0) LRU_SCAN(LRU_POS_F); else LRU_SCAN(LRU_POS_B);
#undef LRU_SCAN
#undef LRU_POS_F
#undef LRU_POS_B
        }
        if (s + 1 < 36) LRU_RAW_STORE((s + 1) & 1);
        __syncthreads();
        if (emit) {
            float hv[16];
#pragma unroll
            for (int c = 0; c < 16; ++c) hv[c] = AU[opos * 64 + ocq * 16 + c].y;
            if (!second) {
                u32x4 o0, o1; o0.x = pk2(hv[0], hv[1]); o0.y = pk2(hv[2], hv[3]); o0.z = pk2(hv[4], hv[5]); o0.w = pk2(hv[6], hv[7]);
                o1.x = pk2(hv[8], hv[9]); o1.y = pk2(hv[10], hv[11]); o1.z = pk2(hv[12], hv[13]); o1.w = pk2(hv[14], hv[15]);
                *(u32x4*)tp = o0; *(u32x4*)(tp + 8) = o1;
            } else {
                const unsigned tw[8] = {t0.x, t0.y, t0.z, t0.w, t1.x, t1.y, t1.z, t1.w}, yw[8] = {y0.x, y0.y, y0.z, y0.w, y1.x, y1.y, y1.z, y1.w};
                float ov[16];
#pragma unroll
                for (int q = 0; q < 8; ++q) { ov[2 * q] = gelu_t(bf_lo(yw[q])) * (hv[2 * q] + bf_lo(tw[q])); ov[2 * q + 1] = gelu_t(bf_hi(yw[q])) * (hv[2 * q + 1] + bf_hi(tw[q])); }
                unsigned char* op = (unsigned char*)CAT + om * D + hh * 64 + ocq * 16;
                *(u32x4*)op = (u32x4){pk4f8(ov[0], ov[1], ov[2], ov[3], CSC), pk4f8(ov[4], ov[5], ov[6], ov[7], CSC), pk4f8(ov[8], ov[9], ov[10], ov[11], CSC), pk4f8(ov[12], ov[13], ov[14], ov[15], CSC)};
            }
        }
    }
#undef LRU_RAW_LOAD
#undef LRU_RAW_STORE
    __syncthreads();
}

__device__ __forceinline__ void retp1_unit(LAS unsigned char* lds, const bf16* P, bf16* SB, int b, int hh, float lgf2, float lgb2, bool want_ctx, int tid) {
    const int wave = __builtin_amdgcn_readfirstlane(tid >> 6), lane = tid & 63, fr = lane & 15, fg = lane >> 4;
    const int half = wave >> 2, w4 = wave & 3, tidh = tid & 255;
    const int jp = tidh >> 2, part = tidh & 3;
    const float lg2 = half ? lgb2 : lgf2; const float dec = fexp2(128.0f * lg2);
    const float wk0 = half ? fexp2((float)(2 * jp) * lg2) : fexp2((float)(127 - 2 * jp) * lg2), wk1 = half ? fexp2((float)(2 * jp + 1) * lg2) : fexp2((float)(126 - 2 * jp) * lg2);
    u32x4 ka[2], kb[2], va[2], vb[2];
#define RP1_CK(S) ((half == 0) ? (S) : ((S) < 2 ? 1 - (S) : 19 - (S)))
#define RP1_M0(CK) (((CK) < 2) ? (size_t)b * CTXL + (CK) * 128 : (size_t)MC + (size_t)b * SEQ + ((CK) - 2) * 128)
#define RP1_LOAD(S) do { const int ck_ = RP1_CK(S); const size_t m_ = RP1_M0(ck_) + 2 * jp; \
        const bf16* kp = P + m_ * INW + 1152 + hh * 64 + part * 16; const bf16* vp = P + m_ * INW + 1536 + hh * 64 + part * 16; \
        ka[0] = *(const u32x4*)kp; ka[1] = *(const u32x4*)(kp + 8); kb[0] = *(const u32x4*)(kp + INW); kb[1] = *(const u32x4*)(kp + INW + 8); \
        va[0] = *(const u32x4*)vp; va[1] = *(const u32x4*)(vp + 8); vb[0] = *(const u32x4*)(vp + INW); vb[1] = *(const u32x4*)(vp + INW + 8); } while (0)
#define RP1_PARK(BUF) do { LAS bf16* KT_ = (LAS bf16*)(lds + ((BUF) * 2 + half) * 34816); LAS bf16* VT_ = KT_ + 64 * 136; \
        _Pragma("unroll") for (int q = 0; q < 2; ++q) { const unsigned k0w[4] = {ka[q].x, ka[q].y, ka[q].z, ka[q].w}, k1w[4] = {kb[q].x, kb[q].y, kb[q].z, kb[q].w}, v0w[4] = {va[q].x, va[q].y, va[q].z, va[q].w}, v1w[4] = {vb[q].x, vb[q].y, vb[q].z, vb[q].w}; \
            _Pragma("unroll") for (int t = 0; t < 4; ++t) { const int d = part * 16 + 8 * q + 2 * t; \
                *(LAS unsigned*)(KT_ + d * 136 + 2 * jp) = pk2(bf_lo(k0w[t]) * wk0, bf_lo(k1w[t]) * wk1); *(LAS unsigned*)(KT_ + (d + 1) * 136 + 2 * jp) = pk2(bf_hi(k0w[t]) * wk0, bf_hi(k1w[t]) * wk1); \
                *(LAS unsigned*)(VT_ + d * 136 + 2 * jp) = (v0w[t] & 0xffffu) | (v1w[t] << 16); *(LAS unsigned*)(VT_ + (d + 1) * 136 + 2 * jp) = (v0w[t] >> 16) | (v1w[t] & 0xffff0000u); } } } while (0)
    f32x4 st[4];
#pragma unroll
    for (int nt = 0; nt < 4; ++nt) st[nt] = (f32x4){0.f, 0.f, 0.f, 0.f};
    RP1_LOAD(0); RP1_PARK(0);
    __syncthreads();
    for (int s = 0; s < 18; ++s) {
        if (s + 1 < 18) RP1_LOAD(s + 1);
        const int ck = RP1_CK(s);
        if (want_ctx || ck >= 2) { bf16* sp = SB + ((((size_t)b * 6 + hh) * 2 + half) * 18 + ck) * 4096;
#pragma unroll
            for (int nt = 0; nt < 4; ++nt) { u32x2 w; w.x = pk2(st[nt][0], st[nt][1]); w.y = pk2(st[nt][2], st[nt][3]); *(u32x2*)(sp + (nt * 16 + fr) * 64 + w4 * 16 + fg * 4) = w; } }
        const LAS bf16* KT = (const LAS bf16*)(lds + ((s & 1) * 2 + half) * 34816); const LAS bf16* VT = KT + 64 * 136;
#pragma unroll
        for (int nt = 0; nt < 4; ++nt) st[nt] = st[nt] * dec;
#pragma unroll
        for (int ks = 0; ks < 4; ++ks) { const bf16x8 af = ld16l(KT + (w4 * 16 + fr) * 136 + ks * 32 + fg * 8);
#pragma unroll
            for (int nt = 0; nt < 4; ++nt) { const bf16x8 bfr = ld16l(VT + (nt * 16 + fr) * 136 + ks * 32 + fg * 8); st[nt] = mfma16(af, bfr, st[nt]); } }
        if (s + 1 < 18) RP1_PARK((s + 1) & 1);
        __syncthreads();
    }
#undef RP1_CK
#undef RP1_M0
#undef RP1_LOAD
#undef RP1_PARK
}

__device__ __forceinline__ void gmlp_unit(LAS unsigned char* lds, const bf16* P, bf16* CAT, const bf16* WS, const float* WSUM, const float* lng, const float* lnb, const float* bs, int b, int ck, int tid) {
    const int wave = __builtin_amdgcn_readfirstlane(tid >> 6), lane = tid & 63, fr = lane & 15, fg = lane >> 4;
    const size_t m0 = (ck < 2) ? (size_t)b * CTXL + ck * 128 : (size_t)MC + (size_t)b * SEQ + (ck - 2) * 128;
    LAS bf16* VnT = (LAS bf16*)lds;
    LAS float* LN = (LAS float*)(lds + 69632);
    const int g2 = wave >> 1, ih = wave & 1; const bf16* wsg = WS + (size_t)g2 * 16384;
    bf16x8 wf[4][4]; float wsv[4], bsv[4];
#pragma unroll
    for (int it = 0; it < 4; ++it) { const int irow = ih * 64 + it * 16 + fr;
#pragma unroll
        for (int ks = 0; ks < 4; ++ks) wf[it][ks] = ld16g(wsg + irow * 128 + ks * 32 + fg * 8);
        wsv[it] = WSUM[g2 * 128 + irow]; bsv[it] = bs[g2 * 128 + irow]; }
    LN[tid] = (tid < 256) ? lng[tid] : lnb[tid - 256];
    { const int j = tid >> 2, g = tid & 3; const bf16* zp = P + (m0 + j) * INW + 2560 + g * 64; float v[64];
#pragma unroll
        for (int q = 0; q < 8; ++q) { const u32x4 w = *(const u32x4*)(zp + 8 * q); const unsigned ww[4] = {w.x, w.y, w.z, w.w};
#pragma unroll
            for (int t = 0; t < 4; ++t) { v[8 * q + 2 * t] = gelu_t(bf_lo(ww[t])); v[8 * q + 2 * t + 1] = gelu_t(bf_hi(ww[t])); } }
        float s = 0.f;
#pragma unroll
        for (int c = 0; c < 64; ++c) s += v[c];
        const float mu = s * (1.0f / 64.0f); float q2 = 0.f;
#pragma unroll
        for (int c = 0; c < 64; ++c) { v[c] -= mu; q2 += v[c] * v[c]; }
        const float rs = 1.0f / sqrtf(q2 * (1.0f / 64.0f) + EPS);
#pragma unroll
        for (int c = 0; c < 64; c += 2) { const unsigned w = pk2(v[c] * rs, v[c + 1] * rs);
            VnT[(g * 64 + c) * 136 + j] = (bf16)(w & 0xffffu); VnT[(g * 64 + c + 1) * 136 + j] = (bf16)(w >> 16); } }
    __syncthreads();
#pragma unroll
    for (int it = 0; it < 4; ++it) { const int irow = ih * 64 + it * 16 + fr; const size_t m = m0 + irow;
        u32x2 zu[4];
#pragma unroll
        for (int ct = 0; ct < 4; ++ct) zu[ct] = *(const u32x2*)(P + m * INW + 2304 + g2 * 64 + ct * 16 + fg * 4);
        f32x4 acc[4];
#pragma unroll
        for (int ct = 0; ct < 4; ++ct) { acc[ct] = (f32x4){0.f, 0.f, 0.f, 0.f};
#pragma unroll
            for (int ks = 0; ks < 4; ++ks) { const bf16x8 vf = ld16l(VnT + (g2 * 64 + ct * 16 + fr) * 136 + ks * 32 + fg * 8); acc[ct] = mfma16(vf, wf[it][ks], acc[ct]); } }
#pragma unroll
        for (int ct = 0; ct < 4; ++ct) { const int c = g2 * 64 + ct * 16 + fg * 4;
            const f32x4 gv = *(const LAS f32x4*)(LN + c), bv = *(const LAS f32x4*)(LN + 256 + c);
            const f32x4 sv = acc[ct] * gv + bv * wsv[it] + bsv[it];
            *(unsigned*)((unsigned char*)CAT + m * D + 768 + c) = pk4f8(gelu_t(bf_lo(zu[ct].x)) * sv[0], gelu_t(bf_hi(zu[ct].x)) * sv[1], gelu_t(bf_lo(zu[ct].y)) * sv[2], gelu_t(bf_hi(zu[ct].y)) * sv[3], CSC); } }
    __syncthreads();
}

__device__ __forceinline__ void retp2_phase(LAS unsigned char* lds, const bf16* P, const bf16* SB, bf16* CAT, const float* theta, bool want_ctx, int G, int bid, int tid) {
    const int wave = __builtin_amdgcn_readfirstlane(tid >> 6), lane = tid & 63, fr = lane & 15, fg = lane >> 4;
    const int nck = want_ctx ? 18 : 16, ck0 = want_ctx ? 0 : 2, NU = NB * nck * 6;
    const int lj = tid >> 2, lpart = tid & 3;
    u32x4 k0, k1, v0, v1;
#define RP2_DECODE(ID, B_, CK_, HH_) const int HH_ = (ID) % 6, CK_ = ck0 + ((ID) / 6) % nck, B_ = (ID) / (6 * nck)
#define RP2_M0(B_, CK_) (((CK_) < 2) ? (size_t)(B_) * CTXL + (CK_) * 128 : (size_t)MC + (size_t)(B_) * SEQ + ((CK_) - 2) * 128)
#define RP2_LOAD(ID) do { RP2_DECODE(ID, b_, ck_, hh_); const size_t m0_ = RP2_M0(b_, ck_); \
        const bf16* kp = P + (m0_ + lj) * INW + 1152 + hh_ * 64 + lpart * 16; const bf16* vp = P + (m0_ + lj) * INW + 1536 + hh_ * 64 + lpart * 16; \
        k0 = *(const u32x4*)kp; k1 = *(const u32x4*)(kp + 8); v0 = *(const u32x4*)vp; v1 = *(const u32x4*)(vp + 8); } while (0)
#define RP2_PARK(BUF) do { LAS bf16* Ks_ = (LAS bf16*)(lds + (BUF) * 35840); LAS bf16* VT_ = (LAS bf16*)(lds + (BUF) * 35840 + 18432); \
        *(LAS u32x4*)(Ks_ + lj * 72 + lpart * 16) = k0; *(LAS u32x4*)(Ks_ + lj * 72 + lpart * 16 + 8) = k1; \
        const unsigned vw_[8] = {v0.x, v0.y, v0.z, v0.w, v1.x, v1.y, v1.z, v1.w}; \
        _Pragma("unroll") for (int q = 0; q < 8; ++q) { const int e = lpart * 16 + 2 * q; VT_[e * 136 + lj] = (bf16)(vw_[q] & 0xffffu); VT_[(e + 1) * 136 + lj] = (bf16)(vw_[q] >> 16); } } while (0)
    LAS float* LG = (LAS float*)(lds + 2 * 35840);
    if (tid < 12) { const float t = theta[tid]; LG[tid] = -1.44269504f * ((t < -15.f) ? -t : log1pf(expf(-t))); }
    const int irow = wave * 16 + fr;
    bf16x8 qn0 = {}, qn1 = {};
#define RP2_LOADQ(ID) do { RP2_DECODE(ID, b_, ck_, hh_); const bf16* qp_ = P + (RP2_M0(b_, ck_) + irow) * INW + 768 + hh_ * 64 + fg * 8; qn0 = ld16g(qp_); qn1 = ld16g(qp_ + 32); } while (0)
    int id = bid, buf = 0;
    if (id < NU) { RP2_LOAD(id); RP2_LOADQ(id); RP2_PARK(0); }
    __syncthreads();
    for (; id < NU; id += G, buf ^= 1) {
        const int nid = id + G;
        const bf16x8 qf0 = qn0, qf1 = qn1;
        if (nid < NU) { RP2_LOAD(nid); RP2_LOADQ(nid); }
        RP2_DECODE(id, b, ck, hh);
        const size_t m0 = RP2_M0(b, ck);
        const float lgf2 = LG[hh], lgb2 = LG[6 + hh];
        const LAS bf16* Ks = (const LAS bf16*)(lds + buf * 35840); const LAS bf16* VT = (const LAS bf16*)(lds + buf * 35840 + 18432);
        const size_t mi = m0 + irow;
        const bf16* sf = SB + ((((size_t)b * 6 + hh) * 2 + 0) * 18 + ck) * 4096; const bf16* sb = SB + ((((size_t)b * 6 + hh) * 2 + 1) * 18 + ck) * 4096;
        bf16x8 sff[4][2], sbf[4][2]; u32x2 gw[4];
#pragma unroll
        for (int et = 0; et < 4; ++et) { sff[et][0] = ld16g(sf + (et * 16 + fr) * 64 + fg * 8); sff[et][1] = ld16g(sf + (et * 16 + fr) * 64 + 32 + fg * 8); }
        f32x4 sc[8];
#pragma unroll
        for (int jt = 0; jt < 8; ++jt) { sc[jt] = (f32x4){0.f, 0.f, 0.f, 0.f};
            const bf16x8 kf0 = ld16l(Ks + (jt * 16 + fr) * 72 + fg * 8), kf1 = ld16l(Ks + (jt * 16 + fr) * 72 + 32 + fg * 8);
            sc[jt] = mfma16(kf0, qf0, sc[jt]); sc[jt] = mfma16(kf1, qf1, sc[jt]); }
#pragma unroll
        for (int jt = 0; jt < 8; ++jt)
#pragma unroll
            for (int r = 0; r < 4; ++r) { const int dd = irow - (jt * 16 + fg * 4 + r);
                const float w = dd > 0 ? fexp2((float)dd * lgf2) : (dd < 0 ? fexp2((float)(-dd) * lgb2) : 2.0f); sc[jt][r] *= w; }
#pragma unroll
        for (int et = 0; et < 4; ++et) { sbf[et][0] = ld16g(sb + (et * 16 + fr) * 64 + fg * 8); sbf[et][1] = ld16g(sb + (et * 16 + fr) * 64 + 32 + fg * 8);
            gw[et] = *(const u32x2*)(P + mi * INW + 1920 + hh * 64 + et * 16 + fg * 4); }
        bf16x8 pf[4];
#pragma unroll
        for (int s4 = 0; s4 < 4; ++s4) { u32x4 w; w.x = pk2(sc[2 * s4][0], sc[2 * s4][1]); w.y = pk2(sc[2 * s4][2], sc[2 * s4][3]); w.z = pk2(sc[2 * s4 + 1][0], sc[2 * s4 + 1][1]); w.w = pk2(sc[2 * s4 + 1][2], sc[2 * s4 + 1][3]); pf[s4] = __builtin_bit_cast(bf16x8, w); }
        f32x4 ao[4], af[4], ab[4];
#pragma unroll
        for (int et = 0; et < 4; ++et) { ao[et] = (f32x4){0.f, 0.f, 0.f, 0.f}; af[et] = ao[et]; ab[et] = ao[et];
#pragma unroll
            for (int s4 = 0; s4 < 4; ++s4) { const LAS bf16* vp = VT + (et * 16 + fr) * 136 + s4 * 32 + fg * 4; const u32x2 lo = *(const LAS u32x2*)vp, hi = *(const LAS u32x2*)(vp + 16);
                const bf16x8 vf = __builtin_bit_cast(bf16x8, ((u32x4){lo.x, lo.y, hi.x, hi.y})); ao[et] = mfma16(vf, pf[s4], ao[et]); }
            af[et] = mfma16(sff[et][0], qf0, af[et]); af[et] = mfma16(sff[et][1], qf1, af[et]); ab[et] = mfma16(sbf[et][0], qf0, ab[et]); ab[et] = mfma16(sbf[et][1], qf1, ab[et]); }
        const float sfw = fexp2((float)(irow + 1) * lgf2), sbw = fexp2((float)(128 - irow) * lgb2);
        float ss = 0.f; f32x4 o[4];
#pragma unroll
        for (int et = 0; et < 4; ++et) { o[et] = ao[et] + af[et] * sfw + ab[et] * sbw; ss += (o[et][0] * o[et][0] + o[et][1] * o[et][1]) + (o[et][2] * o[et][2] + o[et][3] * o[et][3]); }
        ss += __shfl_xor(ss, 16); ss += __shfl_xor(ss, 32);
        const float rs = 1.0f / sqrtf(ss * (1.0f / 64.0f) + EPS);
#pragma unroll
        for (int et = 0; et < 4; ++et) { const int c = hh * 64 + et * 16 + fg * 4;
            *(unsigned*)((unsigned char*)CAT + mi * D + 384 + c) = pk4f8(silu_f(bf_lo(gw[et].x)) * o[et][0] * rs, silu_f(bf_hi(gw[et].x)) * o[et][1] * rs, silu_f(bf_lo(gw[et].y)) * o[et][2] * rs, silu_f(bf_hi(gw[et].y)) * o[et][3] * rs, CSC); }
        if (nid < NU) RP2_PARK(buf ^ 1);
        __syncthreads();
    }
#undef RP2_DECODE
#undef RP2_M0
#undef RP2_LOAD
#undef RP2_PARK
#undef RP2_LOADQ
}

__global__ void __launch_bounds__(NTHR, 2) fwd_kernel(Params p) {
    extern __shared__ __attribute__((aligned(16))) unsigned char lds_raw[];
    LAS unsigned char* lds = (LAS unsigned char*)lds_raw;
    volatile LAS unsigned* MISC = (volatile LAS unsigned*)(lds + MISC_OFF);
    const int tid = threadIdx.x;
    const int G = gridDim.x, bid = blockIdx.x;
    if (tid < 128) MISC[tid] = 0u;
    __syncthreads();
    (void)xcd_barrier_post((unsigned*)(p.ws + WS_CTL) + CW_BAR + (size_t)p.bar_region * XCD_BAR_WORDS, MISC);

    const int wave0 = __builtin_amdgcn_readfirstlane(tid >> 6);
#define PHASE_BEGIN \
    int lane_v; asm volatile("v_mbcnt_lo_u32_b32 %0, -1, 0\n\tv_mbcnt_hi_u32_b32 %0, -1, %0" : "=v"(lane_v)); const int lane = lane_v; const int wave = wave0; const int tid = wave0 * 64 + lane; \
    size_t zoff = 0; asm volatile("" : "+s"(zoff)); unsigned char* ws = p.ws + zoff; float* out = p.out + zoff; \
    unsigned* ctl = (unsigned*)(ws + WS_CTL); (void)ctl; (void)lane; (void)wave; (void)out; \
    const float* x_in = p.in[0]; const float* c_in = p.in[1]; const float* ctx_in = p.in[2]; const float* cctx_in = p.in[3]; const float* w_mod = p.in[4]; const float* b_mod = p.in[5]; \
    (void)x_in; (void)c_in; (void)ctx_in; (void)cctx_in; (void)w_mod; (void)b_mod; \
    float* MOD = (float*)(ws + WS_MOD); float* ROPE = (float*)(ws + WS_ROPE); (void)MOD; (void)ROPE; \
    bf16* WAT = (bf16*)(ws + WS_SMALLW); bf16* WXT = WAT + (size_t)DEPTH * 2 * 6 * 4096; bf16* WSB = WXT + (size_t)DEPTH * 2 * 6 * 4096; float* WSUM = (float*)(WSB + (size_t)DEPTH * 4 * 16384); (void)WAT; (void)WXT; (void)WSB; (void)WSUM; \
    uint4* TOKINFO = (uint4*)(ws + WS_TOKINFO); int2* TOKSLOT = (int2*)(ws + WS_TOKSLOT); int* SLOTTOK = (int*)(ws + WS_SLOTTOK); (void)TOKINFO; (void)TOKSLOT; (void)SLOTTOK; \
    bf16* XCTX = (bf16*)(ws + WS_XCTX); bf16* XLAT = (bf16*)(ws + WS_XL); (void)XCTX; (void)XLAT; \
    float* SAB = (float*)(ws + WS_ROPE + 512 * 1024); float* SASLOT = (float*)(ws + WS_TOKINFO + 1280 * 1024); float* SWIN = (float*)(ws + WS_TOKSLOT + 640 * 1024); float* SW13 = SWIN + 4096; (void)SAB; (void)SASLOT; (void)SWIN; (void)SW13; \
    bf16* WIN_T = (bf16*)(ws + WS_W + W_WIN); bf16* WOUT_T = (bf16*)(ws + WS_W + W_WOUT); bf16* WFFN = (bf16*)(ws + WS_W + W_FFN); (void)WIN_T; (void)WOUT_T; (void)WFFN; \
    bf16* ABUF = (bf16*)(ws + WS_A); bf16* RBUF = (bf16*)(ws + WS_R); bf16* BBUF = (bf16*)(ws + WS_B); bf16* YBUF = (bf16*)(ws + WS_Y); (void)ABUF; (void)RBUF; (void)BBUF; (void)YBUF; \
    bf16* SBUF = (bf16*)(ws + WS_Y + Y_SBUF); bf16* TLRU = (bf16*)(ws + WS_Y + Y_TLRU); (void)SBUF; (void)TLRU; \
    bf16* YSLOT = (bf16*)(ws + MOE_YSLOT); bf16* HIDS = (bf16*)(ws + MOE_HID); (void)YSLOT; (void)HIDS; \
    const float* modl = MOD + (size_t)l * 33 * 6144; (void)modl;

#define CONV_NI8(LA, HAS_IN) (((HAS_IN) ? 88 : 0) + ((((LA) & 1) != 0) ? NE : 1) * 176)
#define CONV_NTQ(LA) ((512 + ((((LA) & 1) != 0) ? NE : 1) * 1408) / 4)
#define CONVERT_I8(IT, LA, HAS_IN) do { \
            LAS float* scr = (LAS float*)(lds + wave * 16384); \
            const bool moe_ = (((LA) & 1) != 0); const int jf_ = (LA) >> 1; \
            int r = (IT); const int nin = (HAS_IN) ? 88 : 0; \
            if (r < nin) { conv_i8_item(p.in[10] + (size_t)((LA) + 1) * D * INW, INW, (signed char*)WIN_T, SWIN, 32 * r, 32 * r, scr, lane); } \
            else { r -= nin; const int e = r / 176, rr = r % 176, is3 = rr >= 88 ? 1 : 0, n0 = 32 * (rr % 88); \
                const float* wsrc = is3 ? (moe_ ? p.in[29] + ((size_t)jf_ * NE + e) * D * DFF : p.in[25] + (size_t)jf_ * D * DFF) : (moe_ ? p.in[28] + ((size_t)jf_ * NE + e) * D * DFF : p.in[24] + (size_t)jf_ * D * DFF); \
                unsigned char* w13t = (unsigned char*)WFFN + (moe_ ? (size_t)e * W13_BYTES : 0); \
                conv_i8_item(wsrc, DFF, (signed char*)w13t, SW13 + (size_t)(moe_ ? e : 0) * 2 * DFF, n0, 256 * (n0 >> 7) + 128 * is3 + (n0 & 127), scr, lane); } \
        } while (0)
#define CONVERT_TQ(GQ, LA) do { \
            LAS float* scr = (LAS float*)(lds + wave * 16384); \
            const bool moe_ = (((LA) & 1) != 0); const int jf_ = (LA) >> 1; \
            int r = 4 * (GQ); \
            if (r < 512) { transpose_quad<true>(p.in[11] + (size_t)(LA) * D * D, D, WOUT_T, D, 64 * (r / 32), 32 * (r % 32), 32 * (r % 32), WSCO, scr, lane); } \
            else { r -= 512; const int e = r / 1408, rr = r % 1408; \
                const float* w2 = moe_ ? p.in[30] + ((size_t)jf_ * NE + e) * DFF * D : p.in[26] + (size_t)jf_ * DFF * D; \
                unsigned char* w2t = (unsigned char*)WFFN + (moe_ ? (size_t)NE * W13_BYTES + (size_t)e * W2_BYTES : W13_BYTES); \
                transpose_quad<true>(w2, D, w2t, DFF, 64 * (rr / 32), 32 * (rr % 32), 32 * (rr % 32), WSC2, scr, lane); } \
        } while (0)
#define IN(k) (p.ph_lo <= (k) && (k) < p.ph_hi)
#define BARRIER_NOW() do { XcdBarrier b_; b_.bar = (unsigned*)(p.ws + WS_CTL) + CW_BAR + (size_t)p.bar_region * XCD_BAR_WORDS; b_.x = xb_xcc_id(); b_.st = MISC; xcd_barrier(b_, fresh_t0(wave0)); } while (0)
#define SEAM(l, k) do { if (((k) + 1 < p.ph_hi) || ((l) + 1 < p.l_hi)) { XcdBarrier b_; b_.bar = (unsigned*)(p.ws + WS_CTL) + CW_BAR + (size_t)p.bar_region * XCD_BAR_WORDS; b_.x = xb_xcc_id(); b_.st = MISC; xcd_barrier(b_, fresh_t0(wave0)); } } while (0)

    for (int l = p.l_lo; l < p.l_hi; ++l) {
        const bool want_ctx = l < DEPTH - 1;
        const bool moe = (l & 1) != 0; const int jf = l >> 1;
        if (IN(0) && l == 0) {
            PHASE_BEGIN
            const int gw = bid * NWAVES + wave, NGW = G * NWAVES;
            for (int rep = 0; rep < NREP_P0; ++rep) {
            if (l == 0) {
                {
                LAS bf16* Sb = (LAS bf16*)lds; LAS float* red = (LAS float*)(lds + 99328);
#pragma unroll
                for (int q = 0; q < 17; ++q) { const int o = tid + q * NTHR; if (o >= 33 * 256) break; const int r = o >> 8, k = (o & 255) * 4;
                    const f32x4 v = (r < 32) ? *(const f32x4*)(c_in + r * D + k) : *(const f32x4*)(cctx_in + k);
                    *(LAS u32x2*)(Sb + r * 1032 + k) = (u32x2){pk2(silu_f(v[0]), silu_f(v[1])), pk2(silu_f(v[2]), silu_f(v[3]))}; }
                for (int o = tid; o < 15 * 256; o += NTHR) { const int r = 33 + (o >> 8), k = (o & 255) * 4; *(LAS u32x2*)(Sb + r * 1032 + k) = (u32x2){0u, 0u}; }
                __syncthreads();
                const int ct = wave & 1, kq = wave >> 1, fr0 = lane & 15, fg0 = lane >> 4;
                for (int it = bid; it < DEPTH * 192; it += G) {
                    const int ll = it / 192, cb = it % 192;
                    const float* wp = w_mod + (size_t)ll * D * 6144 + cb * 32 + ct * 16 + fr0 + (size_t)(kq * 256 + fg0 * 8) * 6144;
                    float wv[64];
#pragma unroll
                    for (int ks = 0; ks < 8; ++ks)
#pragma unroll
                        for (int j = 0; j < 8; ++j) wv[ks * 8 + j] = wp[(size_t)(ks * 32 + j) * 6144];
                    f32x4 acc3[3] = {(f32x4){0.f, 0.f, 0.f, 0.f}, (f32x4){0.f, 0.f, 0.f, 0.f}, (f32x4){0.f, 0.f, 0.f, 0.f}};
#pragma unroll
                    for (int ks = 0; ks < 8; ++ks) {
                        const bf16x8 bfrag = __builtin_bit_cast(bf16x8, ((u32x4){pk2(wv[ks * 8 + 0], wv[ks * 8 + 1]), pk2(wv[ks * 8 + 2], wv[ks * 8 + 3]), pk2(wv[ks * 8 + 4], wv[ks * 8 + 5]), pk2(wv[ks * 8 + 6], wv[ks * 8 + 7])}));
#pragma unroll
                        for (int mt = 0; mt < 3; ++mt) acc3[mt] = mfma16(ld16l(Sb + (mt * 16 + fr0) * 1032 + kq * 256 + ks * 32 + fg0 * 8), bfrag, acc3[mt]); }
#pragma unroll
                    for (int mt = 0; mt < 3; ++mt)
#pragma unroll
                        for (int j = 0; j < 4; ++j) red[(wave * 12 + mt * 4 + j) * 64 + lane] = acc3[mt][j];
                    __syncthreads();
                    if (wave < 2) {
                        const int cc = cb * 32 + wave * 16 + fr0; const float bm = b_mod[(size_t)ll * 6144 + cc];
#pragma unroll
                        for (int mt = 0; mt < 3; ++mt)
#pragma unroll
                            for (int j = 0; j < 4; ++j) { const int r = mt * 16 + fg0 * 4 + j; float sm = 0.f;
#pragma unroll
                                for (int q = 0; q < 4; ++q) sm += red[((q * 2 + wave) * 12 + mt * 4 + j) * 64 + lane];
                                if (r < 33) MOD[((size_t)ll * 33 + r) * 6144 + cc] = sm + bm; } }
                    __syncthreads();
                }
                }
                for (int idx = bid * NTHR + tid; idx < SEQ * 32; idx += G * NTHR) { const int pos = idx >> 5, i = idx & 31;
                    const float fq = expf(-(float)(i & 15) * (4.605170186f / 16.0f)); const float ang = (float)((i < 16) ? (pos >> 6) : (pos & 63)) * fq;
                    ROPE[(size_t)idx * 2] = __cosf(ang); ROPE[(size_t)idx * 2 + 1] = __sinf(ang); }
                for (int idx = bid * NTHR + tid; idx < DEPTH * 2 * 6 * 4096; idx += G * NTHR) { const int blk = idx >> 12, j = (idx >> 6) & 63, i = idx & 63;
                    const float a = p.in[14][(size_t)blk * 4096 + i * 64 + j], xx = p.in[16][(size_t)blk * 4096 + i * 64 + j];
                    WAT[idx] = (bf16)(pk2(a, 0.f) & 0xffffu); WXT[idx] = (bf16)(pk2(xx, 0.f) & 0xffffu); }
                for (int idx = bid * NTHR + tid; idx < DEPTH * 4 * 16384; idx += G * NTHR) WSB[idx] = (bf16)(pk2(p.in[22][idx], 0.f) & 0xffffu);
                for (int idx = gw; idx < DEPTH * 4 * 128; idx += NGW) {
                    const float sm = wave_sum(bf_lo(pk2(p.in[22][(size_t)idx * 128 + lane], 0.f)) + bf_lo(pk2(p.in[22][(size_t)idx * 128 + 64 + lane], 0.f)));
                    if (lane == 0) WSUM[idx] = sm; }
            }
            { LAS float* scr0 = (LAS float*)(lds + wave * 16384);
              for (int it = bid; it < 88; it += G) conv_i8_item_wg(p.in[10], INW, (signed char*)WIN_T, SWIN, 32 * it, 32 * it, scr0, (LAS float*)(lds + 8 * 16384), wave, lane); }
            __syncthreads();
            }
            SEAM(l, 0);
        }
        if (IN(1) && l == 0) {
            PHASE_BEGIN
            for (int rep = 0; rep < NREP_N0; ++rep) row_phase<0, false, true, true, false>(SAB, ctx_in, x_in, nullptr, nullptr, nullptr, nullptr, nullptr, nullptr, nullptr, p.in[6], modl, 0, 0, 1024,
                                      ABUF, nullptr, nullptr, nullptr, nullptr, 0, MT, G, bid, wave, lane, tid);
            SEAM(l, 1);
        }
        if (IN(2)) {
            PHASE_BEGIN
            pg8::Gemm g{ABUF, WIN_T, MT, INW, D, 0, nullptr}; pg8::StaticOrder S; S.init(MT, INW, G, bid);
            pg8::EpiInProj E{RBUF, INW, ROPE, SAB, SWIN};
            for (int rep = 0; rep < NREP_IN; ++rep) { int lane3; asm volatile("v_mbcnt_lo_u32_b32 %0, -1, 0\n\tv_mbcnt_hi_u32_b32 %0, -1, %0" : "=v"(lane3)); const int tid = wave0 * 64 + lane3; pg8::gemm_phase<pg8::EpiInProj, pg8::StaticOrder, true, false, 2>(lds, g, S, E, tid); if (rep + 1 < NREP_IN) BARRIER_NOW(); }
            SEAM(l, 2);
        }
        if (IN(3)) {
            PHASE_BEGIN
#define FRESH_TID(T) int T; { int l_; asm volatile("v_mbcnt_lo_u32_b32 %0, -1, 0\n\tv_mbcnt_hi_u32_b32 %0, -1, %0" : "=v"(l_)); T = wave0 * 64 + l_; }
            for (int rep = 0; rep < NREP_LRU; ++rep)
            for (;;) {
                FRESH_TID(tq);
                if (tq == 0) MISC[8] = __hip_atomic_fetch_add(ctl + CW_QUEUE + (rep * 16 + l * 4 + 0) * 64, 1u, __ATOMIC_RELAXED, __HIP_MEMORY_SCOPE_AGENT);
                __syncthreads(); const int id = (int)MISC[8]; __syncthreads();
                if (id >= NB * 6) break;
                lru_unit(lds, RBUF, BBUF, TLRU, WAT + (size_t)l * 2 * 6 * 4096, WXT + (size_t)l * 2 * 6 * 4096, p.in[15] + (size_t)l * 768, p.in[17] + (size_t)l * 768, p.in[18] + (size_t)l * 768,
                         p.in[12] + (size_t)l * 4 * 384, p.in[13] + (size_t)l * 384, id / 6, id % 6, want_ctx, tq);
            }
            { for (;;) {
                FRESH_TID(tq);
                if (tq == 0) MISC[8] = __hip_atomic_fetch_add(ctl + CW_QUEUE + (l * 4 + 3) * 64, 1u, __ATOMIC_RELAXED, __HIP_MEMORY_SCOPE_AGENT);
                __syncthreads(); const int id = (int)MISC[8]; __syncthreads();
                const int has_in = (l + 1 < DEPTH) ? 1 : 0; const int ni8 = CONV_NI8(l, has_in), ci8 = (ni8 + 7) >> 3, ntq = CONV_NTQ(l), nchunks = ci8 + ((ntq + 7) >> 3);
                if (id >= nchunks) break;
                if (id < ci8) { const int it = id * 8 + wave; if (it < ni8) CONVERT_I8(it, l, has_in); }
                else { const int gq = (id - ci8) * 8 + wave; if (gq < ntq) CONVERT_TQ(gq, l); }
              } }
            for (int rep = 0; rep < NREP_RP1; ++rep)
            for (;;) {
                FRESH_TID(tq);
                if (tq == 0) MISC[8] = __hip_atomic_fetch_add(ctl + CW_QUEUE + (rep * 16 + l * 4 + 1) * 64, 1u, __ATOMIC_RELAXED, __HIP_MEMORY_SCOPE_AGENT);
                __syncthreads(); const int id = (int)MISC[8]; __syncthreads();
                if (id >= NB * 6) break;
                const int hh = id % 6; const float tf = p.in[19][l * 12 + hh], tb = p.in[19][l * 12 + 6 + hh];
                const float lgf2 = -1.44269504f * ((tf < -15.f) ? -tf : log1pf(expf(-tf))), lgb2 = -1.44269504f * ((tb < -15.f) ? -tb : log1pf(expf(-tb)));
                retp1_unit(lds, RBUF, SBUF, id / 6, hh, lgf2, lgb2, want_ctx, tq);
            }
            for (int rep = 0; rep < NREP_GM; ++rep)
            for (;;) {
                FRESH_TID(tq);
                if (tq == 0) MISC[8] = __hip_atomic_fetch_add(ctl + CW_QUEUE + (rep * 16 + l * 4 + 2) * 64, 1u, __ATOMIC_RELAXED, __HIP_MEMORY_SCOPE_AGENT);
                __syncthreads(); const int id = (int)MISC[8]; __syncthreads();
                if (id >= NB * 18) break;
                const int ck = id % 18;
                if (!want_ctx && ck < 2) continue;
                gmlp_unit(lds, RBUF, BBUF, WSB + (size_t)l * 4 * 16384, WSUM + (size_t)l * 512, p.in[20] + (size_t)l * 256, p.in[21] + (size_t)l * 256, p.in[23] + (size_t)l * 512, id / 18, ck, tq);
            }
#undef FRESH_TID
            SEAM(l, 3);
        }
        if (IN(4)) {
            PHASE_BEGIN
            for (int rep = 0; rep < NREP_MB; ++rep) retp2_phase(lds, RBUF, SBUF, BBUF, p.in[19] + l * 12, want_ctx, G, bid, tid);
            SEAM(l, 4);
        }
        const int m_lo = want_ctx ? 0 : MC; const int m_n = MT - m_lo;
        if (IN(5)) {
            PHASE_BEGIN
            pg8::Gemm g{(const unsigned char*)BBUF + (size_t)m_lo * D, WOUT_T, m_n, D, D, 0, nullptr}; pg8::StaticOrder S; S.init(m_n, D, G, bid);
            pg8::EpiBf16 E{YBUF + (size_t)m_lo * D, D, 1.0f / (CSC * WSCO)};
            for (int rep = 0; rep < NREP_OUT; ++rep) { int lane3; asm volatile("v_mbcnt_lo_u32_b32 %0, -1, 0\n\tv_mbcnt_hi_u32_b32 %0, -1, %0" : "=v"(lane3)); const int tid = wave0 * 64 + lane3; pg8::gemm_phase<pg8::EpiBf16, pg8::StaticOrder, true, false, 1>(lds, g, S, E, tid); if (rep + 1 < NREP_OUT) BARRIER_NOW(); }
            SEAM(l, 5);
        }
        if (IN(6)) {
            PHASE_BEGIN
            if (l == 0) {
                row_phase<1, false, true, true, false>(SAB, ctx_in, x_in, XCTX, XLAT, YBUF, nullptr, nullptr, nullptr, p.in[7] + (size_t)l * D, p.in[8] + (size_t)l * D, modl, 2048, 3072, 4096,
                                                       ABUF, nullptr, nullptr, nullptr, nullptr, m_lo, MT, G, bid, wave, lane, tid);
            } else if (moe) {
                row_phase<1, true, true, false, false>(SAB, XCTX, XLAT, XCTX, XLAT, YBUF, nullptr, nullptr, nullptr, p.in[7] + (size_t)l * D, p.in[8] + (size_t)l * D, modl, 2048, 3072, 4096,
                                                       ABUF, p.in[27] + (size_t)jf * D * NE, TOKINFO, (LAS unsigned*)(lds + MISC_OFF) + 16, ctl + CW_GCNT + jf * 64, m_lo, MT, G, bid, wave, lane, tid, lds);
            } else {
                row_phase<1, false, true, false, false>(SAB, XCTX, XLAT, XCTX, XLAT, YBUF, nullptr, nullptr, nullptr, p.in[7] + (size_t)l * D, p.in[8] + (size_t)l * D, modl, 2048, 3072, 4096,
                                                        ABUF, nullptr, nullptr, nullptr, nullptr, m_lo, MT, G, bid, wave, lane, tid);
            }
            SEAM(l, 6);
        }
        if (IN(7)) {
            PHASE_BEGIN
            if (!moe) {
                pg8::Gemm g{(const unsigned char*)ABUF + (size_t)m_lo * D, WFFN, m_n, 2 * DFF, D, 0, nullptr}; pg8::StaticOrder S; S.init(m_n, 2 * DFF, G, bid);
                pg8::EpiSwiGLU E{(unsigned char*)RBUF + (size_t)m_lo * DFF, DFF, SAB + m_lo, SW13, HSC};
                for (int rep = 0; rep < NREP_DG1; ++rep) { int lane3; asm volatile("v_mbcnt_lo_u32_b32 %0, -1, 0\n\tv_mbcnt_hi_u32_b32 %0, -1, %0" : "=v"(lane3)); const int tid = wave0 * 64 + lane3; pg8::gemm_phase<pg8::EpiSwiGLU, pg8::StaticOrder, true, false, 2>(lds, g, S, E, tid); if (rep + 1 < NREP_DG1) BARRIER_NOW(); }
            } else {
                LAS unsigned* T = (LAS unsigned*)(lds + MISC_OFF) + 32;
                if (tid == 0) { unsigned s = 0; for (int e = 0; e < 8; ++e) { T[e] = s; const unsigned c = __hip_atomic_load(ctl + CW_GCNT + jf * 64 + e, __ATOMIC_RELAXED, __HIP_MEMORY_SCOPE_AGENT); s += (c + 255u) & ~255u; } T[8] = s; }
                if (tid < 8) T[16 + tid] = 0u;
                __syncthreads();
                const int per = m_n / G; const int mb = m_lo + bid * per;
                unsigned e1 = 0, e2 = 0, p1 = 0, p2 = 0;
                if (tid < per) { const uint4 ti = TOKINFO[mb + tid]; e1 = ti.x; e2 = ti.y;
                    p1 = __hip_atomic_fetch_add(T + 16 + e1, 1u, __ATOMIC_RELAXED, __HIP_MEMORY_SCOPE_WORKGROUP); p2 = __hip_atomic_fetch_add(T + 16 + e2, 1u, __ATOMIC_RELAXED, __HIP_MEMORY_SCOPE_WORKGROUP); }
                __syncthreads();
                if (tid < 8) T[24 + tid] = __hip_atomic_fetch_add(ctl + CW_GPOS + jf * 64 + tid, T[16 + tid], __ATOMIC_RELAXED, __HIP_MEMORY_SCOPE_AGENT);
                __syncthreads();
                if (tid < per) { const int s1 = (int)(T[e1] + T[24 + e1] + p1), s2 = (int)(T[e2] + T[24 + e2] + p2);
                    SLOTTOK[s1] = mb + tid; SLOTTOK[s2] = mb + tid; TOKSLOT[mb + tid] = make_int2(s1, s2); const float sv = SAB[mb + tid]; SASLOT[s1] = sv; SASLOT[s2] = sv; }
                for (int idx = bid * NTHR + tid; idx < 8 * 256; idx += G * NTHR) { const int e = idx >> 8, k = idx & 255;
                    const unsigned c = __hip_atomic_load(ctl + CW_GCNT + jf * 64 + e, __ATOMIC_RELAXED, __HIP_MEMORY_SCOPE_AGENT); const unsigned s = T[e] + c + k;
                    if (s < T[e + 1]) { SLOTTOK[s] = m_lo; SASLOT[s] = 0.f; } }
                __syncthreads();
            }
            SEAM(l, 7);
        }
        if (IN(8)) {
            PHASE_BEGIN
            if (!moe) {
                pg8::Gemm g{(const unsigned char*)RBUF + (size_t)m_lo * DFF, (const unsigned char*)WFFN + W13_BYTES, m_n, D, DFF, 0, nullptr}; pg8::StaticOrder S; S.init(m_n, D, G, bid);
                pg8::EpiBf16 E{YBUF + (size_t)m_lo * D, D, 1.0f / (WSC2 * HSC)};
                for (int rep = 0; rep < NREP_DG2; ++rep) { int lane3; asm volatile("v_mbcnt_lo_u32_b32 %0, -1, 0\n\tv_mbcnt_hi_u32_b32 %0, -1, %0" : "=v"(lane3)); const int tid = wave0 * 64 + lane3; pg8::gemm_phase<pg8::EpiBf16, pg8::StaticOrder, true, false, 1>(lds, g, S, E, tid); if (rep + 1 < NREP_DG2) BARRIER_NOW(); }
            } else {
                LAS int* SEGT = (LAS int*)(lds + MISC_OFF) + 48;
                if (tid == 0) { unsigned s = 0; for (int e = 0; e < 8; ++e) { SEGT[e] = (int)(s >> 8); const unsigned c = __hip_atomic_load(ctl + CW_GCNT + jf * 64 + e, __ATOMIC_RELAXED, __HIP_MEMORY_SCOPE_AGENT); s += (c + 255u) & ~255u; } SEGT[8] = (int)(s >> 8); }
                __syncthreads();
                const int NT = __builtin_amdgcn_readfirstlane(SEGT[8]);
                const int slab = (NT <= p.slab_cap) ? NT : ((NT + 1) / 2 < SLAB_TILES ? (NT + 1) / 2 : SLAB_TILES);
                for (int t0 = 0; t0 < NT; t0 += slab) {
                    const int nT = (NT - t0) < slab ? (NT - t0) : slab;
                    { int lane2; asm volatile("v_mbcnt_lo_u32_b32 %0, -1, 0\n\tv_mbcnt_hi_u32_b32 %0, -1, %0" : "=v"(lane2)); const int tid = wave0 * 64 + lane2;
                      pg8::MoeOrder S; S.nM = nT; S.nN = 2 * DFF / 256; S.nwg = nT * S.nN; S.G = G; S.c = bid; S.t0 = t0;
                        S.segt = SEGT;
                        pg8::Gemm g{ABUF, WFFN, nT * 256, 2 * DFF, D, W13_BYTES, SLOTTOK};
                        pg8::EpiSwiGLU E{(unsigned char*)HIDS - (size_t)t0 * 256 * DFF, DFF, SASLOT, SW13, HSC};
                        for (int rep = 0; rep < NREP_MG1; ++rep) { int lane3; asm volatile("v_mbcnt_lo_u32_b32 %0, -1, 0\n\tv_mbcnt_hi_u32_b32 %0, -1, %0" : "=v"(lane3)); const int tid = wave0 * 64 + lane3; pg8::gemm_phase<pg8::EpiSwiGLU, pg8::MoeOrder, true, true, 2>(lds, g, S, E, tid); if (rep + 1 < NREP_MG1) BARRIER_NOW(); } }
                    BARRIER_NOW();
                    { int lane2; asm volatile("v_mbcnt_lo_u32_b32 %0, -1, 0\n\tv_mbcnt_hi_u32_b32 %0, -1, %0" : "=v"(lane2)); const int tid = wave0 * 64 + lane2;
                      pg8::MoeOrder S; S.nM = nT; S.nN = D / 256; S.nwg = nT * S.nN; S.G = G; S.c = bid; S.t0 = t0;
                        S.segt = SEGT;
                        pg8::Gemm g{(const unsigned char*)HIDS - (size_t)t0 * 256 * DFF, (const unsigned char*)WFFN + (size_t)NE * W13_BYTES, nT * 256, D, DFF, W2_BYTES, nullptr};
                        pg8::EpiBf16 E{YSLOT, D, 1.0f / (WSC2 * HSC)};
                        for (int rep = 0; rep < NREP_MG2; ++rep) { int lane3; asm volatile("v_mbcnt_lo_u32_b32 %0, -1, 0\n\tv_mbcnt_hi_u32_b32 %0, -1, %0" : "=v"(lane3)); const int tid = wave0 * 64 + lane3; pg8::gemm_phase<pg8::EpiBf16, pg8::MoeOrder, true, false, 1>(lds, g, S, E, tid); if (rep + 1 < NREP_MG2) BARRIER_NOW(); } }
                    if (t0 + slab < NT) BARRIER_NOW();
                }
            }
            SEAM(l, 8);
        }
        if (IN(9)) {
            PHASE_BEGIN
            const float* gpre_n = p.in[6] + (size_t)(l + 1 < DEPTH ? l + 1 : l) * D; const float* modn = MOD + (size_t)(l + 1 < DEPTH ? l + 1 : l) * 33 * 6144;
            const int o_sh = (int)(modn - modl) + 0, o_sc = (int)(modn - modl) + 1024;
            if (l + 1 < DEPTH) {
                if (moe) row_phase<2, false, true, false, false>(SAB, XCTX, XLAT, XCTX, XLAT, nullptr, YSLOT, TOKINFO, TOKSLOT, p.in[9] + (size_t)l * D, gpre_n, modl, 5120, o_sh, o_sc,
                                                                 ABUF, nullptr, nullptr, nullptr, nullptr, m_lo, MT, G, bid, wave, lane, tid);
                else row_phase<1, false, true, false, false>(SAB, XCTX, XLAT, XCTX, XLAT, YBUF, nullptr, nullptr, nullptr, p.in[9] + (size_t)l * D, gpre_n, modl, 5120, o_sh, o_sc,
                                                             ABUF, nullptr, nullptr, nullptr, nullptr, m_lo, MT, G, bid, wave, lane, tid);
            } else {
                row_phase<2, false, false, false, true>(SAB, XCTX, XLAT, XCTX, out, nullptr, YSLOT, TOKINFO, TOKSLOT, p.in[9] + (size_t)l * D, gpre_n, modl, 5120, o_sh, o_sc,
                                                        ABUF, nullptr, nullptr, nullptr, nullptr, m_lo, MT, G, bid, wave, lane, tid);
            }
            SEAM(l, 9);
        }
    }
#undef IN
#undef SEAM
}

extern "C" void kernel_launch(void* const* d_in, const int* in_sizes, int n_in, void* d_out, int out_size, void* d_ws, size_t ws_size, hipStream_t stream) {
    static int grid = 0;
    if (grid == 0) {
        if (n_in != 31 || out_size != ML * D || ws_size < WS_END) { fprintf(stderr, "kernel_launch: unexpected problem (n_in %d, out %d, ws %zu, need %zu)\n", n_in, out_size, ws_size, (size_t)WS_END); grid = -1; return; }
        int dev = 0, cus = 0, per_cu = 0;
        if (hipGetDevice(&dev) != hipSuccess || hipDeviceGetAttribute(&cus, hipDeviceAttributeMultiprocessorCount, dev) != hipSuccess) { grid = -1; return; }
        if (hipFuncSetAttribute((const void*)fwd_kernel, hipFuncAttributeMaxDynamicSharedMemorySize, LDS_BYTES) != hipSuccess) { fprintf(stderr, "kernel_launch: hipFuncSetAttribute failed\n"); grid = -1; return; }
        if (hipOccupancyMaxActiveBlocksPerMultiprocessor(&per_cu, (const void*)fwd_kernel, NTHR, LDS_BYTES) != hipSuccess || per_cu < 1) fprintf(stderr, "kernel_launch: occupancy query says %d\n", per_cu);
        (void)hipGetLastError();
        grid = cus;
        if (grid != 256) { fprintf(stderr, "kernel_launch: %d CUs (built for 256)\n", grid); grid = -1; return; }
    }
    if (grid < 0) return;
    (void)hipMemsetAsync((char*)d_ws + WS_CTL, 0, CTL_BYTES, stream);
    Params a{};
    for (int i = 0; i < 31; ++i) a.in[i] = (const float*)d_in[i];
    a.out = (float*)d_out; a.ws = (unsigned char*)d_ws;
    { const size_t cap = (ws_size - MOE_HID) / ((size_t)256 * DFF); a.slab_cap = cap >= 584 ? 584 : SLAB_TILES; }
#if MK_PER_PHASE
    int region = 0;
    for (int l = 0; l < DEPTH; ++l)
        for (int ph = 0; ph < NPH; ++ph) {
            if (ph == 1 && l != 0) continue;
            a.l_lo = l; a.l_hi = l + 1; a.ph_lo = ph; a.ph_hi = ph + 1; a.bar_region = region++;
            hipLaunchKernelGGL(fwd_kernel, dim3(grid), dim3(NTHR), LDS_BYTES, stream, a);
        }
#else
    a.l_lo = 0; a.l_hi = DEPTH; a.ph_lo = 0; a.ph_hi = NPH; a.bar_region = 0;
    hipLaunchKernelGGL(fwd_kernel, dim3(grid), dim3(NTHR), LDS_BYTES, stream, a);
#endif
    const hipError_t le = hipPeekAtLastError();
    if (le != hipSuccess) fprintf(stderr, "kernel_launch: launch failed: %s\n", hipGetErrorName(le));
}
```

```cpp
#include <hip/hip_runtime.h>
#include <cstdio>
#include <cstdint>

#ifndef NREP_G
#define NREP_G 1
#endif
#ifndef NREP_IN
#define NREP_IN NREP_G
#endif
#ifndef NREP_OUT
#define NREP_OUT NREP_G
#endif
#ifndef NREP_DG1
#define NREP_DG1 NREP_G
#endif
#ifndef NREP_DG2
#define NREP_DG2 NREP_G
#endif
#ifndef NREP_MG1
#define NREP_MG1 NREP_G
#endif
#ifndef NREP_MG2
#define NREP_MG2 NREP_G
#endif
#ifndef NREP_MB
#define NREP_MB 1
#endif
#ifndef NREP_MA
#define NREP_MA 1
#endif
#ifndef NREP_LRU
#define NREP_LRU NREP_MA
#endif
#ifndef NREP_RP1
#define NREP_RP1 NREP_MA
#endif
#ifndef NREP_GM
#define NREP_GM NREP_MA
#endif
#ifndef NREP_P0
#define NREP_P0 1
#endif
#ifndef NREP_N0
#define NREP_N0 1
#endif
#ifndef MK_PER_PHASE
#define MK_PER_PHASE 0
#endif

namespace pg8 {
#define PG8_LAS __attribute__((address_space(3)))
typedef unsigned short bf16_t;
typedef short bf16x8 __attribute__((ext_vector_type(8)));
typedef float f32x4 __attribute__((ext_vector_type(4)));
typedef float f32x2 __attribute__((ext_vector_type(2)));
typedef unsigned u32x4 __attribute__((ext_vector_type(4)));
typedef unsigned u32x2 __attribute__((ext_vector_type(2)));
constexpr int BM = 256, BK = 64, HALF = 128, HTB = HALF * BK * 2, STAGE_BYTES = 8 * HTB, NXCD = 8, WGM = 4;

__host__ __device__ __forceinline__ int lds_byte(int r, int c) { const int st = (r >> 4) * 2 + (c >> 5), rr = r & 15, cc = c & 31, ob = rr * 64 + cc * 2; return st * 1024 + (ob ^ (((ob >> 9) & 1) << 5)); }
__host__ __device__ __forceinline__ void stage_rc(int b, int& R, int& C) { const int st = b / 1024, sb = b % 1024, swz = sb ^ (((sb >> 9) & 1) << 5); R = (st >> 1) * 16 + swz / 64; C = (st & 1) * 32 + (swz % 64) / 2; }
__host__ __device__ __forceinline__ int perm32(int rho) { const int n = rho >> 4, i = rho & 15; return 8 * (i >> 2) + 4 * n + (i & 3); }

struct Unit { int pm, pn, e; };
struct Gemm { const void* A; const void* Bt; int M, N, Kb; size_t bstride; const int* rowidx; };

struct StaticOrder {
    int nM, nN, nwg, G, c;
    __host__ __device__ void init(int M, int N, int G_, int c_) { nM = M / BM; nN = N / BM; nwg = nM * nN; G = G_; c = c_; }
    __host__ __device__ bool next(int i, Unit& u) const {
        const long L = (long)i * G + c; if (L >= nwg) return false;
        int wgid = (int)L; { const int q = nwg / NXCD, r = nwg % NXCD, xcd = wgid % NXCD, off = wgid / NXCD; wgid = (xcd < r ? xcd * (q + 1) : r * (q + 1) + (xcd - r) * q) + off; }
        const int nig = WGM * nN, gid = wgid / nig, fm = gid * WGM, gsz = (nM - fm) < WGM ? (nM - fm) : WGM;
        u.pm = fm + ((wgid % nig) % gsz); u.pn = (wgid % nig) / gsz; u.e = 0; return true;
    }
    __device__ __forceinline__ void a_ready(const Unit&) const {}
    __device__ __forceinline__ void done(const Unit&) const {}
};
struct MoeOrder {
    int nM, nN, nwg, G, c, t0; const PG8_LAS int* segt;
    __device__ __forceinline__ bool next(int i, Unit& u) const {
        const long L = (long)i * G + c; if (L >= nwg) return false;
        int wgid = (int)L; { const int q = nwg / NXCD, r = nwg % NXCD, xcd = wgid % NXCD, off = wgid / NXCD; wgid = (xcd < r ? xcd * (q + 1) : r * (q + 1) + (xcd - r) * q) + off; }
        const int nig = WGM * nN, gid = wgid / nig, fm = gid * WGM, gsz = (nM - fm) < WGM ? (nM - fm) : WGM;
        u.pm = t0 + fm + ((wgid % nig) % gsz); u.pn = (wgid % nig) / gsz;
        int e = 0;
#pragma unroll
        for (int k = 1; k < 8; ++k) e += (u.pm >= segt[k]) ? 1 : 0;
        u.e = __builtin_amdgcn_readfirstlane(e); return true;
    }
    __device__ __forceinline__ void a_ready(const Unit&) const {}
    __device__ __forceinline__ void done(const Unit&) const {}
};

__device__ __forceinline__ unsigned cvt_pk_bf16(float lo, float hi) { unsigned r; asm volatile("v_cvt_pk_bf16_f32 %0, %1, %2" : "=v"(r) : "v"(lo), "v"(hi)); return r; }

struct EpiBf16 {
    static constexpr bool PERM = true, AFTER_DRAIN = false; static constexpr int NST = 16;
    bf16_t* O; int ldc; float scale;
    static constexpr bool SCALES = false;
    __device__ __forceinline__ void operator()(const f32x4 (&acc)[2][2][4][2], const Unit& u, int wr, int wc, int fr, int fq, const PG8_LAS unsigned char*) const {
        const int row0 = u.pm * BM + wr * 64 + fr; const int col0 = u.pn * BM + wc * 32 + 8 * fq;
#pragma unroll
        for (int ai = 0; ai < 2; ++ai)
#pragma unroll
            for (int m = 0; m < 4; ++m) { bf16_t* rowp = O + (size_t)(row0 + ai * HALF + m * 16) * ldc + col0;
#pragma unroll
                for (int bj = 0; bj < 2; ++bj) { const f32x4 v0 = acc[ai][bj][m][0] * scale, v1 = acc[ai][bj][m][1] * scale;
                    u32x4 w; w.x = cvt_pk_bf16(v0[0], v0[1]); w.y = cvt_pk_bf16(v0[2], v0[3]); w.z = cvt_pk_bf16(v1[0], v1[1]); w.w = cvt_pk_bf16(v1[2], v1[3]);
                    *(u32x4*)(rowp + bj * HALF) = w; } }
    }
};
struct EpiInProj {
    static constexpr bool PERM = true, AFTER_DRAIN = false; static constexpr int NST = 16;
    bf16_t* O; int ldc; const float* cs; const float* sa; const float* sw;
    static constexpr bool SCALES = true;
    __device__ __forceinline__ void prefetch(PG8_LAS unsigned char* sl, const Unit& u, int wr, int wc, int lane) const {
        const float* sap = sa + u.pm * BM + wr * 64 + lane;
        __builtin_amdgcn_global_load_lds((const unsigned*)sap, (PG8_LAS unsigned*)sl, 4, 0, 0); __builtin_amdgcn_global_load_lds((const unsigned*)(sap + HALF), (PG8_LAS unsigned*)(sl + 256), 4, 0, 0);
        const float* swp = sw + u.pn * BM + wc * 32 + (lane & 31) + (lane >> 5) * HALF;
        __builtin_amdgcn_global_load_lds((const unsigned*)swp, (PG8_LAS unsigned*)(sl + 512), 4, 0, 0);
    }
    __device__ __forceinline__ void operator()(const f32x4 (&acc)[2][2][4][2], const Unit& u, int wr, int wc, int fr, int fq, const PG8_LAS unsigned char* sl) const {
        const int row0 = u.pm * BM + wr * 64 + fr; const int col0 = u.pn * BM + wc * 32 + 8 * fq;
        const bool qk = (u.pn >= 3 && u.pn <= 5); const bool rope = qk && (u.pm >= 32);
        f32x4 swv[2][2];
#pragma unroll
        for (int bj = 0; bj < 2; ++bj) { swv[bj][0] = *(const PG8_LAS f32x4*)(sl + 512 + (bj * 32 + 8 * fq) * 4); swv[bj][1] = *(const PG8_LAS f32x4*)(sl + 512 + (bj * 32 + 8 * fq + 4) * 4); }
#pragma unroll
        for (int ai = 0; ai < 2; ++ai)
#pragma unroll
            for (int m = 0; m < 4; ++m) { const int row = row0 + ai * HALF + m * 16; bf16_t* rowp = O + (size_t)row * ldc + col0;
                const int pos = (row - 8192) & 2047; const float sar = *(const PG8_LAS float*)(sl + ai * 256 + (m * 16 + fr) * 4);
#pragma unroll
                for (int bj = 0; bj < 2; ++bj) { f32x4 v0 = acc[ai][bj][m][0] * swv[bj][0] * sar, v1 = acc[ai][bj][m][1] * swv[bj][1] * sar;
                    if (qk) { const float sc = (u.pn == 3 || (u.pn == 4 && bj == 0)) ? 0.125f : 1.0f; v0 = v0 * sc; v1 = v1 * sc; }
                    if (rope) { const int pr = ((col0 + bj * HALF) & 63) >> 1;
                        const f32x4 c0 = *(const f32x4*)(cs + ((size_t)pos * 32 + pr) * 2), c1 = *(const f32x4*)(cs + ((size_t)pos * 32 + pr) * 2 + 4);
                        f32x4 r0, r1;
                        r0[0] = v0[0] * c0[0] - v0[1] * c0[1]; r0[1] = v0[0] * c0[1] + v0[1] * c0[0]; r0[2] = v0[2] * c0[2] - v0[3] * c0[3]; r0[3] = v0[2] * c0[3] + v0[3] * c0[2];
                        r1[0] = v1[0] * c1[0] - v1[1] * c1[1]; r1[1] = v1[0] * c1[1] + v1[1] * c1[0]; r1[2] = v1[2] * c1[2] - v1[3] * c1[3]; r1[3] = v1[2] * c1[3] + v1[3] * c1[2];
                        v0 = r0; v1 = r1; }
                    u32x4 w; w.x = cvt_pk_bf16(v0[0], v0[1]); w.y = cvt_pk_bf16(v0[2], v0[3]); w.z = cvt_pk_bf16(v1[0], v1[1]); w.w = cvt_pk_bf16(v1[2], v1[3]);
                    *(u32x4*)(rowp + bj * HALF) = w; } }
    }
};
struct EpiSwiGLU {
    static constexpr bool PERM = true, AFTER_DRAIN = false; static constexpr int NST = 8;
    unsigned char* O; int ldc; const float* sa; const float* sw; float outscale;
    static constexpr bool SCALES = true;
    __device__ __forceinline__ void prefetch(PG8_LAS unsigned char* sl, const Unit& u, int wr, int wc, int lane) const {
        const float* sap = sa + u.pm * BM + wr * 64 + lane;
        __builtin_amdgcn_global_load_lds((const unsigned*)sap, (PG8_LAS unsigned*)sl, 4, 0, 0); __builtin_amdgcn_global_load_lds((const unsigned*)(sap + HALF), (PG8_LAS unsigned*)(sl + 256), 4, 0, 0);
        const float* swp = sw + (size_t)u.e * (2 * 2816) + u.pn * BM + wc * 32 + (lane & 31) + (lane >> 5) * HALF;
        __builtin_amdgcn_global_load_lds((const unsigned*)swp, (PG8_LAS unsigned*)(sl + 512), 4, 0, 0);
    }
    __device__ __forceinline__ void operator()(const f32x4 (&acc)[2][2][4][2], const Unit& u, int wr, int wc, int fr, int fq, const PG8_LAS unsigned char* sl) const {
        const int row0 = u.pm * BM + wr * 64 + fr; const int col0 = u.pn * HALF + wc * 32 + 8 * fq;
        f32x4 sw1[2], sw3[2];
#pragma unroll
        for (int n = 0; n < 2; ++n) { sw1[n] = *(const PG8_LAS f32x4*)(sl + 512 + (8 * fq + 4 * n) * 4); sw3[n] = *(const PG8_LAS f32x4*)(sl + 512 + (32 + 8 * fq + 4 * n) * 4) * outscale; }
#pragma unroll
        for (int ai = 0; ai < 2; ++ai)
#pragma unroll
            for (int m = 0; m < 4; ++m) { unsigned char* rowp = O + (size_t)(row0 + ai * HALF + m * 16) * ldc + col0; const float sar = *(const PG8_LAS float*)(sl + ai * 256 + (m * 16 + fr) * 4);
                f32x4 h[2];
#pragma unroll
                for (int n = 0; n < 2; ++n) { const f32x4 a = acc[ai][0][m][n] * sw1[n] * sar, b = acc[ai][1][m][n] * sw3[n] * sar;
#pragma unroll
                    for (int j = 0; j < 4; ++j) { const float sg = a[j] * __builtin_amdgcn_rcpf(1.0f + __builtin_amdgcn_exp2f(-1.44269504f * a[j])); h[n][j] = __builtin_amdgcn_fmed3f(sg * b[j], -448.0f, 448.0f); } }
                u32x2 w; unsigned t = 0u;
                t = __builtin_amdgcn_cvt_pk_fp8_f32(h[0][0], h[0][1], t, false); t = __builtin_amdgcn_cvt_pk_fp8_f32(h[0][2], h[0][3], t, true); w.x = t;
                t = __builtin_amdgcn_cvt_pk_fp8_f32(h[1][0], h[1][1], t, false); t = __builtin_amdgcn_cvt_pk_fp8_f32(h[1][2], h[1][3], t, true); w.y = t;
                *(u32x2*)rowp = w; }
    }
};

typedef int v4i_t __attribute__((ext_vector_type(4)));
typedef int v8i_t __attribute__((ext_vector_type(8)));
template <class Epi, class Sched, bool ALIGN_EPI, bool GATHER, int DT>
__device__ __forceinline__ void gemm_phase(PG8_LAS unsigned char* lds, const Gemm g, const Sched& S, const Epi& E, const int tid) {
    const int wid = __builtin_amdgcn_readfirstlane(tid >> 6), lane = tid & 63, wr = wid >> 2, wc = wid & 3, fr = lane & 15, fq = lane >> 4;
    const int Kb = g.Kb, nt = Kb / 128;
    unsigned voffA[2], voffB[2];
#pragma unroll
    for (int i = 0; i < 2; ++i) { int R, C; stage_rc(tid * 16 + i * 8192, R, C); const int Rb = Epi::PERM ? ((R & ~31) + perm32(R & 31)) : R;
        voffA[i] = (unsigned)(R * Kb + C * 2); voffB[i] = (unsigned)(Rb * Kb + C * 2); }
    const size_t kstep = (size_t)(BK * 2);
    const size_t hstep = (size_t)HALF * Kb;
    const size_t tstep = 2 * hstep;
    const unsigned ldsw = (unsigned)wid * 1024u;
    const int aoff = lds_byte(wr * 64 + fr, fq * 8), boff = lds_byte(wc * 32 + fr, fq * 8);
#define PG8_SA(b, h) (((b) * 2 + (h)) * HTB)
#define PG8_SB(b, h) ((4 + (b) * 2 + (h)) * HTB)
#define PG8_STAGE(bufoff, gbase, voff) do { _Pragma("unroll") for (int _i = 0; _i < 2; ++_i) \
        __builtin_amdgcn_global_load_lds((const unsigned*)((const char*)(gbase) + (voff)[_i]), (PG8_LAS unsigned*)(lds + (bufoff) + ldsw + _i * 8192), 16, 0, 0); } while (0)
#define PG8_STAGE_A(bufoff, ptr, h, AO0, AO1) do { if constexpr (GATHER) { if ((h) == 0) PG8_STAGE(bufoff, ptr, AO0); else PG8_STAGE(bufoff, ptr, AO1); } else PG8_STAGE(bufoff, (ptr) + (h) * hstep, voffA); } while (0)
#define PG8_LD8(p) __builtin_shufflevector(*(const PG8_LAS v4i_t*)(p), *(const PG8_LAS v4i_t*)((p) + 1024), 0, 1, 2, 3, 4, 5, 6, 7)
#define PG8_LO(x) __builtin_bit_cast(bf16x8, __builtin_shufflevector(x, x, 0, 1, 2, 3))
#define PG8_HI(x) __builtin_bit_cast(bf16x8, __builtin_shufflevector(x, x, 4, 5, 6, 7))
#define PG8_LDA(dst, b, h) do { _Pragma("unroll") for (int m = 0; m < 4; ++m) dst[m] = PG8_LD8(lds + PG8_SA(b, h) + aoff + m * 2048); } while (0)
#define PG8_LDB(dst, b, h) do { _Pragma("unroll") for (int n = 0; n < 2; ++n) dst[n] = PG8_LD8(lds + PG8_SB(b, h) + boff + n * 2048); } while (0)
#define PG8_MMA(ai, bj, At, Bt) do { __builtin_amdgcn_s_setprio(1); \
        if constexpr (DT == 1) { _Pragma("unroll") for (int m = 0; m < 4; ++m) _Pragma("unroll") for (int n = 0; n < 2; ++n) \
            asm volatile("v_mfma_scale_f32_16x16x128_f8f6f4 %0, %1, %2, %0, %3, %3 op_sel_hi:[0,0,0]" : "+v"(acc[ai][bj][m][n]) : "v"(Bt[n]), "v"(At[m]), "v"(f8one)); } \
        else if constexpr (DT == 2) { \
            _Pragma("unroll") for (int m = 0; m < 4; ++m) _Pragma("unroll") for (int n = 0; n < 2; ++n) \
                asm volatile("v_mfma_i32_16x16x64_i8 %0, %1, %2, %0" : "+v"(acc[ai][bj][m][n]) : "v"(__builtin_shufflevector(Bt[n], Bt[n], 0, 1, 2, 3)), "v"(__builtin_shufflevector(At[m], At[m], 0, 1, 2, 3))); \
            _Pragma("unroll") for (int m = 0; m < 4; ++m) _Pragma("unroll") for (int n = 0; n < 2; ++n) \
                asm volatile("v_mfma_i32_16x16x64_i8 %0, %1, %2, %0" : "+v"(acc[ai][bj][m][n]) : "v"(__builtin_shufflevector(Bt[n], Bt[n], 4, 5, 6, 7)), "v"(__builtin_shufflevector(At[m], At[m], 4, 5, 6, 7))); } \
        else { _Pragma("unroll") for (int m = 0; m < 4; ++m) _Pragma("unroll") for (int n = 0; n < 2; ++n) { \
               acc[ai][bj][m][n] = __builtin_amdgcn_mfma_f32_16x16x32_bf16(PG8_LO(Bt[n]), PG8_LO(At[m]), acc[ai][bj][m][n], 0, 0, 0); \
               acc[ai][bj][m][n] = __builtin_amdgcn_mfma_f32_16x16x32_bf16(PG8_HI(Bt[n]), PG8_HI(At[m]), acc[ai][bj][m][n], 0, 0, 0); } } \
        __builtin_amdgcn_s_setprio(0); } while (0)
#define PG8_WAIT_V(n) asm volatile("s_waitcnt vmcnt(" #n ")" ::: "memory")
#define PG8_WAIT_VN(n) asm volatile("s_waitcnt vmcnt(%0)" :: "n"(n) : "memory")
#define PG8_WAIT_L(n) asm volatile("s_waitcnt lgkmcnt(" #n ")" ::: "memory")
#define PG8_BAR __builtin_amdgcn_s_barrier()
#define PG8_SCHED __builtin_amdgcn_sched_barrier(0)
    Unit cur, nxt; int ui = 0;
    if (!S.next(0, cur)) return;
    f32x4 acc[2][2][4][2];
#pragma unroll
    for (int a = 0; a < 2; ++a)
#pragma unroll
        for (int b = 0; b < 2; ++b)
#pragma unroll
            for (int m = 0; m < 4; ++m)
#pragma unroll
                for (int n = 0; n < 2; ++n) { acc[a][b][m][n] = (f32x4){0.f, 0.f, 0.f, 0.f}; asm volatile("" : "+v"(acc[a][b][m][n])); }
    v8i_t At[4], B0[2], B1[2];
    const int f8one = 0x7f7f7f7f;
    unsigned aoC0[2] = {0u, 0u}, aoC1[2] = {0u, 0u};
    PG8_LAS unsigned char* idx_lds = lds + STAGE_BYTES + wid * 1024;
    if constexpr (GATHER) {
#pragma unroll
        for (int i = 0; i < 2; ++i) { int R, C; stage_rc(tid * 16 + i * 8192, R, C); const int r0 = g.rowidx[cur.pm * BM + R], r1 = g.rowidx[cur.pm * BM + HALF + R];
            aoC0[i] = (unsigned)r0 * (unsigned)Kb + (unsigned)(C * 2); aoC1[i] = (unsigned)r1 * (unsigned)Kb + (unsigned)(C * 2); }
    }
    const char* cA = GATHER ? (const char*)g.A : (const char*)g.A + (size_t)cur.pm * tstep; const char* cB = (const char*)g.Bt + (size_t)cur.e * g.bstride + (size_t)cur.pn * tstep;
    S.a_ready(cur);
    PG8_STAGE(PG8_SB(0, 0), cB, voffB); PG8_STAGE(PG8_SB(0, 1), cB + hstep, voffB); PG8_STAGE_A(PG8_SA(0, 0), cA, 0, aoC0, aoC1); PG8_STAGE_A(PG8_SA(0, 1), cA, 1, aoC0, aoC1);
    if (wr == 1) PG8_BAR;
    PG8_WAIT_V(2); PG8_BAR;
    PG8_STAGE(PG8_SB(1, 0), cB + kstep, voffB); PG8_STAGE_A(PG8_SA(1, 0), cA + kstep, 0, aoC0, aoC1); PG8_STAGE(PG8_SB(1, 1), cB + hstep + kstep, voffB);
    PG8_WAIT_V(6); PG8_BAR;
    PG8_LAS unsigned char* scal_lds = lds + STAGE_BYTES + 8192 + wid * 1024;
    for (;;) {
        const bool has_next = S.next(ui + 1, nxt);
        if constexpr (Epi::SCALES) E.prefetch(scal_lds, cur, wr, wc, lane);
        const char* nA = GATHER ? (const char*)g.A : (has_next ? (const char*)g.A + (size_t)nxt.pm * tstep : cA);
        const char* nB = has_next ? (const char*)g.Bt + (size_t)nxt.e * g.bstride + (size_t)nxt.pn * tstep : cB;
        if constexpr (GATHER) { if (has_next) {
#pragma unroll
            for (int i = 0; i < 2; ++i) { int R, C; stage_rc(tid * 16 + i * 8192, R, C);
                __builtin_amdgcn_global_load_lds((const unsigned*)(g.rowidx + nxt.pm * BM + R), (PG8_LAS unsigned*)(idx_lds + (2 * i) * 256), 4, 0, 0);
                __builtin_amdgcn_global_load_lds((const unsigned*)(g.rowidx + nxt.pm * BM + HALF + R), (PG8_LAS unsigned*)(idx_lds + (2 * i + 1) * 256), 4, 0, 0); } } }
#define PG8_TRIP(t, W1, W2, W3, NOSP1) do { \
            const bool last = ((t) == nt - 2); \
            const char* a1 = cA + (size_t)((t) + 1) * kstep; \
            const char* a2 = last ? nA : cA + (size_t)((t) + 2) * kstep; const char* b2 = last ? nB : cB + (size_t)((t) + 2) * kstep; \
            const char* a3 = a2 + kstep; const char* b3 = b2 + kstep; \
            if (last && has_next) S.a_ready(nxt); \
            PG8_LDB(B0, 0, 0); PG8_LDB(B1, 0, 1); PG8_SCHED; PG8_LDA(At, 0, 0); if (!(NOSP1)) PG8_STAGE_A(PG8_SA(1, 1), a1, 1, aoC0, aoC1); \
            if constexpr (GATHER) { if (last && has_next) { \
                _Pragma("unroll") for (int i = 0; i < 2; ++i) { int R, C; stage_rc(tid * 16 + i * 8192, R, C); \
                    const unsigned i0 = *(const PG8_LAS unsigned*)(idx_lds + (2 * i) * 256 + lane * 4), i1 = *(const PG8_LAS unsigned*)(idx_lds + (2 * i + 1) * 256 + lane * 4); \
                    aoC0[i] = i0 * (unsigned)Kb + (unsigned)(C * 2); aoC1[i] = i1 * (unsigned)Kb + (unsigned)(C * 2); } } } \
            PG8_WAIT_VN(W1); PG8_WAIT_L(0); PG8_BAR; PG8_MMA(0, 0, At, B0); PG8_MMA(0, 1, At, B1); PG8_BAR; PG8_SCHED; \
            PG8_LDA(At, 0, 1); PG8_STAGE(PG8_SB(0, 0), b2, voffB); PG8_STAGE(PG8_SB(0, 1), b2 + hstep, voffB); PG8_STAGE_A(PG8_SA(0, 0), a2, 0, aoC0, aoC1); \
            PG8_WAIT_VN(W2); PG8_WAIT_L(0); PG8_BAR; PG8_MMA(1, 0, At, B0); PG8_MMA(1, 1, At, B1); PG8_BAR; PG8_SCHED; \
            PG8_LDB(B0, 1, 0); PG8_LDB(B1, 1, 1); PG8_SCHED; PG8_LDA(At, 1, 0); PG8_STAGE_A(PG8_SA(0, 1), a2, 1, aoC0, aoC1); \
            PG8_WAIT_VN(W3); PG8_WAIT_L(0); PG8_BAR; PG8_MMA(0, 0, At, B0); PG8_MMA(0, 1, At, B1); PG8_BAR; PG8_SCHED; \
            PG8_LDA(At, 1, 1); PG8_STAGE(PG8_SB(1, 0), b3, voffB); PG8_STAGE(PG8_SB(1, 1), b3 + hstep, voffB); PG8_STAGE_A(PG8_SA(1, 0), a3, 0, aoC0, aoC1); \
            PG8_WAIT_VN(8); PG8_WAIT_L(0); PG8_BAR; PG8_MMA(1, 0, At, B0); PG8_MMA(1, 1, At, B1); PG8_BAR; PG8_SCHED; \
            if (last && has_next) PG8_STAGE_A(PG8_SA(1, 1), a3, 1, aoC0, aoC1);        \
        } while (0)
        int tbeg = 0;
        if (ui > 0) { PG8_TRIP(0, 8 + Epi::NST, 8 + Epi::NST, 8 + Epi::NST, true); tbeg = 2; }
#pragma clang loop unroll(disable)
        for (int t = tbeg; t < nt; t += 2) { PG8_TRIP(t, 8, 8, 8, false); }
#undef PG8_TRIP
        if constexpr (ALIGN_EPI) { if (wr == 0) PG8_BAR; }
        if constexpr (DT != 0) asm volatile("s_nop 15\n\ts_nop 15" ::: "memory");
        if constexpr (DT == 2) {
#pragma unroll
            for (int a = 0; a < 2; ++a)
#pragma unroll
                for (int b = 0; b < 2; ++b)
#pragma unroll
                    for (int m = 0; m < 4; ++m)
#pragma unroll
                        for (int n = 0; n < 2; ++n) { const v4i_t ci = __builtin_bit_cast(v4i_t, acc[a][b][m][n]); acc[a][b][m][n] = (f32x4){(float)ci[0], (float)ci[1], (float)ci[2], (float)ci[3]}; } }
        if constexpr (!Epi::AFTER_DRAIN) { E(acc, cur, wr, wc, fr, fq, scal_lds); S.done(cur); }
        if (!has_next) break;
#pragma unroll
        for (int a = 0; a < 2; ++a)
#pragma unroll
            for (int b = 0; b < 2; ++b)
#pragma unroll
                for (int m = 0; m < 4; ++m)
#pragma unroll
                    for (int n = 0; n < 2; ++n) { acc[a][b][m][n] = (f32x4){0.f, 0.f, 0.f, 0.f}; asm volatile("" : "+v"(acc[a][b][m][n])); }
        cur = nxt; cA = nA; cB = nB; ++ui;
        if constexpr (DT != 0) asm volatile("s_nop 7" ::: "memory");
        if constexpr (ALIGN_EPI) { if (wr == 1) PG8_BAR; }
    }
    PG8_WAIT_V(0);
    if constexpr (!ALIGN_EPI) { if (wr == 0) PG8_BAR; }
    PG8_BAR;
#undef PG8_SA
#undef PG8_SB
#undef PG8_STAGE
#undef PG8_STAGE_A
#undef PG8_LDA
#undef PG8_LDB
#undef PG8_MMA
#undef PG8_LD8
#undef PG8_LO
#undef PG8_HI
#undef PG8_WAIT_V
#undef PG8_WAIT_VN
#undef PG8_WAIT_L
#undef PG8_BAR
#undef PG8_SCHED
}
}

using pg8::bf16x8; using pg8::f32x4; using pg8::f32x2; using pg8::u32x4; using pg8::u32x2;
typedef unsigned short bf16;
#define LAS __attribute__((address_space(3)))
constexpr int D = 1024, NB = 32, SEQ = 2048, CTXL = 256, DEPTH = 4;
constexpr int MC = NB * CTXL, ML = NB * SEQ, MT = MC + ML;
constexpr int INW = 2816, DFF = 2816, NE = 8;
constexpr int NWAVES = 8, NTHR = 512;
constexpr float EPS = 1e-6f;
constexpr int NPH = 10;
constexpr int SLAB_TILES = 292;
constexpr float CSC = 8.0f, WSCO = 64.0f;
constexpr float WSC2 = 64.0f, HSC = 4.0f;
constexpr int MAX_SLOTS = 2 * MT + 8 * 256;

constexpr size_t MiB = 1u << 20;
constexpr size_t WS_CTL = 0, CTL_BYTES = 2 * MiB;
constexpr size_t WS_MOD = 2 * MiB;
constexpr size_t WS_ROPE = 6 * MiB;
constexpr size_t WS_SMALLW = 7 * MiB;
constexpr size_t WS_TOKINFO = 9 * MiB;
constexpr size_t WS_TOKSLOT = 11 * MiB;
constexpr size_t WS_SLOTTOK = 12 * MiB;
constexpr size_t WS_XCTX = 13 * MiB;
constexpr size_t WS_W = 45 * MiB;
constexpr size_t W_WIN = 0, W_WOUT = 3 * MiB, W_FFN = 5 * MiB;
constexpr size_t W13_BYTES = (size_t)2 * DFF * D, W2_BYTES = (size_t)D * DFF;
constexpr size_t WS_A = 119 * MiB;
constexpr size_t WS_XL = 191 * MiB;
constexpr size_t WS_A_OLD_UNUSED = 0;
constexpr size_t WS_R = 319 * MiB;
constexpr size_t WS_B = 715 * MiB;
constexpr size_t WS_Y = 859 * MiB;
constexpr size_t WS_END = 1003 * MiB;
constexpr size_t Y_SBUF = 0, Y_TLRU = 56 * MiB;
constexpr size_t MOE_YSLOT = WS_R, MOE_HID = WS_R + 292 * MiB;
static_assert(W_FFN + 8 * (W13_BYTES + W2_BYTES) <= WS_A - WS_W, "weights region");
static_assert((size_t)MAX_SLOTS * D * 2 <= 292 * MiB && MOE_HID + (size_t)SLAB_TILES * 256 * DFF <= WS_END, "moe scratch");
static_assert((size_t)NB * 6 * 2 * 18 * 4096 * 2 <= 56 * MiB && Y_TLRU + (size_t)MT * 384 * 2 <= 144 * MiB, "mixer scratch in Y");

constexpr int CW_QUEUE = 64;
constexpr int CW_GCNT = 3072;
constexpr int CW_GPOS = 3328;
constexpr int CW_BAR = 4096;

constexpr int RING_BYTES = 131072;
constexpr int LDS_BYTES = 155648;
constexpr int MISC_OFF = LDS_BYTES - 512;

__device__ __forceinline__ float bf_lo(unsigned w) { return __uint_as_float(w << 16); }
__device__ __forceinline__ float bf_hi(unsigned w) { return __uint_as_float(w & 0xffff0000u); }
__device__ __forceinline__ unsigned pk2(float lo, float hi) { return pg8::cvt_pk_bf16(lo, hi); }
__device__ __forceinline__ float fexp2(float x) { return __builtin_amdgcn_exp2f(x); }
__device__ __forceinline__ float fexp(float x) { return __builtin_amdgcn_exp2f(1.44269504f * x); }
__device__ __forceinline__ float sigm(float x) { return __builtin_amdgcn_rcpf(1.0f + fexp(-x)); }
__device__ __forceinline__ float silu_f(float x) { return x * sigm(x); }
__device__ __forceinline__ float gelu_t(float x) { const float u = 0.7978845608f * (x + 0.044715f * x * x * x); return x * sigm(2.0f * u); }
__device__ __forceinline__ unsigned pk4f8(float a, float b, float c, float d, float sc) {
    unsigned t = 0u;
    t = __builtin_amdgcn_cvt_pk_fp8_f32(__builtin_amdgcn_fmed3f(a * sc, -448.0f, 448.0f), __builtin_amdgcn_fmed3f(b * sc, -448.0f, 448.0f), t, false);
    t = __builtin_amdgcn_cvt_pk_fp8_f32(__builtin_amdgcn_fmed3f(c * sc, -448.0f, 448.0f), __builtin_amdgcn_fmed3f(d * sc, -448.0f, 448.0f), t, true);
    return t;
}
template <int CTRL> __device__ __forceinline__ float dpp_mov(float v) { return __builtin_bit_cast(float, __builtin_amdgcn_update_dpp(0, __builtin_bit_cast(int, v), CTRL, 0xF, 0xF, false)); }
__device__ __forceinline__ float lane_rd(float v, int l) { return __builtin_bit_cast(float, __builtin_amdgcn_readlane(__builtin_bit_cast(int, v), l)); }
__device__ __forceinline__ float wave_sum(float v) {
    v += dpp_mov<0xB1>(v); v += dpp_mov<0x4E>(v); v += dpp_mov<0x141>(v); v += dpp_mov<0x140>(v);
    return (lane_rd(v, 0) + lane_rd(v, 16)) + (lane_rd(v, 32) + lane_rd(v, 48));
}
__device__ __forceinline__ float wave_max(float v) {
    v = fmaxf(v, dpp_mov<0xB1>(v)); v = fmaxf(v, dpp_mov<0x4E>(v)); v = fmaxf(v, dpp_mov<0x141>(v)); v = fmaxf(v, dpp_mov<0x140>(v));
    return fmaxf(fmaxf(lane_rd(v, 0), lane_rd(v, 16)), fmaxf(lane_rd(v, 32), lane_rd(v, 48)));
}
__device__ __forceinline__ f32x4 mfma16(bf16x8 a, bf16x8 b, f32x4 c) { return __builtin_amdgcn_mfma_f32_16x16x32_bf16(a, b, c, 0, 0, 0); }
__device__ __forceinline__ bf16x8 ld16g(const bf16* p) { return __builtin_bit_cast(bf16x8, *(const u32x4*)p); }
__device__ __forceinline__ bf16x8 ld16l(const LAS bf16* p) { return __builtin_bit_cast(bf16x8, *(const LAS u32x4*)p); }

#define XB_TMO      128
#define XB_XCNT(j)  (256  + 64 * (j))
#define XB_XSUB(j)  (1280 + 64 * (j))
#define XB_XGEN(j)  (2304 + 64 * (j))
#define XB_TOP      3328
#define XB_TOPGEN   3392
#define XCD_BAR_WORDS 3456
#define XB_SPIN_CAP (1u << 18)
__device__ __forceinline__ unsigned xb_ld(unsigned* p)              { return __hip_atomic_load(p, __ATOMIC_RELAXED, __HIP_MEMORY_SCOPE_AGENT); }
__device__ __forceinline__ unsigned xb_add(unsigned* p, unsigned v) { return __hip_atomic_fetch_add(p, v, __ATOMIC_RELAXED, __HIP_MEMORY_SCOPE_AGENT); }
__device__ __forceinline__ unsigned xb_xcc_id() { return (unsigned)__builtin_amdgcn_s_getreg((3 << 11) | 20) & 0xFu; }
#define XB_SPIN(cond, bar) do { unsigned _sp = 0; while (cond) { __builtin_amdgcn_s_sleep(1); \
    if ((++_sp & 255u) == 0u) { if (xb_ld(&(bar)[XB_TMO])) break; if (_sp > XB_SPIN_CAP) { atomicAdd(&(bar)[XB_TMO], 1u); break; } } } } while (0)
struct XcdBarrier { unsigned* bar; unsigned x; volatile LAS unsigned* st; };
__device__ __forceinline__ bool fresh_t0(int wave0) { int l; asm volatile("v_mbcnt_lo_u32_b32 %0, -1, 0\n\tv_mbcnt_hi_u32_b32 %0, -1, %0" : "=v"(l)); return wave0 == 0 && l == 0; }
__device__ __forceinline__ XcdBarrier xcd_barrier_post(unsigned* bar, volatile LAS unsigned* st) {
    XcdBarrier b; b.bar = bar; b.x = xb_xcc_id(); b.st = st;
    if (threadIdx.x == 0) (void)xb_add(&bar[XB_XCNT(b.x)], 1u);
    return b;
}
__device__ __forceinline__ void xcd_barrier_complete(unsigned* bar, unsigned x, unsigned& nloc, unsigned& nx) {
    const unsigned G = gridDim.x * gridDim.y * gridDim.z;
    unsigned sum, cnt, mine, sp = 0u;
    for (;;) {
        sum = 0u; cnt = 0u; mine = 0u;
#pragma unroll
        for (unsigned j = 0; j < 16; ++j) { const unsigned c = xb_ld(&bar[XB_XCNT(j)]); sum += c; cnt += (c > 0u) ? 1u : 0u; mine = (j == x) ? c : mine; }
        if (sum == G) break;
        __builtin_amdgcn_s_sleep(1);
        if ((++sp & 255u) == 0u) { if (xb_ld(&bar[XB_TMO])) break; if (sp > XB_SPIN_CAP) { atomicAdd(&bar[XB_TMO], 1u); break; } }
    }
    nloc = mine > 0u ? mine : 1u; nx = cnt > 0u ? cnt : 1u;
}
__device__ __forceinline__ void xcd_barrier(const XcdBarrier& b, const bool t0) {
    asm volatile("s_waitcnt vmcnt(0)" ::: "memory");
    __syncthreads();
    if (t0) {
        unsigned* bar = b.bar;
        __builtin_amdgcn_s_waitcnt(0);
        unsigned nloc = b.st[0], nx = b.st[1];
        if (nloc == 0u) { xcd_barrier_complete(bar, b.x, nloc, nx); b.st[0] = nloc; b.st[1] = nx; }
        const unsigned old = xb_add(&bar[XB_XSUB(b.x)], 1u);
        const unsigned gen = old / nloc;
        if (old + 1u == (gen + 1u) * nloc) {
            __builtin_amdgcn_fence(__ATOMIC_RELEASE, "agent");
            asm volatile("s_waitcnt vmcnt(0)" ::: "memory");
            const unsigned og = xb_add(&bar[XB_TOP], 1u);
            const unsigned tg = og / nx;
            if (og + 1u == (tg + 1u) * nx) xb_add(&bar[XB_TOPGEN], 1u);
            else XB_SPIN(xb_ld(&bar[XB_TOPGEN]) == tg, bar);
            __builtin_amdgcn_fence(__ATOMIC_ACQUIRE, "agent");
            xb_add(&bar[XB_XGEN(b.x)], 1u);
            asm volatile("s_waitcnt vmcnt(0)" ::: "memory");
        } else {
            XB_SPIN(xb_ld(&bar[XB_XGEN(b.x)]) == gen, bar);
            __builtin_amdgcn_fence(__ATOMIC_ACQUIRE, "agent");
            asm volatile("s_waitcnt vmcnt(0)" ::: "memory");
        }
    }
    __syncthreads();
}

__device__ __forceinline__ void transpose_item(const float* W, int N, bf16* WT, int Kp, int k0, int n0, int drow0, LAS float* scr, int lane) {
    { f32x4 v[8];
#pragma unroll
      for (int i = 0; i < 8; ++i) v[i] = *(const f32x4*)(W + (size_t)(k0 + 8 * i + (lane >> 3)) * N + n0 + 4 * (lane & 7));
#pragma unroll
      for (int i = 0; i < 8; ++i) { LAS float* d = scr + (8 * i + (lane >> 3)) * 33 + 4 * (lane & 7); d[0] = v[i][0]; d[1] = v[i][1]; d[2] = v[i][2]; d[3] = v[i][3]; } }
    asm volatile("s_waitcnt lgkmcnt(0)" ::: "memory");
    const int c = lane & 7;
#pragma unroll
    for (int j = 0; j < 4; ++j) { const int n = (lane >> 3) + 8 * j; const LAS float* s = scr + (8 * c) * 33 + n;
        u32x4 o; o.x = pk2(s[0 * 33], s[1 * 33]); o.y = pk2(s[2 * 33], s[3 * 33]); o.z = pk2(s[4 * 33], s[5 * 33]); o.w = pk2(s[6 * 33], s[7 * 33]);
        *(u32x4*)(WT + (size_t)(drow0 + n) * Kp + k0 + 8 * c) = o; }
    asm volatile("s_waitcnt lgkmcnt(0)" ::: "memory");
}
__device__ __forceinline__ void transpose_item8(const float* W, int N, unsigned char* WT, int Kp, int k0, int n0, int drow0, float sc, LAS float* scr, int lane) {
    { f32x4 v[8];
#pragma unroll
      for (int i = 0; i < 8; ++i) v[i] = *(const f32x4*)(W + (size_t)(k0 + 8 * i + (lane >> 3)) * N + n0 + 4 * (lane & 7));
#pragma unroll
      for (int i = 0; i < 8; ++i) { LAS float* d = scr + (8 * i + (lane >> 3)) * 33 + 4 * (lane & 7); d[0] = v[i][0]; d[1] = v[i][1]; d[2] = v[i][2]; d[3] = v[i][3]; } }
    asm volatile("s_waitcnt lgkmcnt(0)" ::: "memory");
    const int c = lane & 7;
#pragma unroll
    for (int j = 0; j < 4; ++j) { const int n = (lane >> 3) + 8 * j; const LAS float* sp = scr + (8 * c) * 33 + n;
        u32x2 o; unsigned t = 0u;
        float q8[8];
#pragma unroll
        for (int k = 0; k < 8; ++k) q8[k] = __builtin_amdgcn_fmed3f(sp[k * 33] * sc, -448.0f, 448.0f);
        t = __builtin_amdgcn_cvt_pk_fp8_f32(q8[0], q8[1], t, false); t = __builtin_amdgcn_cvt_pk_fp8_f32(q8[2], q8[3], t, true); o.x = t;
        t = __builtin_amdgcn_cvt_pk_fp8_f32(q8[4], q8[5], t, false); t = __builtin_amdgcn_cvt_pk_fp8_f32(q8[6], q8[7], t, true); o.y = t;
        *(u32x2*)(WT + (size_t)(drow0 + n) * Kp + k0 + 8 * c) = o; }
    asm volatile("s_waitcnt lgkmcnt(0)" ::: "memory");
}
__device__ __forceinline__ void conv_i8_item(const float* W, int N, signed char* WT, float* SW, int n0, int drow0, LAS float* scr, int lane) {
    const int cg = lane & 7, rg = lane >> 3;
    const float* wp = W + n0 + 4 * cg;
    f32x4 mx = (f32x4){0.f, 0.f, 0.f, 0.f};
#pragma unroll 16
    for (int i = 0; i < D / 8; ++i) { const f32x4 v = *(const f32x4*)(wp + (size_t)(8 * i + rg) * N); mx[0] = fmaxf(mx[0], fabsf(v[0])); mx[1] = fmaxf(mx[1], fabsf(v[1])); mx[2] = fmaxf(mx[2], fabsf(v[2])); mx[3] = fmaxf(mx[3], fabsf(v[3])); }
#pragma unroll
    for (int o = 8; o < 64; o <<= 1) { mx[0] = fmaxf(mx[0], __shfl_xor(mx[0], o)); mx[1] = fmaxf(mx[1], __shfl_xor(mx[1], o)); mx[2] = fmaxf(mx[2], __shfl_xor(mx[2], o)); mx[3] = fmaxf(mx[3], __shfl_xor(mx[3], o)); }
    f32x4 inv;
#pragma unroll
    for (int j = 0; j < 4; ++j) inv[j] = mx[j] > 0.f ? 127.0f / mx[j] : 0.f;
    if (lane < 8) *(f32x4*)(SW + drow0 + 4 * lane) = mx * (1.0f / 127.0f);
    for (int kb2 = 0; kb2 < D / 64; kb2 += 2) {
        f32x4 v[2][8];
#pragma unroll
        for (int h = 0; h < 2; ++h)
#pragma unroll
            for (int i = 0; i < 8; ++i) v[h][i] = *(const f32x4*)(wp + (size_t)(64 * (kb2 + h) + 8 * i + rg) * N);
#pragma unroll
        for (int h = 0; h < 2; ++h) { const int kb = kb2 + h;
#pragma unroll
            for (int i = 0; i < 8; ++i) { LAS float* d = scr + (8 * i + rg) * 33 + 4 * cg; d[0] = v[h][i][0] * inv[0]; d[1] = v[h][i][1] * inv[1]; d[2] = v[h][i][2] * inv[2]; d[3] = v[h][i][3] * inv[3]; }
            asm volatile("s_waitcnt lgkmcnt(0)" ::: "memory");
            const int c = lane & 7;
#pragma unroll
            for (int j = 0; j < 4; ++j) { const int n = (lane >> 3) + 8 * j; const LAS float* sp = scr + (8 * c) * 33 + n;
                unsigned q[8];
#pragma unroll
                for (int t = 0; t < 8; ++t) q[t] = (unsigned)(int)rintf(sp[t * 33]) & 0xffu;
                u32x2 o; o.x = q[0] | (q[1] << 8) | (q[2] << 16) | (q[3] << 24); o.y = q[4] | (q[5] << 8) | (q[6] << 16) | (q[7] << 24);
                *(u32x2*)(WT + (size_t)(drow0 + n) * D + 64 * kb + 8 * c) = o; }
            asm volatile("s_waitcnt lgkmcnt(0)" ::: "memory"); }
    }
}
__device__ __forceinline__ void conv_i8_item_wg(const float* W, int N, signed char* WT, float* SW, int n0, int drow0, LAS float* scr, LAS float* mxs, int wave, int lane) {
    const int cg = lane & 7, rg = lane >> 3;
    const float* wp = W + n0 + 4 * cg;
    f32x4 mx = (f32x4){0.f, 0.f, 0.f, 0.f};
#pragma unroll
    for (int i = 0; i < 16; ++i) { const f32x4 v = *(const f32x4*)(wp + (size_t)(128 * wave + 8 * i + rg) * N); mx[0] = fmaxf(mx[0], fabsf(v[0])); mx[1] = fmaxf(mx[1], fabsf(v[1])); mx[2] = fmaxf(mx[2], fabsf(v[2])); mx[3] = fmaxf(mx[3], fabsf(v[3])); }
#pragma unroll
    for (int o = 8; o < 64; o <<= 1) { mx[0] = fmaxf(mx[0], __shfl_xor(mx[0], o)); mx[1] = fmaxf(mx[1], __shfl_xor(mx[1], o)); mx[2] = fmaxf(mx[2], __shfl_xor(mx[2], o)); mx[3] = fmaxf(mx[3], __shfl_xor(mx[3], o)); }
    if (lane < 8) *(LAS f32x4*)(mxs + wave * 32 + 4 * lane) = mx;
    __syncthreads();
#pragma unroll
    for (int w = 0; w < 8; ++w) { const f32x4 o = *(const LAS f32x4*)(mxs + w * 32 + 4 * cg); mx[0] = fmaxf(mx[0], o[0]); mx[1] = fmaxf(mx[1], o[1]); mx[2] = fmaxf(mx[2], o[2]); mx[3] = fmaxf(mx[3], o[3]); }
    f32x4 inv;
#pragma unroll
    for (int j = 0; j < 4; ++j) inv[j] = mx[j] > 0.f ? 127.0f / mx[j] : 0.f;
    if (wave == 0 && lane < 8) *(f32x4*)(SW + drow0 + 4 * lane) = mx * (1.0f / 127.0f);
    f32x4 v[2][8];
#pragma unroll
    for (int h = 0; h < 2; ++h)
#pragma unroll
        for (int i = 0; i < 8; ++i) v[h][i] = *(const f32x4*)(wp + (size_t)(64 * (2 * wave + h) + 8 * i + rg) * N);
#pragma unroll
    for (int h = 0; h < 2; ++h) { const int kb = 2 * wave + h;
#pragma unroll
        for (int i = 0; i < 8; ++i) { LAS float* d = scr + (8 * i + rg) * 33 + 4 * cg; d[0] = v[h][i][0] * inv[0]; d[1] = v[h][i][1] * inv[1]; d[2] = v[h][i][2] * inv[2]; d[3] = v[h][i][3] * inv[3]; }
        asm volatile("s_waitcnt lgkmcnt(0)" ::: "memory");
        const int c = lane & 7;
#pragma unroll
        for (int j = 0; j < 4; ++j) { const int n = (lane >> 3) + 8 * j; const LAS float* sp = scr + (8 * c) * 33 + n;
            unsigned q[8];
#pragma unroll
            for (int t = 0; t < 8; ++t) q[t] = (unsigned)(int)rintf(sp[t * 33]) & 0xffu;
            u32x2 o; o.x = q[0] | (q[1] << 8) | (q[2] << 16) | (q[3] << 24); o.y = q[4] | (q[5] << 8) | (q[6] << 16) | (q[7] << 24);
            *(u32x2*)(WT + (size_t)(drow0 + n) * D + 64 * kb + 8 * c) = o; }
        asm volatile("s_waitcnt lgkmcnt(0)" ::: "memory");
    }
    __syncthreads();
}
template <bool FP8>
__device__ __forceinline__ void transpose_quad(const float* W, int N, void* WTv, int Kp, int k0, int n0, int drow0, float sc, LAS float* scr, int lane) {
    f32x4 v[4][8];
#pragma unroll
    for (int q = 0; q < 4; ++q)
#pragma unroll
        for (int i = 0; i < 8; ++i) v[q][i] = *(const f32x4*)(W + (size_t)(k0 + 8 * i + (lane >> 3)) * N + n0 + 32 * q + 4 * (lane & 7));
    const int c = lane & 7;
#pragma unroll
    for (int q = 0; q < 4; ++q) {
#pragma unroll
        for (int i = 0; i < 8; ++i) { LAS float* d = scr + (8 * i + (lane >> 3)) * 33 + 4 * (lane & 7); d[0] = v[q][i][0]; d[1] = v[q][i][1]; d[2] = v[q][i][2]; d[3] = v[q][i][3]; }
        asm volatile("s_waitcnt lgkmcnt(0)" ::: "memory");
#pragma unroll
        for (int j = 0; j < 4; ++j) { const int n = (lane >> 3) + 8 * j; const LAS float* sp = scr + (8 * c) * 33 + n;
            if constexpr (FP8) {
                u32x2 o; unsigned t = 0u; float q8[8];
#pragma unroll
                for (int k = 0; k < 8; ++k) q8[k] = __builtin_amdgcn_fmed3f(sp[k * 33] * sc, -448.0f, 448.0f);
                t = __builtin_amdgcn_cvt_pk_fp8_f32(q8[0], q8[1], t, false); t = __builtin_amdgcn_cvt_pk_fp8_f32(q8[2], q8[3], t, true); o.x = t;
                t = __builtin_amdgcn_cvt_pk_fp8_f32(q8[4], q8[5], t, false); t = __builtin_amdgcn_cvt_pk_fp8_f32(q8[6], q8[7], t, true); o.y = t;
                *(u32x2*)((unsigned char*)WTv + (size_t)(drow0 + 32 * q + n) * Kp + k0 + 8 * c) = o;
            } else {
                u32x4 o; o.x = pk2(sp[0 * 33], sp[1 * 33]); o.y = pk2(sp[2 * 33], sp[3 * 33]); o.z = pk2(sp[4 * 33], sp[5 * 33]); o.w = pk2(sp[6 * 33], sp[7 * 33]);
                *(u32x4*)((bf16*)WTv + (size_t)(drow0 + 32 * q + n) * Kp + k0 + 8 * c) = o; } }
        asm volatile("s_waitcnt lgkmcnt(0)" ::: "memory");
    }
}
__device__ __forceinline__ void conv_plain(const float* W, int K, int N, bf16* WT, int item, LAS float* scr, int lane) {
    const int nblk = N / 32, kb = item / nblk, nb = item % nblk;
    transpose_item(W, N, WT, K, 64 * kb, 32 * nb, 32 * nb, scr, lane);
}
__device__ __forceinline__ void conv_w2(const float* W, unsigned char* WT, int item, LAS float* scr, int lane) {
    const int nblk = D / 32, kb = item / nblk, nb = item % nblk;
    transpose_item8(W, D, WT, DFF, 64 * kb, 32 * nb, 32 * nb, WSC2, scr, lane);
}

struct Params {
    const float* in[31];
    float* out;
    unsigned char* ws;
    int l_lo, l_hi, ph_lo, ph_hi, bar_region, slab_cap;
};

template <int MODE, bool XIN32>
__device__ __forceinline__ void row_issue(int m, const void* xin_ctx, const void* xin_lat, const bf16* Y, const bf16* yslot, int2 sl, int lane, f32x4 (&x)[4], u32x2 (&xb)[4], u32x2 (&ya)[4], u32x2 (&yb)[4]) {
    if (XIN32) { const float* xi = (m < MC) ? (const float*)xin_ctx + (size_t)m * D : (const float*)xin_lat + (size_t)(m - MC) * D;
#pragma unroll
        for (int j = 0; j < 4; ++j) x[j] = __builtin_nontemporal_load((const f32x4*)(xi + 4 * lane + 256 * j)); }
    else { const bf16* xi = (m < MC) ? (const bf16*)xin_ctx + (size_t)m * D : (const bf16*)xin_lat + (size_t)(m - MC) * D;
#pragma unroll
        for (int j = 0; j < 4; ++j) xb[j] = __builtin_nontemporal_load((const u32x2*)(xi + 4 * lane + 256 * j)); }
    if (MODE == 1) { const bf16* yr = Y + (size_t)m * D;
#pragma unroll
        for (int j = 0; j < 4; ++j) ya[j] = __builtin_nontemporal_load((const u32x2*)(yr + 4 * lane + 256 * j)); }
    if (MODE == 2) { const bf16* y1 = yslot + (size_t)sl.x * D; const bf16* y2 = yslot + (size_t)sl.y * D;
#pragma unroll
        for (int j = 0; j < 4; ++j) { ya[j] = __builtin_nontemporal_load((const u32x2*)(y1 + 4 * lane + 256 * j)); yb[j] = __builtin_nontemporal_load((const u32x2*)(y2 + 4 * lane + 256 * j)); } }
}
template <int MODE, bool ROUTER, bool WRITE_H, bool XIN32, bool XOUT32>
__device__ __forceinline__ void row_phase(float* SA, const void* xin_ctx, const void* xin_lat, void* xo_ctx, void* xo_lat,
                                          const bf16* Y, const bf16* yslot, const uint4* tokinfo, const int2* tokslot,
                                          const float* gpost, const float* gpre, const float* modl, int o_gt, int o_sh, int o_sc,
                                          bf16* Aout, const float* router_w, uint4* tokinfo_out, LAS unsigned* lcnt, unsigned* gcnt,
                                          int m_lo, int m_hi, int G, int bid, int wave, int lane, int tid, LAS unsigned char* rw_lds = nullptr) {
    const int nw = G * NWAVES, gw = bid * NWAVES + wave;
    const int per = (m_hi - m_lo) / nw;
    const int mbase = m_lo + gw * per;
    f32x4 gq[4], gp[4];
#pragma unroll
    for (int j = 0; j < 4; ++j) { gp[j] = *(const f32x4*)(gpre + 4 * lane + 256 * j); if (MODE != 0) gq[j] = *(const f32x4*)(gpost + 4 * lane + 256 * j); else gq[j] = (f32x4){0.f, 0.f, 0.f, 0.f}; }
    LAS float* RW = (LAS float*)rw_lds;
    if (ROUTER) { if (tid < 8) lcnt[tid] = 0u;
        for (int i = tid; i < D * 8; i += NTHR) RW[(i & 7) * D + (i >> 3)] = router_w[i];
        __syncthreads(); }
    int mrow_cur = -1; f32x4 vgt[4], vsh[4], vsc[4];
#pragma unroll
    for (int j = 0; j < 4; ++j) { vgt[j] = (f32x4){0.f, 0.f, 0.f, 0.f}; vsh[j] = vgt[j]; vsc[j] = vgt[j]; }
    f32x4 xn[4]; u32x2 xbn[4], yan[4], ybn[4]; int2 sl_n2 = make_int2(0, 0); uint4 ti_c = make_uint4(0, 0, 0, 0), ti_n = ti_c;
#pragma unroll
    for (int j = 0; j < 4; ++j) { xn[j] = (f32x4){0.f, 0.f, 0.f, 0.f}; yan[j] = (u32x2){0u, 0u}; ybn[j] = yan[j]; xbn[j] = yan[j]; }
    { int2 sl0 = make_int2(0, 0); if (MODE == 2) { sl0 = tokslot[mbase]; ti_n = tokinfo[mbase]; if (per > 1) sl_n2 = tokslot[mbase + 1]; }
      row_issue<MODE, XIN32>(mbase, xin_ctx, xin_lat, Y, yslot, sl0, lane, xn, xbn, yan, ybn); }
    for (int i = 0; i < per; ++i) {
        const int m = mbase + i;
        f32x4 x[4]; u32x2 ya[4], yb[4];
#pragma unroll
        for (int j = 0; j < 4; ++j) { if (XIN32) x[j] = xn[j]; else x[j] = (f32x4){bf_lo(xbn[j].x), bf_hi(xbn[j].x), bf_lo(xbn[j].y), bf_hi(xbn[j].y)}; ya[j] = yan[j]; yb[j] = ybn[j]; }
        ti_c = ti_n;
        if (i + 1 < per) { const int2 sl1 = sl_n2; if (MODE == 2) { ti_n = tokinfo[m + 1]; if (i + 2 < per) sl_n2 = tokslot[m + 2]; }
            row_issue<MODE, XIN32>(m + 1, xin_ctx, xin_lat, Y, yslot, sl1, lane, xn, xbn, yan, ybn); }
        const bool isctx = m < MC;
        const int mrow = isctx ? 32 : ((m - MC) >> 11);
        if (mrow != mrow_cur) { mrow_cur = mrow; const float* mp = modl + (size_t)mrow * 6144;
#pragma unroll
            for (int j = 0; j < 4; ++j) { if (MODE != 0) vgt[j] = *(const f32x4*)(mp + o_gt + 4 * lane + 256 * j); vsh[j] = *(const f32x4*)(mp + o_sh + 4 * lane + 256 * j); vsc[j] = *(const f32x4*)(mp + o_sc + 4 * lane + 256 * j); } }
        if (MODE != 0) {
            f32x4 y[4];
            if (MODE == 1) {
#pragma unroll
                for (int j = 0; j < 4; ++j) y[j] = (f32x4){bf_lo(ya[j].x), bf_hi(ya[j].x), bf_lo(ya[j].y), bf_hi(ya[j].y)};
            } else {
                const float w1 = __uint_as_float(ti_c.z), w2 = __uint_as_float(ti_c.w);
#pragma unroll
                for (int j = 0; j < 4; ++j) y[j] = (f32x4){w1 * bf_lo(ya[j].x) + w2 * bf_lo(yb[j].x), w1 * bf_hi(ya[j].x) + w2 * bf_hi(yb[j].x), w1 * bf_lo(ya[j].y) + w2 * bf_lo(yb[j].y), w1 * bf_hi(ya[j].y) + w2 * bf_hi(yb[j].y)};
            }
            float ss = 0.f;
#pragma unroll
            for (int j = 0; j < 4; ++j) ss += (y[j][0] * y[j][0] + y[j][1] * y[j][1]) + (y[j][2] * y[j][2] + y[j][3] * y[j][3]);
            const float rs = 1.0f / sqrtf(wave_sum(ss) * (1.0f / D) + EPS);
#pragma unroll
            for (int j = 0; j < 4; ++j) x[j] = x[j] + vgt[j] * (y[j] * rs * gq[j]);
            if (XOUT32) { float* xo = isctx ? (float*)xo_ctx + (size_t)m * D : (float*)xo_lat + (size_t)(m - MC) * D;
#pragma unroll
                for (int j = 0; j < 4; ++j) __builtin_nontemporal_store(x[j], (f32x4*)(xo + 4 * lane + 256 * j)); }
            else { bf16* xo = isctx ? (bf16*)xo_ctx + (size_t)m * D : (bf16*)xo_lat + (size_t)(m - MC) * D;
#pragma unroll
                for (int j = 0; j < 4; ++j) { u32x2 w; w.x = pk2(x[j][0], x[j][1]); w.y = pk2(x[j][2], x[j][3]); __builtin_nontemporal_store(w, (u32x2*)(xo + 4 * lane + 256 * j));
                    x[j] = (f32x4){bf_lo(w.x), bf_hi(w.x), bf_lo(w.y), bf_hi(w.y)}; } }
        }
        if (WRITE_H) {
            float s2 = 0.f;
#pragma unroll
            for (int j = 0; j < 4; ++j) s2 += (x[j][0] * x[j][0] + x[j][1] * x[j][1]) + (x[j][2] * x[j][2] + x[j][3] * x[j][3]);
            const float r2 = 1.0f / sqrtf(wave_sum(s2) * (1.0f / D) + EPS);
            f32x4 h[4]; float amax = 0.f;
#pragma unroll
            for (int j = 0; j < 4; ++j) { h[j] = (x[j] * r2 * gp[j]) * (vsc[j] + 1.0f) + vsh[j]; amax = fmaxf(fmaxf(amax, fmaxf(fabsf(h[j][0]), fabsf(h[j][1]))), fmaxf(fabsf(h[j][2]), fabsf(h[j][3]))); }
            amax = wave_max(amax);
            const float qinv = amax > 0.f ? 127.0f / amax : 0.f;
            if (lane == 0) SA[m] = amax * (1.0f / 127.0f);
#pragma unroll
            for (int j = 0; j < 4; ++j) { const unsigned q0 = (unsigned)(int)rintf(h[j][0] * qinv) & 0xffu, q1 = (unsigned)(int)rintf(h[j][1] * qinv) & 0xffu, q2 = (unsigned)(int)rintf(h[j][2] * qinv) & 0xffu, q3 = (unsigned)(int)rintf(h[j][3] * qinv) & 0xffu;
                __builtin_nontemporal_store(q0 | (q1 << 8) | (q2 << 16) | (q3 << 24), (unsigned*)((unsigned char*)Aout + (size_t)m * D + 4 * lane + 256 * j)); }
            if (ROUTER) {
                float lg[8];
#pragma unroll
                for (int e = 0; e < 8; ++e) lg[e] = 0.f;
#pragma unroll
                for (int j = 0; j < 4; ++j)
#pragma unroll
                    for (int e = 0; e < 8; ++e) { const f32x4 r = *(const LAS f32x4*)(RW + e * D + 4 * lane + 256 * j);
                        lg[e] += (h[j][0] * r[0] + h[j][1] * r[1]) + (h[j][2] * r[2] + h[j][3] * r[3]); }
#pragma unroll
                for (int e = 0; e < 8; ++e) lg[e] = wave_sum(lg[e]);
                int e1 = 0; float l1 = lg[0];
#pragma unroll
                for (int e = 1; e < 8; ++e) if (lg[e] > l1) { l1 = lg[e]; e1 = e; }
                int e2 = -1; float l2 = -3.0e38f;
#pragma unroll
                for (int e = 0; e < 8; ++e) if (e != e1 && lg[e] > l2) { l2 = lg[e]; e2 = e; }
                const float w1 = 1.0f / (1.0f + expf(l2 - l1)), w2 = 1.0f - w1;
                if (lane == 0) { tokinfo_out[m] = make_uint4((unsigned)e1, (unsigned)e2, __float_as_uint(w1), __float_as_uint(w2));
                    __hip_atomic_fetch_add(lcnt + e1, 1u, __ATOMIC_RELAXED, __HIP_MEMORY_SCOPE_WORKGROUP); __hip_atomic_fetch_add(lcnt + e2, 1u, __ATOMIC_RELAXED, __HIP_MEMORY_SCOPE_WORKGROUP); }
            }
        }
    }
    if (ROUTER) {
        __syncthreads();
        if (tid < 8) { const unsigned c = lcnt[tid]; if (c) __hip_atomic_fetch_add(gcnt + tid, c, __ATOMIC_RELAXED, __HIP_MEMORY_SCOPE_AGENT); }
    }
}

__device__ __forceinline__ void lru_blk(int half, int s, int& isctx, int& bi) { isctx = s < 4; bi = (half == 0) ? (isctx ? s : s - 4) : (isctx ? 3 - s : 35 - s); }
__device__ __forceinline__ void lru_unit(LAS unsigned char* lds, const bf16* P, bf16* CAT, bf16* TL, const bf16* WaT, const bf16* WxT,
                                         const float* ba, const float* bx, const float* lam, const float* convw, const float* convb,
                                         int b, int hh, bool want_ctx, int tid) {
    const int wave = __builtin_amdgcn_readfirstlane(tid >> 6), lane = tid & 63, fr = lane & 15, fg = lane >> 4;
    const int half = wave >> 2, w4 = wave & 3, tidh = tid & 255;
    LAS unsigned char* hb = lds + half * 59136;
    LAS bf16* Xr = (LAS bf16*)hb;
    LAS bf16* Xc = (LAS bf16*)(hb + 17152);
    LAS f32x2* AU = (LAS f32x2*)(hb + 17152 + 9216);
    LAS float* CW = (LAS float*)(lds + 118272);
    if (tid < 320) CW[tid] = (tid < 256) ? convw[(tid >> 6) * 384 + hh * 64 + (tid & 63)] : convb[hh * 64 + (tid - 256)];
    const bf16* wa = WaT + (size_t)(half * 6 + hh) * 4096; const bf16* wx = WxT + (size_t)(half * 6 + hh) * 4096;
    bf16x8 Ba[4][2], Bx[4][2]; float bav[4], bxv[4], spv[4];
#pragma unroll
    for (int nt = 0; nt < 4; ++nt) {
#pragma unroll
        for (int ks = 0; ks < 2; ++ks) { Ba[nt][ks] = ld16g(wa + (nt * 16 + fr) * 64 + ks * 32 + fg * 8); Bx[nt][ks] = ld16g(wx + (nt * 16 + fr) * 64 + ks * 32 + fg * 8); }
        const int ch = (half * 6 + hh) * 64 + nt * 16 + fr;
        bav[nt] = -1.44269504f * ba[ch]; bxv[nt] = -1.44269504f * bx[ch]; const float lm = lam[ch]; spv[nt] = -8.0f * 1.44269504f * ((lm > 15.f) ? expf(-lm) : log1pf(expf(-lm)));
    }
    float hstate = 0.f;
    u32x4 rr[3];
#define LRU_RAW_LOAD(ISCTX, BI) do { const int seqlen_ = (ISCTX) ? CTXL : SEQ; const size_t m0_ = (ISCTX) ? (size_t)b * CTXL : (size_t)MC + (size_t)b * SEQ; \
        _Pragma("unroll") for (int k = 0; k < 3; ++k) { const int q = tidh + 256 * k, tp = (BI) * 64 - 2 + (q >> 3); rr[k] = (u32x4){0u, 0u, 0u, 0u}; \
            if (q < 536 && tp >= 0 && tp < seqlen_) rr[k] = *(const u32x4*)(P + (m0_ + tp) * INW + hh * 64 + (q & 7) * 8); } } while (0)
#define LRU_RAW_STORE(BUF) do { _Pragma("unroll") for (int k = 0; k < 3; ++k) { const int q = tidh + 256 * k; if (q < 536) *(LAS u32x4*)(Xr + (BUF) * 4288 + q * 8) = rr[k]; } } while (0)
    { int ic, bb; lru_blk(half, 0, ic, bb); LRU_RAW_LOAD(ic, bb); LRU_RAW_STORE(0); }
    __syncthreads();
    for (int s = 0; s < 36; ++s) {
        int isctx, bi; lru_blk(half, s, isctx, bi);
        const size_t m0 = isctx ? (size_t)b * CTXL : (size_t)MC + (size_t)b * SEQ;
        if (s + 1 < 36) { int ic, bb; lru_blk(half, s + 1, ic, bb); LRU_RAW_LOAD(ic, bb); }
        { const int pos = tidh >> 2, cq = tidh & 3; f32x2 acc[8]; const LAS bf16* xr = Xr + (s & 1) * 4288;
#pragma unroll
            for (int c = 0; c < 8; ++c) acc[c] = *(const LAS f32x2*)(CW + 256 + cq * 16 + 2 * c);
#pragma unroll
            for (int j = 0; j < 4; ++j) { const u32x4 a = *(const LAS u32x4*)(xr + (pos + j) * 64 + cq * 16), c2 = *(const LAS u32x4*)(xr + (pos + j) * 64 + cq * 16 + 8);
                const unsigned ww[8] = {a.x, a.y, a.z, a.w, c2.x, c2.y, c2.z, c2.w};
#pragma unroll
                for (int q = 0; q < 8; ++q) acc[q] += *(const LAS f32x2*)(CW + j * 64 + cq * 16 + 2 * q) * (f32x2){bf_lo(ww[q]), bf_hi(ww[q])}; }
            u32x4 o0, o1; o0.x = pk2(acc[0].x, acc[0].y); o0.y = pk2(acc[1].x, acc[1].y); o0.z = pk2(acc[2].x, acc[2].y); o0.w = pk2(acc[3].x, acc[3].y);
            o1.x = pk2(acc[4].x, acc[4].y); o1.y = pk2(acc[5].x, acc[5].y); o1.z = pk2(acc[6].x, acc[6].y); o1.w = pk2(acc[7].x, acc[7].y);
            *(LAS u32x4*)(Xc + pos * 72 + cq * 16) = o0; *(LAS u32x4*)(Xc + pos * 72 + cq * 16 + 8) = o1; }
        __syncthreads();
        const int nb_half = isctx ? 2 : 16; const bool second = (half == 0) ? (bi >= nb_half) : (bi < nb_half);
        const bool emit = want_ctx || !isctx;
        const int opos = tidh >> 2, ocq = tidh & 3; const size_t om = m0 + bi * 64 + opos;
        bf16* tp = TL + om * 384 + hh * 64 + ocq * 16;
        u32x4 t0 = (u32x4){0u, 0u, 0u, 0u}, t1 = t0, y0 = t0, y1 = t0;
        if (emit && second) { t0 = *(const u32x4*)tp; t1 = *(const u32x4*)(tp + 8); const bf16* lp = P + om * INW + 384 + hh * 64 + ocq * 16; y0 = *(const u32x4*)lp; y1 = *(const u32x4*)(lp + 8); }
        { const bf16x8 A0 = ld16l(Xc + (w4 * 16 + fr) * 72 + fg * 8), A1 = ld16l(Xc + (w4 * 16 + fr) * 72 + 32 + fg * 8);
#pragma unroll
            for (int nt = 0; nt < 4; ++nt) {
                f32x4 ga = (f32x4){0.f, 0.f, 0.f, 0.f}, gx = ga;
                ga = mfma16(A0, Ba[nt][0], ga); ga = mfma16(A1, Ba[nt][1], ga); gx = mfma16(A0, Bx[nt][0], gx); gx = mfma16(A1, Bx[nt][1], gx);
#pragma unroll
                for (int pr = 0; pr < 2; ++pr) { const int pos = w4 * 16 + fg * 4 + 2 * pr, ch = nt * 16 + fr;
                    const f32x2 ta = (f32x2){ga[2 * pr], ga[2 * pr + 1]} * (f32x2){-1.44269504f, -1.44269504f} + (f32x2){bav[nt], bav[nt]};
                    const f32x2 tx = (f32x2){gx[2 * pr], gx[2 * pr + 1]} * (f32x2){-1.44269504f, -1.44269504f} + (f32x2){bxv[nt], bxv[nt]};
                    const f32x2 e1 = (f32x2){fexp2(ta.x), fexp2(ta.y)} + (f32x2){1.0f, 1.0f}, e2 = (f32x2){fexp2(tx.x), fexp2(tx.y)} + (f32x2){1.0f, 1.0f};
                    const f32x2 rg = (f32x2){__builtin_amdgcn_rcpf(e1.x), __builtin_amdgcn_rcpf(e1.y)}, ig = (f32x2){__builtin_amdgcn_rcpf(e2.x), __builtin_amdgcn_rcpf(e2.y)};
                    const f32x2 la2 = rg * (f32x2){spv[nt], spv[nt]};
                    const f32x2 a = (f32x2){fexp2(la2.x), fexp2(la2.y)};
                    const f32x2 om1 = (f32x2){1.0f, 1.0f} - a * a;
                    const f32x2 xc = (f32x2){__uint_as_float(((unsigned)Xc[pos * 72 + ch]) << 16), __uint_as_float(((unsigned)Xc[(pos + 1) * 72 + ch]) << 16)};
                    const f32x2 u = (f32x2){__builtin_amdgcn_sqrtf(om1.x), __builtin_amdgcn_sqrtf(om1.y)} * (ig * xc);
                    AU[pos * 64 + ch] = (f32x2){a.x, u.x}; AU[(pos + 1) * 64 + ch] = (f32x2){a.y, u.y}; } } }
        __syncthreads();
        if (w4 == 0) {
            LAS f32x2* aup = AU + lane;
#define LRU_SCAN(POS) do { \
                _Pragma("unroll") for (int bb = 0; bb < 4; ++bb) { f32x2 cu[16]; float hs[16]; \
                    _Pragma("unroll") for (int k = 0; k < 16; ++k) cu[k] = aup[(POS(16 * bb + k)) * 64]; \
                    _Pragma("unroll") for (int k = 0; k < 16; ++k) { hstate = cu[k].x * hstate + cu[k].y; hs[k] = hstate; } \
                    _Pragma("unroll") for (int k = 0; k < 16; ++k) ((LAS float*)(aup + (POS(16 * bb + k)) * 64))[1] = hs[k]; } } while (0)
#define LRU_POS_F(k) (k)
#define LRU_POS_B(k) (63 - (k))
            if (half == 0) LRU_SCAN(LRU_POS_F); else LRU_SCAN(LRU_POS_B);
#undef LRU_SCAN
#undef LRU_POS_F
#undef LRU_POS_B
        }
        if (s + 1 < 36) LRU_RAW_STORE((s + 1) & 1);
        __syncthreads();
        if (emit) {
            float hv[16];
#pragma unroll
            for (int c = 0; c < 16; ++c) hv[c] = AU[opos * 64 + ocq * 16 + c].y;
            if (!second) {
                u32x4 o0, o1; o0.x = pk2(hv[0], hv[1]); o0.y = pk2(hv[2], hv[3]); o0.z = pk2(hv[4], hv[5]); o0.w = pk2(hv[6], hv[7]);
                o1.x = pk2(hv[8], hv[9]); o1.y = pk2(hv[10], hv[11]); o1.z = pk2(hv[12], hv[13]); o1.w = pk2(hv[14], hv[15]);
                *(u32x4*)tp = o0; *(u32x4*)(tp + 8) = o1;
            } else {
                const unsigned tw[8] = {t0.x, t0.y, t0.z, t0.w, t1.x, t1.y, t1.z, t1.w}, yw[8] = {y0.x, y0.y, y0.z, y0.w, y1.x, y1.y, y1.z, y1.w};
                float ov[16];
#pragma unroll
                for (int q = 0; q < 8; ++q) { ov[2 * q] = gelu_t(bf_lo(yw[q])) * (hv[2 * q] + bf_lo(tw[q])); ov[2 * q + 1] = gelu_t(bf_hi(yw[q])) * (hv[2 * q + 1] + bf_hi(tw[q])); }
                unsigned char* op = (unsigned char*)CAT + om * D + hh * 64 + ocq * 16;
                *(u32x4*)op = (u32x4){pk4f8(ov[0], ov[1], ov[2], ov[3], CSC), pk4f8(ov[4], ov[5], ov[6], ov[7], CSC), pk4f8(ov[8], ov[9], ov[10], ov[11], CSC), pk4f8(ov[12], ov[13], ov[14], ov[15], CSC)};
            }
        }
    }
#undef LRU_RAW_LOAD
#undef LRU_RAW_STORE
    __syncthreads();
}

__device__ __forceinline__ void retp1_unit(LAS unsigned char* lds, const bf16* P, bf16* SB, int b, int hh, float lgf2, float lgb2, bool want_ctx, int tid) {
    const int wave = __builtin_amdgcn_readfirstlane(tid >> 6), lane = tid & 63, fr = lane & 15, fg = lane >> 4;
    const int half = wave >> 2, w4 = wave & 3, tidh = tid & 255;
    const int jp = tidh >> 2, part = tidh & 3;
    const float lg2 = half ? lgb2 : lgf2; const float dec = fexp2(128.0f * lg2);
    const float wk0 = half ? fexp2((float)(2 * jp) * lg2) : fexp2((float)(127 - 2 * jp) * lg2), wk1 = half ? fexp2((float)(2 * jp + 1) * lg2) : fexp2((float)(126 - 2 * jp) * lg2);
    u32x4 ka[2], kb[2], va[2], vb[2];
#define RP1_CK(S) ((half == 0) ? (S) : ((S) < 2 ? 1 - (S) : 19 - (S)))
#define RP1_M0(CK) (((CK) < 2) ? (size_t)b * CTXL + (CK) * 128 : (size_t)MC + (size_t)b * SEQ + ((CK) - 2) * 128)
#define RP1_LOAD(S) do { const int ck_ = RP1_CK(S); const size_t m_ = RP1_M0(ck_) + 2 * jp; \
        const bf16* kp = P + m_ * INW + 1152 + hh * 64 + part * 16; const bf16* vp = P + m_ * INW + 1536 + hh * 64 + part * 16; \
        ka[0] = *(const u32x4*)kp; ka[1] = *(const u32x4*)(kp + 8); kb[0] = *(const u32x4*)(kp + INW); kb[1] = *(const u32x4*)(kp + INW + 8); \
        va[0] = *(const u32x4*)vp; va[1] = *(const u32x4*)(vp + 8); vb[0] = *(const u32x4*)(vp + INW); vb[1] = *(const u32x4*)(vp + INW + 8); } while (0)
#define RP1_PARK(BUF) do { LAS bf16* KT_ = (LAS bf16*)(lds + ((BUF) * 2 + half) * 34816); LAS bf16* VT_ = KT_ + 64 * 136; \
        _Pragma("unroll") for (int q = 0; q < 2; ++q) { const unsigned k0w[4] = {ka[q].x, ka[q].y, ka[q].z, ka[q].w}, k1w[4] = {kb[q].x, kb[q].y, kb[q].z, kb[q].w}, v0w[4] = {va[q].x, va[q].y, va[q].z, va[q].w}, v1w[4] = {vb[q].x, vb[q].y, vb[q].z, vb[q].w}; \
            _Pragma("unroll") for (int t = 0; t < 4; ++t) { const int d = part * 16 + 8 * q + 2 * t; \
                *(LAS unsigned*)(KT_ + d * 136 + 2 * jp) = pk2(bf_lo(k0w[t]) * wk0, bf_lo(k1w[t]) * wk1); *(LAS unsigned*)(KT_ + (d + 1) * 136 + 2 * jp) = pk2(bf_hi(k0w[t]) * wk0, bf_hi(k1w[t]) * wk1); \
                *(LAS unsigned*)(VT_ + d * 136 + 2 * jp) = (v0w[t] & 0xffffu) | (v1w[t] << 16); *(LAS unsigned*)(VT_ + (d + 1) * 136 + 2 * jp) = (v0w[t] >> 16) | (v1w[t] & 0xffff0000u); } } } while (0)
    f32x4 st[4];
#pragma unroll
    for (int nt = 0; nt < 4; ++nt) st[nt] = (f32x4){0.f, 0.f, 0.f, 0.f};
    RP1_LOAD(0); RP1_PARK(0);
    __syncthreads();
    for (int s = 0; s < 18; ++s) {
        if (s + 1 < 18) RP1_LOAD(s + 1);
        const int ck = RP1_CK(s);
        if (want_ctx || ck >= 2) { bf16* sp = SB + ((((size_t)b * 6 + hh) * 2 + half) * 18 + ck) * 4096;
#pragma unroll
            for (int nt = 0; nt < 4; ++nt) { u32x2 w; w.x = pk2(st[nt][0], st[nt][1]); w.y = pk2(st[nt][2], st[nt][3]); *(u32x2*)(sp + (nt * 16 + fr) * 64 + w4 * 16 + fg * 4) = w; } }
        const LAS bf16* KT = (const LAS bf16*)(lds + ((s & 1) * 2 + half) * 34816); const LAS bf16* VT = KT + 64 * 136;
#pragma unroll
        for (int nt = 0; nt < 4; ++nt) st[nt] = st[nt] * dec;
#pragma unroll
        for (int ks = 0; ks < 4; ++ks) { const bf16x8 af = ld16l(KT + (w4 * 16 + fr) * 136 + ks * 32 + fg * 8);
#pragma unroll
            for (int nt = 0; nt < 4; ++nt) { const bf16x8 bfr = ld16l(VT + (nt * 16 + fr) * 136 + ks * 32 + fg * 8); st[nt] = mfma16(af, bfr, st[nt]); } }
        if (s + 1 < 18) RP1_PARK((s + 1) & 1);
        __syncthreads();
    }
#undef RP1_CK
#undef RP1_M0
#undef RP1_LOAD
#undef RP1_PARK
}

__device__ __forceinline__ void gmlp_unit(LAS unsigned char* lds, const bf16* P, bf16* CAT, const bf16* WS, const float* WSUM, const float* lng, const float* lnb, const float* bs, int b, int ck, int tid) {
    const int wave = __builtin_amdgcn_readfirstlane(tid >> 6), lane = tid & 63, fr = lane & 15, fg = lane >> 4;
    const size_t m0 = (ck < 2) ? (size_t)b * CTXL + ck * 128 : (size_t)MC + (size_t)b * SEQ + (ck - 2) * 128;
    LAS bf16* VnT = (LAS bf16*)lds;
    LAS float* LN = (LAS float*)(lds + 69632);
    const int g2 = wave >> 1, ih = wave & 1; const bf16* wsg = WS + (size_t)g2 * 16384;
    bf16x8 wf[4][4]; float wsv[4], bsv[4];
#pragma unroll
    for (int it = 0; it < 4; ++it) { const int irow = ih * 64 + it * 16 + fr;
#pragma unroll
        for (int ks = 0; ks < 4; ++ks) wf[it][ks] = ld16g(wsg + irow * 128 + ks * 32 + fg * 8);
        wsv[it] = WSUM[g2 * 128 + irow]; bsv[it] = bs[g2 * 128 + irow]; }
    LN[tid] = (tid < 256) ? lng[tid] : lnb[tid - 256];
    { const int j = tid >> 2, g = tid & 3; const bf16* zp = P + (m0 + j) * INW + 2560 + g * 64; float v[64];
#pragma unroll
        for (int q = 0; q < 8; ++q) { const u32x4 w = *(const u32x4*)(zp + 8 * q); const unsigned ww[4] = {w.x, w.y, w.z, w.w};
#pragma unroll
            for (int t = 0; t < 4; ++t) { v[8 * q + 2 * t] = gelu_t(bf_lo(ww[t])); v[8 * q + 2 * t + 1] = gelu_t(bf_hi(ww[t])); } }
        float s = 0.f;
#pragma unroll
        for (int c = 0; c < 64; ++c) s += v[c];
        const float mu = s * (1.0f / 64.0f); float q2 = 0.f;
#pragma unroll
        for (int c = 0; c < 64; ++c) { v[c] -= mu; q2 += v[c] * v[c]; }
        const float rs = 1.0f / sqrtf(q2 * (1.0f / 64.0f) + EPS);
#pragma unroll
        for (int c = 0; c < 64; c += 2) { const unsigned w = pk2(v[c] * rs, v[c + 1] * rs);
            VnT[(g * 64 + c) * 136 + j] = (bf16)(w & 0xffffu); VnT[(g * 64 + c + 1) * 136 + j] = (bf16)(w >> 16); } }
    __syncthreads();
#pragma unroll
    for (int it = 0; it < 4; ++it) { const int irow = ih * 64 + it * 16 + fr; const size_t m = m0 + irow;
        u32x2 zu[4];
#pragma unroll
        for (int ct = 0; ct < 4; ++ct) zu[ct] = *(const u32x2*)(P + m * INW + 2304 + g2 * 64 + ct * 16 + fg * 4);
        f32x4 acc[4];
#pragma unroll
        for (int ct = 0; ct < 4; ++ct) { acc[ct] = (f32x4){0.f, 0.f, 0.f, 0.f};
#pragma unroll
            for (int ks = 0; ks < 4; ++ks) { const bf16x8 vf = ld16l(VnT + (g2 * 64 + ct * 16 + fr) * 136 + ks * 32 + fg * 8); acc[ct] = mfma16(vf, wf[it][ks], acc[ct]); } }
#pragma unroll
        for (int ct = 0; ct < 4; ++ct) { const int c = g2 * 64 + ct * 16 + fg * 4;
            const f32x4 gv = *(const LAS f32x4*)(LN + c), bv = *(const LAS f32x4*)(LN + 256 + c);
            const f32x4 sv = acc[ct] * gv + bv * wsv[it] + bsv[it];
            *(unsigned*)((unsigned char*)CAT + m * D + 768 + c) = pk4f8(gelu_t(bf_lo(zu[ct].x)) * sv[0], gelu_t(bf_hi(zu[ct].x)) * sv[1], gelu_t(bf_lo(zu[ct].y)) * sv[2], gelu_t(bf_hi(zu[ct].y)) * sv[3], CSC); } }
    __syncthreads();
}

__device__ __forceinline__ void retp2_phase(LAS unsigned char* lds, const bf16* P, const bf16* SB, bf16* CAT, const float* theta, bool want_ctx, int G, int bid, int tid) {
    const int wave = __builtin_amdgcn_readfirstlane(tid >> 6), lane = tid & 63, fr = lane & 15, fg = lane >> 4;
    const int nck = want_ctx ? 18 : 16, ck0 = want_ctx ? 0 : 2, NU = NB * nck * 6;
    const int lj = tid >> 2, lpart = tid & 3;
    u32x4 k0, k1, v0, v1, s0, s1;
#define RP2_DECODE(ID, B_, CK_, HH_) const int HH_ = (ID) % 6, CK_ = ck0 + ((ID) / 6) % nck, B_ = (ID) / (6 * nck)
#define RP2_M0(B_, CK_) (((CK_) < 2) ? (size_t)(B_) * CTXL + (CK_) * 128 : (size_t)MC + (size_t)(B_) * SEQ + ((CK_) - 2) * 128)
#define RP2_LOAD(ID) do { RP2_DECODE(ID, b_, ck_, hh_); const size_t m0_ = RP2_M0(b_, ck_); \
        const bf16* kp = P + (m0_ + lj) * INW + 1152 + hh_ * 64 + lpart * 16; const bf16* vp = P + (m0_ + lj) * INW + 1536 + hh_ * 64 + lpart * 16; \
        k0 = *(const u32x4*)kp; k1 = *(const u32x4*)(kp + 8); v0 = *(const u32x4*)vp; v1 = *(const u32x4*)(vp + 8); \
        const bf16* sp_ = SB + ((((size_t)b_ * 6 + hh_) * 2 + 0) * 18 + ck_) * 4096 + tid * 8; s0 = *(const u32x4*)sp_; s1 = *(const u32x4*)(sp_ + (size_t)18 * 4096); } while (0)
#define RP2_PARK(BUF) do { LAS bf16* Ks_ = (LAS bf16*)(lds + (BUF) * 35840); LAS bf16* VT_ = (LAS bf16*)(lds + (BUF) * 35840 + 18432); \
        *(LAS u32x4*)(Ks_ + lj * 72 + lpart * 16) = k0; *(LAS u32x4*)(Ks_ + lj * 72 + lpart * 16 + 8) = k1; \
        const unsigned vw_[8] = {v0.x, v0.y, v0.z, v0.w, v1.x, v1.y, v1.z, v1.w}; \
        _Pragma("unroll") for (int q = 0; q < 8; ++q) { const int e = lpart * 16 + 2 * q; VT_[e * 136 + lj] = (bf16)(vw_[q] & 0xffffu); VT_[(e + 1) * 136 + lj] = (bf16)(vw_[q] >> 16); } \
        LAS bf16* SF_ = (LAS bf16*)(lds + 73728 + (BUF) * 18432); *(LAS u32x4*)(SF_ + (tid >> 3) * 72 + (tid & 7) * 8) = s0; *(LAS u32x4*)(SF_ + 4608 + (tid >> 3) * 72 + (tid & 7) * 8) = s1; } while (0)
    LAS float* LG = (LAS float*)(lds + 2 * 35840);
    if (tid < 12) { const float t = theta[tid]; LG[tid] = -1.44269504f * ((t < -15.f) ? -t : log1pf(expf(-t))); }
    const int irow = wave * 16 + fr;
    bf16x8 qn0 = {}, qn1 = {};
#define RP2_LOADQ(ID) do { RP2_DECODE(ID, b_, ck_, hh_); const bf16* qp_ = P + (RP2_M0(b_, ck_) + irow) * INW + 768 + hh_ * 64 + fg * 8; qn0 = ld16g(qp_); qn1 = ld16g(qp_ + 32); } while (0)
    int id = bid, buf = 0;
    if (id < NU) { RP2_LOAD(id); RP2_LOADQ(id); RP2_PARK(0); }
    __syncthreads();
    for (; id < NU; id += G, buf ^= 1) {
        const int nid = id + G;
        const bf16x8 qf0 = qn0, qf1 = qn1;
        if (nid < NU) { RP2_LOAD(nid); RP2_LOADQ(nid); }
        RP2_DECODE(id, b, ck, hh);
        const size_t m0 = RP2_M0(b, ck);
        const float lgf2 = LG[hh], lgb2 = LG[6 + hh];
        const LAS bf16* Ks = (const LAS bf16*)(lds + buf * 35840); const LAS bf16* VT = (const LAS bf16*)(lds + buf * 35840 + 18432);
        const size_t mi = m0 + irow;
        const LAS bf16* SFl = (const LAS bf16*)(lds + 73728 + buf * 18432); const LAS bf16* SBl = SFl + 4608;
        u32x2 gw[4];
        f32x4 sc[8];
#pragma unroll
        for (int jt = 0; jt < 8; ++jt) { sc[jt] = (f32x4){0.f, 0.f, 0.f, 0.f};
            const bf16x8 kf0 = ld16l(Ks + (jt * 16 + fr) * 72 + fg * 8), kf1 = ld16l(Ks + (jt * 16 + fr) * 72 + 32 + fg * 8);
            sc[jt] = mfma16(kf0, qf0, sc[jt]); sc[jt] = mfma16(kf1, qf1, sc[jt]); }
#pragma unroll
        for (int jt = 0; jt < 8; ++jt)
#pragma unroll
            for (int r = 0; r < 4; ++r) { const int dd = irow - (jt * 16 + fg * 4 + r);
                const float w = dd > 0 ? fexp2((float)dd * lgf2) : (dd < 0 ? fexp2((float)(-dd) * lgb2) : 2.0f); sc[jt][r] *= w; }
#pragma unroll
        for (int et = 0; et < 4; ++et) gw[et] = *(const u32x2*)(P + mi * INW + 1920 + hh * 64 + et * 16 + fg * 4);
        bf16x8 pf[4];
#pragma unroll
        for (int s4 = 0; s4 < 4; ++s4) { u32x4 w; w.x = pk2(sc[2 * s4][0], sc[2 * s4][1]); w.y = pk2(sc[2 * s4][2], sc[2 * s4][3]); w.z = pk2(sc[2 * s4 + 1][0], sc[2 * s4 + 1][1]); w.w = pk2(sc[2 * s4 + 1][2], sc[2 * s4 + 1][3]); pf[s4] = __builtin_bit_cast(bf16x8, w); }
        f32x4 ao[4], af[4], ab[4];
#pragma unroll
        for (int et = 0; et < 4; ++et) { ao[et] = (f32x4){0.f, 0.f, 0.f, 0.f}; af[et] = ao[et]; ab[et] = ao[et];
#pragma unroll
            for (int s4 = 0; s4 < 4; ++s4) { const LAS bf16* vp = VT + (et * 16 + fr) * 136 + s4 * 32 + fg * 4; const u32x2 lo = *(const LAS u32x2*)vp, hi = *(const LAS u32x2*)(vp + 16);
                const bf16x8 vf = __builtin_bit_cast(bf16x8, ((u32x4){lo.x, lo.y, hi.x, hi.y})); ao[et] = mfma16(vf, pf[s4], ao[et]); }
            af[et] = mfma16(ld16l(SFl + (et * 16 + fr) * 72 + fg * 8), qf0, af[et]); af[et] = mfma16(ld16l(SFl + (et * 16 + fr) * 72 + 32 + fg * 8), qf1, af[et]);
            ab[et] = mfma16(ld16l(SBl + (et * 16 + fr) * 72 + fg * 8), qf0, ab[et]); ab[et] = mfma16(ld16l(SBl + (et * 16 + fr) * 72 + 32 + fg * 8), qf1, ab[et]); }
        const float sfw = fexp2((float)(irow + 1) * lgf2), sbw = fexp2((float)(128 - irow) * lgb2);
        float ss = 0.f; f32x4 o[4];
#pragma unroll
        for (int et = 0; et < 4; ++et) { o[et] = ao[et] + af[et] * sfw + ab[et] * sbw; ss += (o[et][0] * o[et][0] + o[et][1] * o[et][1]) + (o[et][2] * o[et][2] + o[et][3] * o[et][3]); }
        ss += __shfl_xor(ss, 16); ss += __shfl_xor(ss, 32);
        const float rs = 1.0f / sqrtf(ss * (1.0f / 64.0f) + EPS);
#pragma unroll
        for (int et = 0; et < 4; ++et) { const int c = hh * 64 + et * 16 + fg * 4;
            *(unsigned*)((unsigned char*)CAT + mi * D + 384 + c) = pk4f8(silu_f(bf_lo(gw[et].x)) * o[et][0] * rs, silu_f(bf_hi(gw[et].x)) * o[et][1] * rs, silu_f(bf_lo(gw[et].y)) * o[et][2] * rs, silu_f(bf_hi(gw[et].y)) * o[et][3] * rs, CSC); }
        if (nid < NU) RP2_PARK(buf ^ 1);
        __syncthreads();
    }
#undef RP2_DECODE
#undef RP2_M0
#undef RP2_LOAD
#undef RP2_PARK
#undef RP2_LOADQ
}

__global__ void __launch_bounds__(NTHR, 2) fwd_kernel(Params p) {
    extern __shared__ __attribute__((aligned(16))) unsigned char lds_raw[];
    LAS unsigned char* lds = (LAS unsigned char*)lds_raw;
    volatile LAS unsigned* MISC = (volatile LAS unsigned*)(lds + MISC_OFF);
    const int tid = threadIdx.x;
    const int G = gridDim.x, bid = blockIdx.x;
    if (tid < 128) MISC[tid] = 0u;
    __syncthreads();
    (void)xcd_barrier_post((unsigned*)(p.ws + WS_CTL) + CW_BAR + (size_t)p.bar_region * XCD_BAR_WORDS, MISC);

    const int wave0 = __builtin_amdgcn_readfirstlane(tid >> 6);
#define PHASE_BEGIN \
    int lane_v; asm volatile("v_mbcnt_lo_u32_b32 %0, -1, 0\n\tv_mbcnt_hi_u32_b32 %0, -1, %0" : "=v"(lane_v)); const int lane = lane_v; const int wave = wave0; const int tid = wave0 * 64 + lane; \
    size_t zoff = 0; asm volatile("" : "+s"(zoff)); unsigned char* ws = p.ws + zoff; float* out = p.out + zoff; \
    unsigned* ctl = (unsigned*)(ws + WS_CTL); (void)ctl; (void)lane; (void)wave; (void)out; \
    const float* x_in = p.in[0]; const float* c_in = p.in[1]; const float* ctx_in = p.in[2]; const float* cctx_in = p.in[3]; const float* w_mod = p.in[4]; const float* b_mod = p.in[5]; \
    (void)x_in; (void)c_in; (void)ctx_in; (void)cctx_in; (void)w_mod; (void)b_mod; \
    float* MOD = (float*)(ws + WS_MOD); float* ROPE = (float*)(ws + WS_ROPE); (void)MOD; (void)ROPE; \
    bf16* WAT = (bf16*)(ws + WS_SMALLW); bf16* WXT = WAT + (size_t)DEPTH * 2 * 6 * 4096; bf16* WSB = WXT + (size_t)DEPTH * 2 * 6 * 4096; float* WSUM = (float*)(WSB + (size_t)DEPTH * 4 * 16384); (void)WAT; (void)WXT; (void)WSB; (void)WSUM; \
    uint4* TOKINFO = (uint4*)(ws + WS_TOKINFO); int2* TOKSLOT = (int2*)(ws + WS_TOKSLOT); int* SLOTTOK = (int*)(ws + WS_SLOTTOK); (void)TOKINFO; (void)TOKSLOT; (void)SLOTTOK; \
    bf16* XCTX = (bf16*)(ws + WS_XCTX); bf16* XLAT = (bf16*)(ws + WS_XL); (void)XCTX; (void)XLAT; \
    float* SAB = (float*)(ws + WS_ROPE + 512 * 1024); float* SASLOT = (float*)(ws + WS_TOKINFO + 1280 * 1024); float* SWIN = (float*)(ws + WS_TOKSLOT + 640 * 1024); float* SW13 = SWIN + 4096; (void)SAB; (void)SASLOT; (void)SWIN; (void)SW13; \
    bf16* WIN_T = (bf16*)(ws + WS_W + W_WIN); bf16* WOUT_T = (bf16*)(ws + WS_W + W_WOUT); bf16* WFFN = (bf16*)(ws + WS_W + W_FFN); (void)WIN_T; (void)WOUT_T; (void)WFFN; \
    bf16* ABUF = (bf16*)(ws + WS_A); bf16* RBUF = (bf16*)(ws + WS_R); bf16* BBUF = (bf16*)(ws + WS_B); bf16* YBUF = (bf16*)(ws + WS_Y); (void)ABUF; (void)RBUF; (void)BBUF; (void)YBUF; \
    bf16* SBUF = (bf16*)(ws + WS_Y + Y_SBUF); bf16* TLRU = (bf16*)(ws + WS_Y + Y_TLRU); (void)SBUF; (void)TLRU; \
    bf16* YSLOT = (bf16*)(ws + MOE_YSLOT); bf16* HIDS = (bf16*)(ws + MOE_HID); (void)YSLOT; (void)HIDS; \
    const float* modl = MOD + (size_t)l * 33 * 6144; (void)modl;

#define CONV_NI8(LA, HAS_IN) (((HAS_IN) ? 88 : 0) + ((((LA) & 1) != 0) ? NE : 1) * 176)
#define CONV_NTQ(LA) ((512 + ((((LA) & 1) != 0) ? NE : 1) * 1408) / 4)
#define CONVERT_I8(IT, LA, HAS_IN) do { \
            LAS float* scr = (LAS float*)(lds + wave * 16384); \
            const bool moe_ = (((LA) & 1) != 0); const int jf_ = (LA) >> 1; \
            int r = (IT); const int nin = (HAS_IN) ? 88 : 0; \
            if (r < nin) { conv_i8_item(p.in[10] + (size_t)((LA) + 1) * D * INW, INW, (signed char*)WIN_T, SWIN, 32 * r, 32 * r, scr, lane); } \
            else { r -= nin; const int e = r / 176, rr = r % 176, is3 = rr >= 88 ? 1 : 0, n0 = 32 * (rr % 88); \
                const float* wsrc = is3 ? (moe_ ? p.in[29] + ((size_t)jf_ * NE + e) * D * DFF : p.in[25] + (size_t)jf_ * D * DFF) : (moe_ ? p.in[28] + ((size_t)jf_ * NE + e) * D * DFF : p.in[24] + (size_t)jf_ * D * DFF); \
                unsigned char* w13t = (unsigned char*)WFFN + (moe_ ? (size_t)e * W13_BYTES : 0); \
                conv_i8_item(wsrc, DFF, (signed char*)w13t, SW13 + (size_t)(moe_ ? e : 0) * 2 * DFF, n0, 256 * (n0 >> 7) + 128 * is3 + (n0 & 127), scr, lane); } \
        } while (0)
#define CONVERT_TQ(GQ, LA) do { \
            LAS float* scr = (LAS float*)(lds + wave * 16384); \
            const bool moe_ = (((LA) & 1) != 0); const int jf_ = (LA) >> 1; \
            int r = 4 * (GQ); \
            if (r < 512) { transpose_quad<true>(p.in[11] + (size_t)(LA) * D * D, D, WOUT_T, D, 64 * (r / 32), 32 * (r % 32), 32 * (r % 32), WSCO, scr, lane); } \
            else { r -= 512; const int e = r / 1408, rr = r % 1408; \
                const float* w2 = moe_ ? p.in[30] + ((size_t)jf_ * NE + e) * DFF * D : p.in[26] + (size_t)jf_ * DFF * D; \
                unsigned char* w2t = (unsigned char*)WFFN + (moe_ ? (size_t)NE * W13_BYTES + (size_t)e * W2_BYTES : W13_BYTES); \
                transpose_quad<true>(w2, D, w2t, DFF, 64 * (rr / 32), 32 * (rr % 32), 32 * (rr % 32), WSC2, scr, lane); } \
        } while (0)
#define IN(k) (p.ph_lo <= (k) && (k) < p.ph_hi)
#define BARRIER_NOW() do { XcdBarrier b_; b_.bar = (unsigned*)(p.ws + WS_CTL) + CW_BAR + (size_t)p.bar_region * XCD_BAR_WORDS; b_.x = xb_xcc_id(); b_.st = MISC; xcd_barrier(b_, fresh_t0(wave0)); } while (0)
#define SEAM(l, k) do { if (((k) + 1 < p.ph_hi) || ((l) + 1 < p.l_hi)) { XcdBarrier b_; b_.bar = (unsigned*)(p.ws + WS_CTL) + CW_BAR + (size_t)p.bar_region * XCD_BAR_WORDS; b_.x = xb_xcc_id(); b_.st = MISC; xcd_barrier(b_, fresh_t0(wave0)); } } while (0)

    for (int l = p.l_lo; l < p.l_hi; ++l) {
        const bool want_ctx = l < DEPTH - 1;
        const bool moe = (l & 1) != 0; const int jf = l >> 1;
        if (IN(0) && l == 0) {
            PHASE_BEGIN
            const int gw = bid * NWAVES + wave, NGW = G * NWAVES;
            for (int rep = 0; rep < NREP_P0; ++rep) {
            if (l == 0) {
                {
                LAS bf16* Sb = (LAS bf16*)lds; LAS float* red = (LAS float*)(lds + 99328);
#pragma unroll
                for (int q = 0; q < 17; ++q) { const int o = tid + q * NTHR; if (o >= 33 * 256) break; const int r = o >> 8, k = (o & 255) * 4;
                    const f32x4 v = (r < 32) ? *(const f32x4*)(c_in + r * D + k) : *(const f32x4*)(cctx_in + k);
                    *(LAS u32x2*)(Sb + r * 1032 + k) = (u32x2){pk2(silu_f(v[0]), silu_f(v[1])), pk2(silu_f(v[2]), silu_f(v[3]))}; }
                for (int o = tid; o < 15 * 256; o += NTHR) { const int r = 33 + (o >> 8), k = (o & 255) * 4; *(LAS u32x2*)(Sb + r * 1032 + k) = (u32x2){0u, 0u}; }
                __syncthreads();
                const int ct = wave & 1, kq = wave >> 1, fr0 = lane & 15, fg0 = lane >> 4;
                for (int it = bid; it < DEPTH * 192; it += G) {
                    const int ll = it / 192, cb = it % 192;
                    const float* wp = w_mod + (size_t)ll * D * 6144 + cb * 32 + ct * 16 + fr0 + (size_t)(kq * 256 + fg0 * 8) * 6144;
                    float wv[64];
#pragma unroll
                    for (int ks = 0; ks < 8; ++ks)
#pragma unroll
                        for (int j = 0; j < 8; ++j) wv[ks * 8 + j] = wp[(size_t)(ks * 32 + j) * 6144];
                    f32x4 acc3[3] = {(f32x4){0.f, 0.f, 0.f, 0.f}, (f32x4){0.f, 0.f, 0.f, 0.f}, (f32x4){0.f, 0.f, 0.f, 0.f}};
#pragma unroll
                    for (int ks = 0; ks < 8; ++ks) {
                        const bf16x8 bfrag = __builtin_bit_cast(bf16x8, ((u32x4){pk2(wv[ks * 8 + 0], wv[ks * 8 + 1]), pk2(wv[ks * 8 + 2], wv[ks * 8 + 3]), pk2(wv[ks * 8 + 4], wv[ks * 8 + 5]), pk2(wv[ks * 8 + 6], wv[ks * 8 + 7])}));
#pragma unroll
                        for (int mt = 0; mt < 3; ++mt) acc3[mt] = mfma16(ld16l(Sb + (mt * 16 + fr0) * 1032 + kq * 256 + ks * 32 + fg0 * 8), bfrag, acc3[mt]); }
#pragma unroll
                    for (int mt = 0; mt < 3; ++mt)
#pragma unroll
                        for (int j = 0; j < 4; ++j) red[(wave * 12 + mt * 4 + j) * 64 + lane] = acc3[mt][j];
                    __syncthreads();
                    if (wave < 2) {
                        const int cc = cb * 32 + wave * 16 + fr0; const float bm = b_mod[(size_t)ll * 6144 + cc];
#pragma unroll
                        for (int mt = 0; mt < 3; ++mt)
#pragma unroll
                            for (int j = 0; j < 4; ++j) { const int r = mt * 16 + fg0 * 4 + j; float sm = 0.f;
#pragma unroll
                                for (int q = 0; q < 4; ++q) sm += red[((q * 2 + wave) * 12 + mt * 4 + j) * 64 + lane];
                                if (r < 33) MOD[((size_t)ll * 33 + r) * 6144 + cc] = sm + bm; } }
                    __syncthreads();
                }
                }
                for (int idx = bid * NTHR + tid; idx < SEQ * 32; idx += G * NTHR) { const int pos = idx >> 5, i = idx & 31;
                    const float fq = expf(-(float)(i & 15) * (4.605170186f / 16.0f)); const float ang = (float)((i < 16) ? (pos >> 6) : (pos & 63)) * fq;
                    ROPE[(size_t)idx * 2] = __cosf(ang); ROPE[(size_t)idx * 2 + 1] = __sinf(ang); }
                for (int idx = bid * NTHR + tid; idx < DEPTH * 2 * 6 * 4096; idx += G * NTHR) { const int blk = idx >> 12, j = (idx >> 6) & 63, i = idx & 63;
                    const float a = p.in[14][(size_t)blk * 4096 + i * 64 + j], xx = p.in[16][(size_t)blk * 4096 + i * 64 + j];
                    WAT[idx] = (bf16)(pk2(a, 0.f) & 0xffffu); WXT[idx] = (bf16)(pk2(xx, 0.f) & 0xffffu); }
                for (int idx = bid * NTHR + tid; idx < DEPTH * 4 * 16384; idx += G * NTHR) WSB[idx] = (bf16)(pk2(p.in[22][idx], 0.f) & 0xffffu);
                for (int idx = gw; idx < DEPTH * 4 * 128; idx += NGW) {
                    const float sm = wave_sum(bf_lo(pk2(p.in[22][(size_t)idx * 128 + lane], 0.f)) + bf_lo(pk2(p.in[22][(size_t)idx * 128 + 64 + lane], 0.f)));
                    if (lane == 0) WSUM[idx] = sm; }
            }
            { LAS float* scr0 = (LAS float*)(lds + wave * 16384);
              for (int it = bid; it < 88; it += G) conv_i8_item_wg(p.in[10], INW, (signed char*)WIN_T, SWIN, 32 * it, 32 * it, scr0, (LAS float*)(lds + 8 * 16384), wave, lane); }
            __syncthreads();
            }
            SEAM(l, 0);
        }
        if (IN(1) && l == 0) {
            PHASE_BEGIN
            for (int rep = 0; rep < NREP_N0; ++rep) row_phase<0, false, true, true, false>(SAB, ctx_in, x_in, nullptr, nullptr, nullptr, nullptr, nullptr, nullptr, nullptr, p.in[6], modl, 0, 0, 1024,
                                      ABUF, nullptr, nullptr, nullptr, nullptr, 0, MT, G, bid, wave, lane, tid);
            SEAM(l, 1);
        }
        if (IN(2)) {
            PHASE_BEGIN
            pg8::Gemm g{ABUF, WIN_T, MT, INW, D, 0, nullptr}; pg8::StaticOrder S; S.init(MT, INW, G, bid);
            pg8::EpiInProj E{RBUF, INW, ROPE, SAB, SWIN};
            for (int rep = 0; rep < NREP_IN; ++rep) { int lane3; asm volatile("v_mbcnt_lo_u32_b32 %0, -1, 0\n\tv_mbcnt_hi_u32_b32 %0, -1, %0" : "=v"(lane3)); const int tid = wave0 * 64 + lane3; pg8::gemm_phase<pg8::EpiInProj, pg8::StaticOrder, true, false, 2>(lds, g, S, E, tid); if (rep + 1 < NREP_IN) BARRIER_NOW(); }
            SEAM(l, 2);
        }
        if (IN(3)) {
            PHASE_BEGIN
#define FRESH_TID(T) int T; { int l_; asm volatile("v_mbcnt_lo_u32_b32 %0, -1, 0\n\tv_mbcnt_hi_u32_b32 %0, -1, %0" : "=v"(l_)); T = wave0 * 64 + l_; }
            for (int rep = 0; rep < NREP_LRU; ++rep)
            for (;;) {
                FRESH_TID(tq);
                if (tq == 0) MISC[8] = __hip_atomic_fetch_add(ctl + CW_QUEUE + (rep * 16 + l * 4 + 0) * 64, 1u, __ATOMIC_RELAXED, __HIP_MEMORY_SCOPE_AGENT);
                __syncthreads(); const int id = (int)MISC[8]; __syncthreads();
                if (id >= NB * 6) break;
                lru_unit(lds, RBUF, BBUF, TLRU, WAT + (size_t)l * 2 * 6 * 4096, WXT + (size_t)l * 2 * 6 * 4096, p.in[15] + (size_t)l * 768, p.in[17] + (size_t)l * 768, p.in[18] + (size_t)l * 768,
                         p.in[12] + (size_t)l * 4 * 384, p.in[13] + (size_t)l * 384, id / 6, id % 6, want_ctx, tq);
            }
            { for (;;) {
                FRESH_TID(tq);
                if (tq == 0) MISC[8] = __hip_atomic_fetch_add(ctl + CW_QUEUE + (l * 4 + 3) * 64, 1u, __ATOMIC_RELAXED, __HIP_MEMORY_SCOPE_AGENT);
                __syncthreads(); const int id = (int)MISC[8]; __syncthreads();
                const int has_in = (l + 1 < DEPTH) ? 1 : 0; const int ni8 = CONV_NI8(l, has_in), ci8 = (ni8 + 7) >> 3, ntq = CONV_NTQ(l), nchunks = ci8 + ((ntq + 7) >> 3);
                if (id >= nchunks) break;
                if (id < ci8) { const int it = id * 8 + wave; if (it < ni8) CONVERT_I8(it, l, has_in); }
                else { const int gq = (id - ci8) * 8 + wave; if (gq < ntq) CONVERT_TQ(gq, l); }
              } }
            for (int rep = 0; rep < NREP_RP1; ++rep)
            for (;;) {
                FRESH_TID(tq);
                if (tq == 0) MISC[8] = __hip_atomic_fetch_add(ctl + CW_QUEUE + (rep * 16 + l * 4 + 1) * 64, 1u, __ATOMIC_RELAXED, __HIP_MEMORY_SCOPE_AGENT);
                __syncthreads(); const int id = (int)MISC[8]; __syncthreads();
                if (id >= NB * 6) break;
                const int hh = id % 6; const float tf = p.in[19][l * 12 + hh], tb = p.in[19][l * 12 + 6 + hh];
                const float lgf2 = -1.44269504f * ((tf < -15.f) ? -tf : log1pf(expf(-tf))), lgb2 = -1.44269504f * ((tb < -15.f) ? -tb : log1pf(expf(-tb)));
                retp1_unit(lds, RBUF, SBUF, id / 6, hh, lgf2, lgb2, want_ctx, tq);
            }
            for (int rep = 0; rep < NREP_GM; ++rep)
            for (;;) {
                FRESH_TID(tq);
                if (tq == 0) MISC[8] = __hip_atomic_fetch_add(ctl + CW_QUEUE + (rep * 16 + l * 4 + 2) * 64, 1u, __ATOMIC_RELAXED, __HIP_MEMORY_SCOPE_AGENT);
                __syncthreads(); const int id = (int)MISC[8]; __syncthreads();
                if (id >= NB * 18) break;
                const int ck = id % 18;
                if (!want_ctx && ck < 2) continue;
                gmlp_unit(lds, RBUF, BBUF, WSB + (size_t)l * 4 * 16384, WSUM + (size_t)l * 512, p.in[20] + (size_t)l * 256, p.in[21] + (size_t)l * 256, p.in[23] + (size_t)l * 512, id / 18, ck, tq);
            }
#undef FRESH_TID
            SEAM(l, 3);
        }
        if (IN(4)) {
            PHASE_BEGIN
            for (int rep = 0; rep < NREP_MB; ++rep) retp2_phase(lds, RBUF, SBUF, BBUF, p.in[19] + l * 12, want_ctx, G, bid, tid);
            SEAM(l, 4);
        }
        const int m_lo = want_ctx ? 0 : MC; const int m_n = MT - m_lo;
        if (IN(5)) {
            PHASE_BEGIN
            pg8::Gemm g{(const unsigned char*)BBUF + (size_t)m_lo * D, WOUT_T, m_n, D, D, 0, nullptr}; pg8::StaticOrder S; S.init(m_n, D, G, bid);
            pg8::EpiBf16 E{YBUF + (size_t)m_lo * D, D, 1.0f / (CSC * WSCO)};
            for (int rep = 0; rep < NREP_OUT; ++rep) { int lane3; asm volatile("v_mbcnt_lo_u32_b32 %0, -1, 0\n\tv_mbcnt_hi_u32_b32 %0, -1, %0" : "=v"(lane3)); const int tid = wave0 * 64 + lane3; pg8::gemm_phase<pg8::EpiBf16, pg8::StaticOrder, true, false, 1>(lds, g, S, E, tid); if (rep + 1 < NREP_OUT) BARRIER_NOW(); }
            SEAM(l, 5);
        }
        if (IN(6)) {
            PHASE_BEGIN
            if (l == 0) {
                row_phase<1, false, true, true, false>(SAB, ctx_in, x_in, XCTX, XLAT, YBUF, nullptr, nullptr, nullptr, p.in[7] + (size_t)l * D, p.in[8] + (size_t)l * D, modl, 2048, 3072, 4096,
                                                       ABUF, nullptr, nullptr, nullptr, nullptr, m_lo, MT, G, bid, wave, lane, tid);
            } else if (moe) {
                row_phase<1, true, true, false, false>(SAB, XCTX, XLAT, XCTX, XLAT, YBUF, nullptr, nullptr, nullptr, p.in[7] + (size_t)l * D, p.in[8] + (size_t)l * D, modl, 2048, 3072, 4096,
                                                       ABUF, p.in[27] + (size_t)jf * D * NE, TOKINFO, (LAS unsigned*)(lds + MISC_OFF) + 16, ctl + CW_GCNT + jf * 64, m_lo, MT, G, bid, wave, lane, tid, lds);
            } else {
                row_phase<1, false, true, false, false>(SAB, XCTX, XLAT, XCTX, XLAT, YBUF, nullptr, nullptr, nullptr, p.in[7] + (size_t)l * D, p.in[8] + (size_t)l * D, modl, 2048, 3072, 4096,
                                                        ABUF, nullptr, nullptr, nullptr, nullptr, m_lo, MT, G, bid, wave, lane, tid);
            }
            SEAM(l, 6);
        }
        if (IN(7)) {
            PHASE_BEGIN
            if (!moe) {
                pg8::Gemm g{(const unsigned char*)ABUF + (size_t)m_lo * D, WFFN, m_n, 2 * DFF, D, 0, nullptr}; pg8::StaticOrder S; S.init(m_n, 2 * DFF, G, bid);
                pg8::EpiSwiGLU E{(unsigned char*)RBUF + (size_t)m_lo * DFF, DFF, SAB + m_lo, SW13, HSC};
                for (int rep = 0; rep < NREP_DG1; ++rep) { int lane3; asm volatile("v_mbcnt_lo_u32_b32 %0, -1, 0\n\tv_mbcnt_hi_u32_b32 %0, -1, %0" : "=v"(lane3)); const int tid = wave0 * 64 + lane3; pg8::gemm_phase<pg8::EpiSwiGLU, pg8::StaticOrder, true, false, 2>(lds, g, S, E, tid); if (rep + 1 < NREP_DG1) BARRIER_NOW(); }
            } else {
                LAS unsigned* T = (LAS unsigned*)(lds + MISC_OFF) + 32;
                if (tid == 0) { unsigned s = 0; for (int e = 0; e < 8; ++e) { T[e] = s; const unsigned c = __hip_atomic_load(ctl + CW_GCNT + jf * 64 + e, __ATOMIC_RELAXED, __HIP_MEMORY_SCOPE_AGENT); s += (c + 255u) & ~255u; } T[8] = s; }
                if (tid < 8) T[16 + tid] = 0u;
                __syncthreads();
                const int per = m_n / G; const int mb = m_lo + bid * per;
                unsigned e1 = 0, e2 = 0, p1 = 0, p2 = 0;
                if (tid < per) { const uint4 ti = TOKINFO[mb + tid]; e1 = ti.x; e2 = ti.y;
                    p1 = __hip_atomic_fetch_add(T + 16 + e1, 1u, __ATOMIC_RELAXED, __HIP_MEMORY_SCOPE_WORKGROUP); p2 = __hip_atomic_fetch_add(T + 16 + e2, 1u, __ATOMIC_RELAXED, __HIP_MEMORY_SCOPE_WORKGROUP); }
                __syncthreads();
                if (tid < 8) T[24 + tid] = __hip_atomic_fetch_add(ctl + CW_GPOS + jf * 64 + tid, T[16 + tid], __ATOMIC_RELAXED, __HIP_MEMORY_SCOPE_AGENT);
                __syncthreads();
                if (tid < per) { const int s1 = (int)(T[e1] + T[24 + e1] + p1), s2 = (int)(T[e2] + T[24 + e2] + p2);
                    SLOTTOK[s1] = mb + tid; SLOTTOK[s2] = mb + tid; TOKSLOT[mb + tid] = make_int2(s1, s2); const float sv = SAB[mb + tid]; SASLOT[s1] = sv; SASLOT[s2] = sv; }
                for (int idx = bid * NTHR + tid; idx < 8 * 256; idx += G * NTHR) { const int e = idx >> 8, k = idx & 255;
                    const unsigned c = __hip_atomic_load(ctl + CW_GCNT + jf * 64 + e, __ATOMIC_RELAXED, __HIP_MEMORY_SCOPE_AGENT); const unsigned s = T[e] + c + k;
                    if (s < T[e + 1]) { SLOTTOK[s] = m_lo; SASLOT[s] = 0.f; } }
                __syncthreads();
            }
            SEAM(l, 7);
        }
        if (IN(8)) {
            PHASE_BEGIN
            if (!moe) {
                pg8::Gemm g{(const unsigned char*)RBUF + (size_t)m_lo * DFF, (const unsigned char*)WFFN + W13_BYTES, m_n, D, DFF, 0, nullptr}; pg8::StaticOrder S; S.init(m_n, D, G, bid);
                pg8::EpiBf16 E{YBUF + (size_t)m_lo * D, D, 1.0f / (WSC2 * HSC)};
                for (int rep = 0; rep < NREP_DG2; ++rep) { int lane3; asm volatile("v_mbcnt_lo_u32_b32 %0, -1, 0\n\tv_mbcnt_hi_u32_b32 %0, -1, %0" : "=v"(lane3)); const int tid = wave0 * 64 + lane3; pg8::gemm_phase<pg8::EpiBf16, pg8::StaticOrder, true, false, 1>(lds, g, S, E, tid); if (rep + 1 < NREP_DG2) BARRIER_NOW(); }
            } else {
                LAS int* SEGT = (LAS int*)(lds + MISC_OFF) + 48;
                if (tid == 0) { unsigned s = 0; for (int e = 0; e < 8; ++e) { SEGT[e] = (int)(s >> 8); const unsigned c = __hip_atomic_load(ctl + CW_GCNT + jf * 64 + e, __ATOMIC_RELAXED, __HIP_MEMORY_SCOPE_AGENT); s += (c + 255u) & ~255u; } SEGT[8] = (int)(s >> 8); }
                __syncthreads();
                const int NT = __builtin_amdgcn_readfirstlane(SEGT[8]);
                const int slab = (NT <= p.slab_cap) ? NT : ((NT + 1) / 2 < SLAB_TILES ? (NT + 1) / 2 : SLAB_TILES);
                for (int t0 = 0; t0 < NT; t0 += slab) {
                    const int nT = (NT - t0) < slab ? (NT - t0) : slab;
                    { int lane2; asm volatile("v_mbcnt_lo_u32_b32 %0, -1, 0\n\tv_mbcnt_hi_u32_b32 %0, -1, %0" : "=v"(lane2)); const int tid = wave0 * 64 + lane2;
                      pg8::MoeOrder S; S.nM = nT; S.nN = 2 * DFF / 256; S.nwg = nT * S.nN; S.G = G; S.c = bid; S.t0 = t0;
                        S.segt = SEGT;
                        pg8::Gemm g{ABUF, WFFN, nT * 256, 2 * DFF, D, W13_BYTES, SLOTTOK};
                        pg8::EpiSwiGLU E{(unsigned char*)HIDS - (size_t)t0 * 256 * DFF, DFF, SASLOT, SW13, HSC};
                        for (int rep = 0; rep < NREP_MG1; ++rep) { int lane3; asm volatile("v_mbcnt_lo_u32_b32 %0, -1, 0\n\tv_mbcnt_hi_u32_b32 %0, -1, %0" : "=v"(lane3)); const int tid = wave0 * 64 + lane3; pg8::gemm_phase<pg8::EpiSwiGLU, pg8::MoeOrder, true, true, 2>(lds, g, S, E, tid); if (rep + 1 < NREP_MG1) BARRIER_NOW(); } }
                    BARRIER_NOW();
                    { int lane2; asm volatile("v_mbcnt_lo_u32_b32 %0, -1, 0\n\tv_mbcnt_hi_u32_b32 %0, -1, %0" : "=v"(lane2)); const int tid = wave0 * 64 + lane2;
                      pg8::MoeOrder S; S.nM = nT; S.nN = D / 256; S.nwg = nT * S.nN; S.G = G; S.c = bid; S.t0 = t0;
                        S.segt = SEGT;
                        pg8::Gemm g{(const unsigned char*)HIDS - (size_t)t0 * 256 * DFF, (const unsigned char*)WFFN + (size_t)NE * W13_BYTES, nT * 256, D, DFF, W2_BYTES, nullptr};
                        pg8::EpiBf16 E{YSLOT, D, 1.0f / (WSC2 * HSC)};
                        for (int rep = 0; rep < NREP_MG2; ++rep) { int lane3; asm volatile("v_mbcnt_lo_u32_b32 %0, -1, 0\n\tv_mbcnt_hi_u32_b32 %0, -1, %0" : "=v"(lane3)); const int tid = wave0 * 64 + lane3; pg8::gemm_phase<pg8::EpiBf16, pg8::MoeOrder, true, false, 1>(lds, g, S, E, tid); if (rep + 1 < NREP_MG2) BARRIER_NOW(); } }
                    if (t0 + slab < NT) BARRIER_NOW();
                }
            }
            SEAM(l, 8);
        }
        if (IN(9)) {
            PHASE_BEGIN
            const float* gpre_n = p.in[6] + (size_t)(l + 1 < DEPTH ? l + 1 : l) * D; const float* modn = MOD + (size_t)(l + 1 < DEPTH ? l + 1 : l) * 33 * 6144;
            const int o_sh = (int)(modn - modl) + 0, o_sc = (int)(modn - modl) + 1024;
            if (l + 1 < DEPTH) {
                if (moe) row_phase<2, false, true, false, false>(SAB, XCTX, XLAT, XCTX, XLAT, nullptr, YSLOT, TOKINFO, TOKSLOT, p.in[9] + (size_t)l * D, gpre_n, modl, 5120, o_sh, o_sc,
                                                                 ABUF, nullptr, nullptr, nullptr, nullptr, m_lo, MT, G, bid, wave, lane, tid);
                else row_phase<1, false, true, false, false>(SAB, XCTX, XLAT, XCTX, XLAT, YBUF, nullptr, nullptr, nullptr, p.in[9] + (size_t)l * D, gpre_n, modl, 5120, o_sh, o_sc,
                                                             ABUF, nullptr, nullptr, nullptr, nullptr, m_lo, MT, G, bid, wave, lane, tid);
            } else {
                row_phase<2, false, false, false, true>(SAB, XCTX, XLAT, XCTX, out, nullptr, YSLOT, TOKINFO, TOKSLOT, p.in[9] + (size_t)l * D, gpre_n, modl, 5120, o_sh, o_sc,
                                                        ABUF, nullptr, nullptr, nullptr, nullptr, m_lo, MT, G, bid, wave, lane, tid);
            }
            SEAM(l, 9);
        }
    }
#undef IN
#undef SEAM
}

extern "C" void kernel_launch(void* const* d_in, const int* in_sizes, int n_in, void* d_out, int out_size, void* d_ws, size_t ws_size, hipStream_t stream) {
    static int grid = 0;
    if (grid == 0) {
        if (n_in != 31 || out_size != ML * D || ws_size < WS_END) { fprintf(stderr, "kernel_launch: unexpected problem (n_in %d, out %d, ws %zu, need %zu)\n", n_in, out_size, ws_size, (size_t)WS_END); grid = -1; return; }
        int dev = 0, cus = 0, per_cu = 0;
        if (hipGetDevice(&dev) != hipSuccess || hipDeviceGetAttribute(&cus, hipDeviceAttributeMultiprocessorCount, dev) != hipSuccess) { grid = -1; return; }
        if (hipFuncSetAttribute((const void*)fwd_kernel, hipFuncAttributeMaxDynamicSharedMemorySize, LDS_BYTES) != hipSuccess) { fprintf(stderr, "kernel_launch: hipFuncSetAttribute failed\n"); grid = -1; return; }
        if (hipOccupancyMaxActiveBlocksPerMultiprocessor(&per_cu, (const void*)fwd_kernel, NTHR, LDS_BYTES) != hipSuccess || per_cu < 1) fprintf(stderr, "kernel_launch: occupancy query says %d\n", per_cu);
        (void)hipGetLastError();
        grid = cus;
        if (grid != 256) { fprintf(stderr, "kernel_launch: %d CUs (built for 256)\n", grid); grid = -1; return; }
    }
    if (grid < 0) return;
    (void)hipMemsetAsync((char*)d_ws + WS_CTL, 0, CTL_BYTES, stream);
    Params a{};
    for (int i = 0; i < 31; ++i) a.in[i] = (const float*)d_in[i];
    a.out = (float*)d_out; a.ws = (unsigned char*)d_ws;
    { const size_t cap = (ws_size - MOE_HID) / ((size_t)256 * DFF); a.slab_cap = cap >= 584 ? 584 : SLAB_TILES; }
#if MK_PER_PHASE
    int region = 0;
    for (int l = 0; l < DEPTH; ++l)
        for (int ph = 0; ph < NPH; ++ph) {
            if (ph == 1 && l != 0) continue;
            a.l_lo = l; a.l_hi = l + 1; a.ph_lo = ph; a.ph_hi = ph + 1; a.bar_region = region++;
            hipLaunchKernelGGL(fwd_kernel, dim3(grid), dim3(NTHR), LDS_BYTES, stream, a);
        }
#else
    a.l_lo = 0; a.l_hi = DEPTH; a.ph_lo = 0; a.ph_hi = NPH; a.bar_region = 0;
    hipLaunchKernelGGL(fwd_kernel, dim3(grid), dim3(NTHR), LDS_BYTES, stream, a);
#endif
    const hipError_t le = hipPeekAtLastError();
    if (le != hipSuccess) fprintf(stderr, "kernel_launch: launch failed: %s\n", hipGetErrorName(le));
}
```

```cpp
#include <hip/hip_runtime.h>
#include <cstdio>
#include <cstdint>

#ifndef NREP_G
#define NREP_G 1
#endif
#ifndef NREP_IN
#define NREP_IN NREP_G
#endif
#ifndef NREP_OUT
#define NREP_OUT NREP_G
#endif
#ifndef NREP_DG1
#define NREP_DG1 NREP_G
#endif
#ifndef NREP_DG2
#define NREP_DG2 NREP_G
#endif
#ifndef NREP_MG1
#define NREP_MG1 NREP_G
#endif
#ifndef NREP_MG2
#define NREP_MG2 NREP_G
#endif
#ifndef NREP_MB
#define NREP_MB 1
#endif
#ifndef NREP_MA
#define NREP_MA 1
#endif
#ifndef NREP_LRU
#define NREP_LRU NREP_MA
#endif
#ifndef NREP_RP1
#define NREP_RP1 NREP_MA
#endif
#ifndef NREP_GM
#define NREP_GM NREP_MA
#endif
#ifndef NREP_P0
#define NREP_P0 1
#endif
#ifndef NREP_N0
#define NREP_N0 1
#endif
#ifndef MK_PER_PHASE
#define MK_PER_PHASE 0
#endif

namespace pg8 {
#define PG8_LAS __attribute__((address_space(3)))
typedef unsigned short bf16_t;
typedef short bf16x8 __attribute__((ext_vector_type(8)));
typedef float f32x4 __attribute__((ext_vector_type(4)));
typedef float f32x2 __attribute__((ext_vector_type(2)));
typedef unsigned u32x4 __attribute__((ext_vector_type(4)));
typedef unsigned u32x2 __attribute__((ext_vector_type(2)));
constexpr int BM = 256, BK = 64, HALF = 128, HTB = HALF * BK * 2, STAGE_BYTES = 8 * HTB, NXCD = 8, WGM = 4;

__host__ __device__ __forceinline__ int lds_byte(int r, int c) { const int st = (r >> 4) * 2 + (c >> 5), rr = r & 15, cc = c & 31, ob = rr * 64 + cc * 2; return st * 1024 + (ob ^ (((ob >> 9) & 1) << 5)); }
__host__ __device__ __forceinline__ void stage_rc(int b, int& R, int& C) { const int st = b / 1024, sb = b % 1024, swz = sb ^ (((sb >> 9) & 1) << 5); R = (st >> 1) * 16 + swz / 64; C = (st & 1) * 32 + (swz % 64) / 2; }
__host__ __device__ __forceinline__ int perm32(int rho) { const int n = rho >> 4, i = rho & 15; return 8 * (i >> 2) + 4 * n + (i & 3); }

struct Unit { int pm, pn, e; };
struct Gemm { const void* A; const void* Bt; int M, N, Kb; size_t bstride; const int* rowidx; };

struct StaticOrder {
    int nM, nN, nwg, G, c;
    __host__ __device__ void init(int M, int N, int G_, int c_) { nM = M / BM; nN = N / BM; nwg = nM * nN; G = G_; c = c_; }
    __host__ __device__ bool next(int i, Unit& u) const {
        const long L = (long)i * G + c; if (L >= nwg) return false;
        int wgid = (int)L; { const int q = nwg / NXCD, r = nwg % NXCD, xcd = wgid % NXCD, off = wgid / NXCD; wgid = (xcd < r ? xcd * (q + 1) : r * (q + 1) + (xcd - r) * q) + off; }
        const int nig = WGM * nN, gid = wgid / nig, fm = gid * WGM, gsz = (nM - fm) < WGM ? (nM - fm) : WGM;
        u.pm = fm + ((wgid % nig) % gsz); u.pn = (wgid % nig) / gsz; u.e = 0; return true;
    }
    __device__ __forceinline__ void a_ready(const Unit&) const {}
    __device__ __forceinline__ void done(const Unit&) const {}
};
struct MoeOrder {
    int nM, nN, nwg, G, c, t0; const PG8_LAS int* segt;
    __device__ __forceinline__ bool next(int i, Unit& u) const {
        const long L = (long)i * G + c; if (L >= nwg) return false;
        int wgid = (int)L; { const int q = nwg / NXCD, r = nwg % NXCD, xcd = wgid % NXCD, off = wgid / NXCD; wgid = (xcd < r ? xcd * (q + 1) : r * (q + 1) + (xcd - r) * q) + off; }
        const int nig = WGM * nN, gid = wgid / nig, fm = gid * WGM, gsz = (nM - fm) < WGM ? (nM - fm) : WGM;
        u.pm = t0 + fm + ((wgid % nig) % gsz); u.pn = (wgid % nig) / gsz;
        int e = 0;
#pragma unroll
        for (int k = 1; k < 8; ++k) e += (u.pm >= segt[k]) ? 1 : 0;
        u.e = __builtin_amdgcn_readfirstlane(e); return true;
    }
    __device__ __forceinline__ void a_ready(const Unit&) const {}
    __device__ __forceinline__ void done(const Unit&) const {}
};

__device__ __forceinline__ unsigned cvt_pk_bf16(float lo, float hi) { unsigned r; asm volatile("v_cvt_pk_bf16_f32 %0, %1, %2" : "=v"(r) : "v"(lo), "v"(hi)); return r; }

struct EpiBf16 {
    static constexpr bool PERM = true, AFTER_DRAIN = false; static constexpr int NST = 16;
    bf16_t* O; int ldc; float scale;
    static constexpr bool SCALES = false;
    __device__ __forceinline__ void operator()(const f32x4 (&acc)[2][2][4][2], const Unit& u, int wr, int wc, int fr, int fq, const PG8_LAS unsigned char*) const {
        const int row0 = u.pm * BM + wr * 64 + fr; const int col0 = u.pn * BM + wc * 32 + 8 * fq;
#pragma unroll
        for (int ai = 0; ai < 2; ++ai)
#pragma unroll
            for (int m = 0; m < 4; ++m) { bf16_t* rowp = O + (size_t)(row0 + ai * HALF + m * 16) * ldc + col0;
#pragma unroll
                for (int bj = 0; bj < 2; ++bj) { const f32x4 v0 = acc[ai][bj][m][0] * scale, v1 = acc[ai][bj][m][1] * scale;
                    u32x4 w; w.x = cvt_pk_bf16(v0[0], v0[1]); w.y = cvt_pk_bf16(v0[2], v0[3]); w.z = cvt_pk_bf16(v1[0], v1[1]); w.w = cvt_pk_bf16(v1[2], v1[3]);
                    *(u32x4*)(rowp + bj * HALF) = w; } }
    }
};
struct EpiInProj {
    static constexpr bool PERM = true, AFTER_DRAIN = false; static constexpr int NST = 16;
    bf16_t* O; int ldc; const float* cs; const float* sa; const float* sw;
    static constexpr bool SCALES = true;
    __device__ __forceinline__ void prefetch(PG8_LAS unsigned char* sl, const Unit& u, int wr, int wc, int lane) const {
        const float* sap = sa + u.pm * BM + wr * 64 + lane;
        __builtin_amdgcn_global_load_lds((const unsigned*)sap, (PG8_LAS unsigned*)sl, 4, 0, 0); __builtin_amdgcn_global_load_lds((const unsigned*)(sap + HALF), (PG8_LAS unsigned*)(sl + 256), 4, 0, 0);
        const float* swp = sw + u.pn * BM + wc * 32 + (lane & 31) + (lane >> 5) * HALF;
        __builtin_amdgcn_global_load_lds((const unsigned*)swp, (PG8_LAS unsigned*)(sl + 512), 4, 0, 0);
    }
    __device__ __forceinline__ void operator()(const f32x4 (&acc)[2][2][4][2], const Unit& u, int wr, int wc, int fr, int fq, const PG8_LAS unsigned char* sl) const {
        const int row0 = u.pm * BM + wr * 64 + fr; const int col0 = u.pn * BM + wc * 32 + 8 * fq;
        const bool qk = (u.pn >= 3 && u.pn <= 5); const bool rope = qk && (u.pm >= 32);
        f32x4 swv[2][2];
#pragma unroll
        for (int bj = 0; bj < 2; ++bj) { swv[bj][0] = *(const PG8_LAS f32x4*)(sl + 512 + (bj * 32 + 8 * fq) * 4); swv[bj][1] = *(const PG8_LAS f32x4*)(sl + 512 + (bj * 32 + 8 * fq + 4) * 4); }
#pragma unroll
        for (int ai = 0; ai < 2; ++ai)
#pragma unroll
            for (int m = 0; m < 4; ++m) { const int row = row0 + ai * HALF + m * 16; bf16_t* rowp = O + (size_t)row * ldc + col0;
                const int pos = (row - 8192) & 2047; const float sar = *(const PG8_LAS float*)(sl + ai * 256 + (m * 16 + fr) * 4);
#pragma unroll
                for (int bj = 0; bj < 2; ++bj) { f32x4 v0 = acc[ai][bj][m][0] * swv[bj][0] * sar, v1 = acc[ai][bj][m][1] * swv[bj][1] * sar;
                    if (qk) { const float sc = (u.pn == 3 || (u.pn == 4 && bj == 0)) ? 0.125f : 1.0f; v0 = v0 * sc; v1 = v1 * sc; }
                    if (rope) { const int pr = ((col0 + bj * HALF) & 63) >> 1;
                        const f32x4 c0 = *(const f32x4*)(cs + ((size_t)pos * 32 + pr) * 2), c1 = *(const f32x4*)(cs + ((size_t)pos * 32 + pr) * 2 + 4);
                        f32x4 r0, r1;
                        r0[0] = v0[0] * c0[0] - v0[1] * c0[1]; r0[1] = v0[0] * c0[1] + v0[1] * c0[0]; r0[2] = v0[2] * c0[2] - v0[3] * c0[3]; r0[3] = v0[2] * c0[3] + v0[3] * c0[2];
                        r1[0] = v1[0] * c1[0] - v1[1] * c1[1]; r1[1] = v1[0] * c1[1] + v1[1] * c1[0]; r1[2] = v1[2] * c1[2] - v1[3] * c1[3]; r1[3] = v1[2] * c1[3] + v1[3] * c1[2];
                        v0 = r0; v1 = r1; }
                    u32x4 w; w.x = cvt_pk_bf16(v0[0], v0[1]); w.y = cvt_pk_bf16(v0[2], v0[3]); w.z = cvt_pk_bf16(v1[0], v1[1]); w.w = cvt_pk_bf16(v1[2], v1[3]);
                    *(u32x4*)(rowp + bj * HALF) = w; } }
    }
};
struct EpiSwiGLU {
    static constexpr bool PERM = true, AFTER_DRAIN = false; static constexpr int NST = 8;
    unsigned char* O; int ldc; const float* sa; const float* sw; float outscale;
    static constexpr bool SCALES = true;
    __device__ __forceinline__ void prefetch(PG8_LAS unsigned char* sl, const Unit& u, int wr, int wc, int lane) const {
        const float* sap = sa + u.pm * BM + wr * 64 + lane;
        __builtin_amdgcn_global_load_lds((const unsigned*)sap, (PG8_LAS unsigned*)sl, 4, 0, 0); __builtin_amdgcn_global_load_lds((const unsigned*)(sap + HALF), (PG8_LAS unsigned*)(sl + 256), 4, 0, 0);
        const float* swp = sw + (size_t)u.e * (2 * 2816) + u.pn * BM + wc * 32 + (lane & 31) + (lane >> 5) * HALF;
        __builtin_amdgcn_global_load_lds((const unsigned*)swp, (PG8_LAS unsigned*)(sl + 512), 4, 0, 0);
    }
    __device__ __forceinline__ void operator()(const f32x4 (&acc)[2][2][4][2], const Unit& u, int wr, int wc, int fr, int fq, const PG8_LAS unsigned char* sl) const {
        const int row0 = u.pm * BM + wr * 64 + fr; const int col0 = u.pn * HALF + wc * 32 + 8 * fq;
        f32x4 sw1[2], sw3[2];
#pragma unroll
        for (int n = 0; n < 2; ++n) { sw1[n] = *(const PG8_LAS f32x4*)(sl + 512 + (8 * fq + 4 * n) * 4); sw3[n] = *(const PG8_LAS f32x4*)(sl + 512 + (32 + 8 * fq + 4 * n) * 4) * outscale; }
#pragma unroll
        for (int ai = 0; ai < 2; ++ai)
#pragma unroll
            for (int m = 0; m < 4; ++m) { unsigned char* rowp = O + (size_t)(row0 + ai * HALF + m * 16) * ldc + col0; const float sar = *(const PG8_LAS float*)(sl + ai * 256 + (m * 16 + fr) * 4);
                f32x4 h[2];
#pragma unroll
                for (int n = 0; n < 2; ++n) { const f32x4 a = acc[ai][0][m][n] * sw1[n] * sar, b = acc[ai][1][m][n] * sw3[n] * sar;
#pragma unroll
                    for (int j = 0; j < 4; ++j) { const float sg = a[j] * __builtin_amdgcn_rcpf(1.0f + __builtin_amdgcn_exp2f(-1.44269504f * a[j])); h[n][j] = __builtin_amdgcn_fmed3f(sg * b[j], -448.0f, 448.0f); } }
                u32x2 w; unsigned t = 0u;
                t = __builtin_amdgcn_cvt_pk_fp8_f32(h[0][0], h[0][1], t, false); t = __builtin_amdgcn_cvt_pk_fp8_f32(h[0][2], h[0][3], t, true); w.x = t;
                t = __builtin_amdgcn_cvt_pk_fp8_f32(h[1][0], h[1][1], t, false); t = __builtin_amdgcn_cvt_pk_fp8_f32(h[1][2], h[1][3], t, true); w.y = t;
                *(u32x2*)rowp = w; }
    }
};

typedef int v4i_t __attribute__((ext_vector_type(4)));
typedef int v8i_t __attribute__((ext_vector_type(8)));
template <class Epi, class Sched, bool ALIGN_EPI, bool GATHER, int DT>
__device__ __forceinline__ void gemm_phase(PG8_LAS unsigned char* lds, const Gemm g, const Sched& S, const Epi& E, const int tid) {
    const int wid = __builtin_amdgcn_readfirstlane(tid >> 6), lane = tid & 63, wr = wid >> 2, wc = wid & 3, fr = lane & 15, fq = lane >> 4;
    const int Kb = g.Kb, nt = Kb / 128;
    unsigned voffA[2], voffB[2];
#pragma unroll
    for (int i = 0; i < 2; ++i) { int R, C; stage_rc(tid * 16 + i * 8192, R, C); const int Rb = Epi::PERM ? ((R & ~31) + perm32(R & 31)) : R;
        voffA[i] = (unsigned)(R * Kb + C * 2); voffB[i] = (unsigned)(Rb * Kb + C * 2); }
    const size_t kstep = (size_t)(BK * 2);
    const size_t hstep = (size_t)HALF * Kb;
    const size_t tstep = 2 * hstep;
    const unsigned ldsw = (unsigned)wid * 1024u;
    const int aoff = lds_byte(wr * 64 + fr, fq * 8), boff = lds_byte(wc * 32 + fr, fq * 8);
#define PG8_SA(b, h) (((b) * 2 + (h)) * HTB)
#define PG8_SB(b, h) ((4 + (b) * 2 + (h)) * HTB)
#define PG8_STAGE(bufoff, gbase, voff) do { _Pragma("unroll") for (int _i = 0; _i < 2; ++_i) \
        __builtin_amdgcn_global_load_lds((const unsigned*)((const char*)(gbase) + (voff)[_i]), (PG8_LAS unsigned*)(lds + (bufoff) + ldsw + _i * 8192), 16, 0, 0); } while (0)
#define PG8_STAGE_A(bufoff, ptr, h, AO0, AO1) do { if constexpr (GATHER) { if ((h) == 0) PG8_STAGE(bufoff, ptr, AO0); else PG8_STAGE(bufoff, ptr, AO1); } else PG8_STAGE(bufoff, (ptr) + (h) * hstep, voffA); } while (0)
#define PG8_LD8(p) __builtin_shufflevector(*(const PG8_LAS v4i_t*)(p), *(const PG8_LAS v4i_t*)((p) + 1024), 0, 1, 2, 3, 4, 5, 6, 7)
#define PG8_LO(x) __builtin_bit_cast(bf16x8, __builtin_shufflevector(x, x, 0, 1, 2, 3))
#define PG8_HI(x) __builtin_bit_cast(bf16x8, __builtin_shufflevector(x, x, 4, 5, 6, 7))
#define PG8_LDA(dst, b, h) do { _Pragma("unroll") for (int m = 0; m < 4; ++m) dst[m] = PG8_LD8(lds + PG8_SA(b, h) + aoff + m * 2048); } while (0)
#define PG8_LDB(dst, b, h) do { _Pragma("unroll") for (int n = 0; n < 2; ++n) dst[n] = PG8_LD8(lds + PG8_SB(b, h) + boff + n * 2048); } while (0)
#define PG8_MMA(ai, bj, At, Bt) do { __builtin_amdgcn_s_setprio(1); \
        if constexpr (DT == 1) { _Pragma("unroll") for (int m = 0; m < 4; ++m) _Pragma("unroll") for (int n = 0; n < 2; ++n) \
            asm volatile("v_mfma_scale_f32_16x16x128_f8f6f4 %0, %1, %2, %0, %3, %3 op_sel_hi:[0,0,0]" : "+v"(acc[ai][bj][m][n]) : "v"(Bt[n]), "v"(At[m]), "v"(f8one)); } \
        else if constexpr (DT == 2) { \
            _Pragma("unroll") for (int m = 0; m < 4; ++m) _Pragma("unroll") for (int n = 0; n < 2; ++n) \
                asm volatile("v_mfma_i32_16x16x64_i8 %0, %1, %2, %0" : "+v"(acc[ai][bj][m][n]) : "v"(__builtin_shufflevector(Bt[n], Bt[n], 0, 1, 2, 3)), "v"(__builtin_shufflevector(At[m], At[m], 0, 1, 2, 3))); \
            _Pragma("unroll") for (int m = 0; m < 4; ++m) _Pragma("unroll") for (int n = 0; n < 2; ++n) \
                asm volatile("v_mfma_i32_16x16x64_i8 %0, %1, %2, %0" : "+v"(acc[ai][bj][m][n]) : "v"(__builtin_shufflevector(Bt[n], Bt[n], 4, 5, 6, 7)), "v"(__builtin_shufflevector(At[m], At[m], 4, 5, 6, 7))); } \
        else { _Pragma("unroll") for (int m = 0; m < 4; ++m) _Pragma("unroll") for (int n = 0; n < 2; ++n) { \
               acc[ai][bj][m][n] = __builtin_amdgcn_mfma_f32_16x16x32_bf16(PG8_LO(Bt[n]), PG8_LO(At[m]), acc[ai][bj][m][n], 0, 0, 0); \
               acc[ai][bj][m][n] = __builtin_amdgcn_mfma_f32_16x16x32_bf16(PG8_HI(Bt[n]), PG8_HI(At[m]), acc[ai][bj][m][n], 0, 0, 0); } } \
        __builtin_amdgcn_s_setprio(0); } while (0)
#define PG8_WAIT_V(n) asm volatile("s_waitcnt vmcnt(" #n ")" ::: "memory")
#define PG8_WAIT_VN(n) asm volatile("s_waitcnt vmcnt(%0)" :: "n"(n) : "memory")
#define PG8_WAIT_L(n) asm volatile("s_waitcnt lgkmcnt(" #n ")" ::: "memory")
#define PG8_BAR __builtin_amdgcn_s_barrier()
#define PG8_SCHED __builtin_amdgcn_sched_barrier(0)
    Unit cur, nxt; int ui = 0;
    if (!S.next(0, cur)) return;
    f32x4 acc[2][2][4][2];
#pragma unroll
    for (int a = 0; a < 2; ++a)
#pragma unroll
        for (int b = 0; b < 2; ++b)
#pragma unroll
            for (int m = 0; m < 4; ++m)
#pragma unroll
                for (int n = 0; n < 2; ++n) { acc[a][b][m][n] = (f32x4){0.f, 0.f, 0.f, 0.f}; asm volatile("" : "+v"(acc[a][b][m][n])); }
    v8i_t At[4], B0[2], B1[2];
    const int f8one = 0x7f7f7f7f;
    unsigned aoC0[2] = {0u, 0u}, aoC1[2] = {0u, 0u};
    PG8_LAS unsigned char* idx_lds = lds + STAGE_BYTES + wid * 1024;
    if constexpr (GATHER) {
#pragma unroll
        for (int i = 0; i < 2; ++i) { int R, C; stage_rc(tid * 16 + i * 8192, R, C); const int r0 = g.rowidx[cur.pm * BM + R], r1 = g.rowidx[cur.pm * BM + HALF + R];
            aoC0[i] = (unsigned)r0 * (unsigned)Kb + (unsigned)(C * 2); aoC1[i] = (unsigned)r1 * (unsigned)Kb + (unsigned)(C * 2); }
    }
    const char* cA = GATHER ? (const char*)g.A : (const char*)g.A + (size_t)cur.pm * tstep; const char* cB = (const char*)g.Bt + (size_t)cur.e * g.bstride + (size_t)cur.pn * tstep;
    S.a_ready(cur);
    PG8_STAGE(PG8_SB(0, 0), cB, voffB); PG8_STAGE(PG8_SB(0, 1), cB + hstep, voffB); PG8_STAGE_A(PG8_SA(0, 0), cA, 0, aoC0, aoC1); PG8_STAGE_A(PG8_SA(0, 1), cA, 1, aoC0, aoC1);
    if (wr == 1) PG8_BAR;
    PG8_WAIT_V(2); PG8_BAR;
    PG8_STAGE(PG8_SB(1, 0), cB + kstep, voffB); PG8_STAGE_A(PG8_SA(1, 0), cA + kstep, 0, aoC0, aoC1); PG8_STAGE(PG8_SB(1, 1), cB + hstep + kstep, voffB);
    PG8_WAIT_V(6); PG8_BAR;
    PG8_LAS unsigned char* scal_lds = lds + STAGE_BYTES + 8192 + wid * 1024;
    for (;;) {
        const bool has_next = S.next(ui + 1, nxt);
        if constexpr (Epi::SCALES) E.prefetch(scal_lds, cur, wr, wc, lane);
        const char* nA = GATHER ? (const char*)g.A : (has_next ? (const char*)g.A + (size_t)nxt.pm * tstep : cA);
        const char* nB = has_next ? (const char*)g.Bt + (size_t)nxt.e * g.bstride + (size_t)nxt.pn * tstep : cB;
        if constexpr (GATHER) { if (has_next) {
#pragma unroll
            for (int i = 0; i < 2; ++i) { int R, C; stage_rc(tid * 16 + i * 8192, R, C);
                __builtin_amdgcn_global_load_lds((const unsigned*)(g.rowidx + nxt.pm * BM + R), (PG8_LAS unsigned*)(idx_lds + (2 * i) * 256), 4, 0, 0);
                __builtin_amdgcn_global_load_lds((const unsigned*)(g.rowidx + nxt.pm * BM + HALF + R), (PG8_LAS unsigned*)(idx_lds + (2 * i + 1) * 256), 4, 0, 0); } } }
#define PG8_TRIP(t, W1, W2, W3, NOSP1) do { \
            const bool last = ((t) == nt - 2); \
            const char* a1 = cA + (size_t)((t) + 1) * kstep; \
            const char* a2 = last ? nA : cA + (size_t)((t) + 2) * kstep; const char* b2 = last ? nB : cB + (size_t)((t) + 2) * kstep; \
            const char* a3 = a2 + kstep; const char* b3 = b2 + kstep; \
            if (last && has_next) S.a_ready(nxt); \
            PG8_LDB(B0, 0, 0); PG8_LDB(B1, 0, 1); PG8_SCHED; PG8_LDA(At, 0, 0); if (!(NOSP1)) PG8_STAGE_A(PG8_SA(1, 1), a1, 1, aoC0, aoC1); \
            if constexpr (GATHER) { if (last && has_next) { \
                _Pragma("unroll") for (int i = 0; i < 2; ++i) { int R, C; stage_rc(tid * 16 + i * 8192, R, C); \
                    const unsigned i0 = *(const PG8_LAS unsigned*)(idx_lds + (2 * i) * 256 + lane * 4), i1 = *(const PG8_LAS unsigned*)(idx_lds + (2 * i + 1) * 256 + lane * 4); \
                    aoC0[i] = i0 * (unsigned)Kb + (unsigned)(C * 2); aoC1[i] = i1 * (unsigned)Kb + (unsigned)(C * 2); } } } \
            PG8_WAIT_VN(W1); PG8_WAIT_L(0); PG8_BAR; PG8_MMA(0, 0, At, B0); PG8_MMA(0, 1, At, B1); PG8_BAR; PG8_SCHED; \
            PG8_LDA(At, 0, 1); PG8_STAGE(PG8_SB(0, 0), b2, voffB); PG8_STAGE(PG8_SB(0, 1), b2 + hstep, voffB); PG8_STAGE_A(PG8_SA(0, 0), a2, 0, aoC0, aoC1); \
            PG8_WAIT_VN(W2); PG8_WAIT_L(0); PG8_BAR; PG8_MMA(1, 0, At, B0); PG8_MMA(1, 1, At, B1); PG8_BAR; PG8_SCHED; \
            PG8_LDB(B0, 1, 0); PG8_LDB(B1, 1, 1); PG8_SCHED; PG8_LDA(At, 1, 0); PG8_STAGE_A(PG8_SA(0, 1), a2, 1, aoC0, aoC1); \
            PG8_WAIT_VN(W3); PG8_WAIT_L(0); PG8_BAR; PG8_MMA(0, 0, At, B0); PG8_MMA(0, 1, At, B1); PG8_BAR; PG8_SCHED; \
            PG8_LDA(At, 1, 1); PG8_STAGE(PG8_SB(1, 0), b3, voffB); PG8_STAGE(PG8_SB(1, 1), b3 + hstep, voffB); PG8_STAGE_A(PG8_SA(1, 0), a3, 0, aoC0, aoC1); \
            PG8_WAIT_VN(8); PG8_WAIT_L(0); PG8_BAR; PG8_MMA(1, 0, At, B0); PG8_MMA(1, 1, At, B1); PG8_BAR; PG8_SCHED; \
            if (last && has_next) PG8_STAGE_A(PG8_SA(1, 1), a3, 1, aoC0, aoC1);        \
        } while (0)
        int tbeg = 0;
        if (ui > 0) { PG8_TRIP(0, 8 + Epi::NST, 8 + Epi::NST, 8 + Epi::NST, true); tbeg = 2; }
#pragma clang loop unroll(disable)
        for (int t = tbeg; t < nt; t += 2) { PG8_TRIP(t, 8, 8, 8, false); }
#undef PG8_TRIP
        if constexpr (ALIGN_EPI) { if (wr == 0) PG8_BAR; }
        if constexpr (DT != 0) asm volatile("s_nop 15\n\ts_nop 15" ::: "memory");
        if constexpr (DT == 2) {
#pragma unroll
            for (int a = 0; a < 2; ++a)
#pragma unroll
                for (int b = 0; b < 2; ++b)
#pragma unroll
                    for (int m = 0; m < 4; ++m)
#pragma unroll
                        for (int n = 0; n < 2; ++n) { const v4i_t ci = __builtin_bit_cast(v4i_t, acc[a][b][m][n]); acc[a][b][m][n] = (f32x4){(float)ci[0], (float)ci[1], (float)ci[2], (float)ci[3]}; } }
        if constexpr (!Epi::AFTER_DRAIN) { E(acc, cur, wr, wc, fr, fq, scal_lds); S.done(cur); }
        if (!has_next) break;
#pragma unroll
        for (int a = 0; a < 2; ++a)
#pragma unroll
            for (int b = 0; b < 2; ++b)
#pragma unroll
                for (int m = 0; m < 4; ++m)
#pragma unroll
                    for (int n = 0; n < 2; ++n) { acc[a][b][m][n] = (f32x4){0.f, 0.f, 0.f, 0.f}; asm volatile("" : "+v"(acc[a][b][m][n])); }
        cur = nxt; cA = nA; cB = nB; ++ui;
        if constexpr (DT != 0) asm volatile("s_nop 7" ::: "memory");
        if constexpr (ALIGN_EPI) { if (wr == 1) PG8_BAR; }
    }
    PG8_WAIT_V(0);
    if constexpr (!ALIGN_EPI) { if (wr == 0) PG8_BAR; }
    PG8_BAR;
#undef PG8_SA
#undef PG8_SB
#undef PG8_STAGE
#undef PG8_STAGE_A
#undef PG8_LDA
#undef PG8_LDB
#undef PG8_MMA
#undef PG8_LD8
#undef PG8_LO
#undef PG8_HI
#undef PG8_WAIT_V
#undef PG8_WAIT_VN
#undef PG8_WAIT_L
#undef PG8_BAR
#undef PG8_SCHED
}
}

using pg8::bf16x8; using pg8::f32x4; using pg8::f32x2; using pg8::u32x4; using pg8::u32x2;
typedef unsigned short bf16;
#define LAS __attribute__((address_space(3)))
constexpr int D = 1024, NB = 32, SEQ = 2048, CTXL = 256, DEPTH = 4;
constexpr int MC = NB * CTXL, ML = NB * SEQ, MT = MC + ML;
constexpr int INW = 2816, DFF = 2816, NE = 8;
constexpr int NWAVES = 8, NTHR = 512;
constexpr float EPS = 1e-6f;
constexpr int NPH = 10;
constexpr int SLAB_TILES = 292;
constexpr float CSC = 8.0f, WSCO = 64.0f;
constexpr float WSC2 = 64.0f, HSC = 4.0f;
constexpr int MAX_SLOTS = 2 * MT + 8 * 256;

constexpr size_t MiB = 1u << 20;
constexpr size_t WS_CTL = 0, CTL_BYTES = 2 * MiB;
constexpr size_t WS_MOD = 2 * MiB;
constexpr size_t WS_ROPE = 6 * MiB;
constexpr size_t WS_SMALLW = 7 * MiB;
constexpr size_t WS_TOKINFO = 9 * MiB;
constexpr size_t WS_TOKSLOT = 11 * MiB;
constexpr size_t WS_SLOTTOK = 12 * MiB;
constexpr size_t WS_XCTX = 13 * MiB;
constexpr size_t WS_W = 45 * MiB;
constexpr size_t W_WIN = 0, W_WOUT = 3 * MiB, W_FFN = 5 * MiB;
constexpr size_t W13_BYTES = (size_t)2 * DFF * D, W2_BYTES = (size_t)D * DFF;
constexpr size_t WS_A = 119 * MiB;
constexpr size_t WS_XL = 191 * MiB;
constexpr size_t WS_A_OLD_UNUSED = 0;
constexpr size_t WS_R = 319 * MiB;
constexpr size_t WS_B = 715 * MiB;
constexpr size_t WS_Y = 859 * MiB;
constexpr size_t WS_END = 1003 * MiB;
constexpr size_t Y_SBUF = 0, Y_TLRU = 56 * MiB;
constexpr size_t MOE_YSLOT = WS_R, MOE_HID = WS_R + 292 * MiB;
static_assert(W_FFN + 8 * (W13_BYTES + W2_BYTES) <= WS_A - WS_W, "weights region");
static_assert((size_t)MAX_SLOTS * D * 2 <= 292 * MiB && MOE_HID + (size_t)SLAB_TILES * 256 * DFF <= WS_END, "moe scratch");
static_assert((size_t)NB * 6 * 2 * 18 * 4096 * 2 <= 56 * MiB && Y_TLRU + (size_t)MT * 384 * 2 <= 144 * MiB, "mixer scratch in Y");

constexpr int CW_QUEUE = 64;
constexpr int CW_GCNT = 3072;
constexpr int CW_GPOS = 3328;
constexpr int CW_BAR = 4096;

constexpr int RING_BYTES = 131072;
constexpr int LDS_BYTES = 155648;
constexpr int MISC_OFF = LDS_BYTES - 512;

__device__ __forceinline__ float bf_lo(unsigned w) { return __uint_as_float(w << 16); }
__device__ __forceinline__ float bf_hi(unsigned w) { return __uint_as_float(w & 0xffff0000u); }
__device__ __forceinline__ unsigned pk2(float lo, float hi) { return pg8::cvt_pk_bf16(lo, hi); }
__device__ __forceinline__ float fexp2(float x) { return __builtin_amdgcn_exp2f(x); }
__device__ __forceinline__ float fexp(float x) { return __builtin_amdgcn_exp2f(1.44269504f * x); }
__device__ __forceinline__ float sigm(float x) { return __builtin_amdgcn_rcpf(1.0f + fexp(-x)); }
__device__ __forceinline__ float silu_f(float x) { return x * sigm(x); }
__device__ __forceinline__ float gelu_t(float x) { const float u = 0.7978845608f * (x + 0.044715f * x * x * x); return x * sigm(2.0f * u); }
__device__ __forceinline__ unsigned pk4f8(float a, float b, float c, float d, float sc) {
    unsigned t = 0u;
    t = __builtin_amdgcn_cvt_pk_fp8_f32(__builtin_amdgcn_fmed3f(a * sc, -448.0f, 448.0f), __builtin_amdgcn_fmed3f(b * sc, -448.0f, 448.0f), t, false);
    t = __builtin_amdgcn_cvt_pk_fp8_f32(__builtin_amdgcn_fmed3f(c * sc, -448.0f, 448.0f), __builtin_amdgcn_fmed3f(d * sc, -448.0f, 448.0f), t, true);
    return t;
}
template <int CTRL> __device__ __forceinline__ float dpp_mov(float v) { return __builtin_bit_cast(float, __builtin_amdgcn_update_dpp(0, __builtin_bit_cast(int, v), CTRL, 0xF, 0xF, false)); }
__device__ __forceinline__ float lane_rd(float v, int l) { return __builtin_bit_cast(float, __builtin_amdgcn_readlane(__builtin_bit_cast(int, v), l)); }
__device__ __forceinline__ float wave_sum(float v) {
    v += dpp_mov<0xB1>(v); v += dpp_mov<0x4E>(v); v += dpp_mov<0x141>(v); v += dpp_mov<0x140>(v);
    return (lane_rd(v, 0) + lane_rd(v, 16)) + (lane_rd(v, 32) + lane_rd(v, 48));
}
__device__ __forceinline__ float wave_max(float v) {
    v = fmaxf(v, dpp_mov<0xB1>(v)); v = fmaxf(v, dpp_mov<0x4E>(v)); v = fmaxf(v, dpp_mov<0x141>(v)); v = fmaxf(v, dpp_mov<0x140>(v));
    return fmaxf(fmaxf(lane_rd(v, 0), lane_rd(v, 16)), fmaxf(lane_rd(v, 32), lane_rd(v, 48)));
}
__device__ __forceinline__ f32x4 mfma16(bf16x8 a, bf16x8 b, f32x4 c) { return __builtin_amdgcn_mfma_f32_16x16x32_bf16(a, b, c, 0, 0, 0); }
__device__ __forceinline__ bf16x8 ld16g(const bf16* p) { return __builtin_bit_cast(bf16x8, *(const u32x4*)p); }
__device__ __forceinline__ bf16x8 ld16l(const LAS bf16* p) { return __builtin_bit_cast(bf16x8, *(const LAS u32x4*)p); }

#define XB_TMO      128
#define XB_XCNT(j)  (256  + 64 * (j))
#define XB_XSUB(j)  (1280 + 64 * (j))
#define XB_XGEN(j)  (2304 + 64 * (j))
#define XB_TOP      3328
#define XB_TOPGEN   3392
#define XCD_BAR_WORDS 3456
#define XB_SPIN_CAP (1u << 18)
__device__ __forceinline__ unsigned xb_ld(unsigned* p)              { return __hip_atomic_load(p, __ATOMIC_RELAXED, __HIP_MEMORY_SCOPE_AGENT); }
__device__ __forceinline__ unsigned xb_add(unsigned* p, unsigned v) { return __hip_atomic_fetch_add(p, v, __ATOMIC_RELAXED, __HIP_MEMORY_SCOPE_AGENT); }
__device__ __forceinline__ unsigned xb_xcc_id() { return (unsigned)__builtin_amdgcn_s_getreg((3 << 11) | 20) & 0xFu; }
#define XB_SPIN(cond, bar) do { unsigned _sp = 0; while (cond) { __builtin_amdgcn_s_sleep(1); \
    if ((++_sp & 255u) == 0u) { if (xb_ld(&(bar)[XB_TMO])) break; if (_sp > XB_SPIN_CAP) { atomicAdd(&(bar)[XB_TMO], 1u); break; } } } } while (0)
struct XcdBarrier { unsigned* bar; unsigned x; volatile LAS unsigned* st; };
__device__ __forceinline__ bool fresh_t0(int wave0) { int l; asm volatile("v_mbcnt_lo_u32_b32 %0, -1, 0\n\tv_mbcnt_hi_u32_b32 %0, -1, %0" : "=v"(l)); return wave0 == 0 && l == 0; }
__device__ __forceinline__ XcdBarrier xcd_barrier_post(unsigned* bar, volatile LAS unsigned* st) {
    XcdBarrier b; b.bar = bar; b.x = xb_xcc_id(); b.st = st;
    if (threadIdx.x == 0) (void)xb_add(&bar[XB_XCNT(b.x)], 1u);
    return b;
}
__device__ __forceinline__ void xcd_barrier_complete(unsigned* bar, unsigned x, unsigned& nloc, unsigned& nx) {
    const unsigned G = gridDim.x * gridDim.y * gridDim.z;
    unsigned sum, cnt, mine, sp = 0u;
    for (;;) {
        sum = 0u; cnt = 0u; mine = 0u;
#pragma unroll
        for (unsigned j = 0; j < 16; ++j) { const unsigned c = xb_ld(&bar[XB_XCNT(j)]); sum += c; cnt += (c > 0u) ? 1u : 0u; mine = (j == x) ? c : mine; }
        if (sum == G) break;
        __builtin_amdgcn_s_sleep(1);
        if ((++sp & 255u) == 0u) { if (xb_ld(&bar[XB_TMO])) break; if (sp > XB_SPIN_CAP) { atomicAdd(&bar[XB_TMO], 1u); break; } }
    }
    nloc = mine > 0u ? mine : 1u; nx = cnt > 0u ? cnt : 1u;
}
__device__ __forceinline__ void xcd_barrier(const XcdBarrier& b, const bool t0) {
    asm volatile("s_waitcnt vmcnt(0)" ::: "memory");
    __syncthreads();
    if (t0) {
        unsigned* bar = b.bar;
        __builtin_amdgcn_s_waitcnt(0);
        unsigned nloc = b.st[0], nx = b.st[1];
        if (nloc == 0u) { xcd_barrier_complete(bar, b.x, nloc, nx); b.st[0] = nloc; b.st[1] = nx; }
        const unsigned old = xb_add(&bar[XB_XSUB(b.x)], 1u);
        const unsigned gen = old / nloc;
        if (old + 1u == (gen + 1u) * nloc) {
            __builtin_amdgcn_fence(__ATOMIC_RELEASE, "agent");
            asm volatile("s_waitcnt vmcnt(0)" ::: "memory");
            const unsigned og = xb_add(&bar[XB_TOP], 1u);
            const unsigned tg = og / nx;
            if (og + 1u == (tg + 1u) * nx) xb_add(&bar[XB_TOPGEN], 1u);
            else XB_SPIN(xb_ld(&bar[XB_TOPGEN]) == tg, bar);
            __builtin_amdgcn_fence(__ATOMIC_ACQUIRE, "agent");
            xb_add(&bar[XB_XGEN(b.x)], 1u);
            asm volatile("s_waitcnt vmcnt(0)" ::: "memory");
        } else {
            XB_SPIN(xb_ld(&bar[XB_XGEN(b.x)]) == gen, bar);
            __builtin_amdgcn_fence(__ATOMIC_ACQUIRE, "agent");
            asm volatile("s_waitcnt vmcnt(0)" ::: "memory");
        }
    }
    __syncthreads();
}

__device__ __forceinline__ void transpose_item(const float* W, int N, bf16* WT, int Kp, int k0, int n0, int drow0, LAS float* scr, int lane) {
    { f32x4 v[8];
#pragma unroll
      for (int i = 0; i < 8; ++i) v[i] = *(const f32x4*)(W + (size_t)(k0 + 8 * i + (lane >> 3)) * N + n0 + 4 * (lane & 7));
#pragma unroll
      for (int i = 0; i < 8; ++i) { LAS float* d = scr + (8 * i + (lane >> 3)) * 33 + 4 * (lane & 7); d[0] = v[i][0]; d[1] = v[i][1]; d[2] = v[i][2]; d[3] = v[i][3]; } }
    asm volatile("s_waitcnt lgkmcnt(0)" ::: "memory");
    const int c = lane & 7;
#pragma unroll
    for (int j = 0; j < 4; ++j) { const int n = (lane >> 3) + 8 * j; const LAS float* s = scr + (8 * c) * 33 + n;
        u32x4 o; o.x = pk2(s[0 * 33], s[1 * 33]); o.y = pk2(s[2 * 33], s[3 * 33]); o.z = pk2(s[4 * 33], s[5 * 33]); o.w = pk2(s[6 * 33], s[7 * 33]);
        *(u32x4*)(WT + (size_t)(drow0 + n) * Kp + k0 + 8 * c) = o; }
    asm volatile("s_waitcnt lgkmcnt(0)" ::: "memory");
}
__device__ __forceinline__ void transpose_item8(const float* W, int N, unsigned char* WT, int Kp, int k0, int n0, int drow0, float sc, LAS float* scr, int lane) {
    { f32x4 v[8];
#pragma unroll
      for (int i = 0; i < 8; ++i) v[i] = *(const f32x4*)(W + (size_t)(k0 + 8 * i + (lane >> 3)) * N + n0 + 4 * (lane & 7));
#pragma unroll
      for (int i = 0; i < 8; ++i) { LAS float* d = scr + (8 * i + (lane >> 3)) * 33 + 4 * (lane & 7); d[0] = v[i][0]; d[1] = v[i][1]; d[2] = v[i][2]; d[3] = v[i][3]; } }
    asm volatile("s_waitcnt lgkmcnt(0)" ::: "memory");
    const int c = lane & 7;
#pragma unroll
    for (int j = 0; j < 4; ++j) { const int n = (lane >> 3) + 8 * j; const LAS float* sp = scr + (8 * c) * 33 + n;
        u32x2 o; unsigned t = 0u;
        float q8[8];
#pragma unroll
        for (int k = 0; k < 8; ++k) q8[k] = __builtin_amdgcn_fmed3f(sp[k * 33] * sc, -448.0f, 448.0f);
        t = __builtin_amdgcn_cvt_pk_fp8_f32(q8[0], q8[1], t, false); t = __builtin_amdgcn_cvt_pk_fp8_f32(q8[2], q8[3], t, true); o.x = t;
        t = __builtin_amdgcn_cvt_pk_fp8_f32(q8[4], q8[5], t, false); t = __builtin_amdgcn_cvt_pk_fp8_f32(q8[6], q8[7], t, true); o.y = t;
        *(u32x2*)(WT + (size_t)(drow0 + n) * Kp + k0 + 8 * c) = o; }
    asm volatile("s_waitcnt lgkmcnt(0)" ::: "memory");
}
__device__ __forceinline__ void conv_i8_item(const float* W, int N, signed char* WT, float* SW, int n0, int drow0, LAS float* scr, int lane) {
    const int cg = lane & 7, rg = lane >> 3;
    const float* wp = W + n0 + 4 * cg;
    f32x4 mx = (f32x4){0.f, 0.f, 0.f, 0.f};
#pragma unroll 16
    for (int i = 0; i < D / 8; ++i) { const f32x4 v = *(const f32x4*)(wp + (size_t)(8 * i + rg) * N); mx[0] = fmaxf(mx[0], fabsf(v[0])); mx[1] = fmaxf(mx[1], fabsf(v[1])); mx[2] = fmaxf(mx[2], fabsf(v[2])); mx[3] = fmaxf(mx[3], fabsf(v[3])); }
#pragma unroll
    for (int o = 8; o < 64; o <<= 1) { mx[0] = fmaxf(mx[0], __shfl_xor(mx[0], o)); mx[1] = fmaxf(mx[1], __shfl_xor(mx[1], o)); mx[2] = fmaxf(mx[2], __shfl_xor(mx[2], o)); mx[3] = fmaxf(mx[3], __shfl_xor(mx[3], o)); }
    f32x4 inv;
#pragma unroll
    for (int j = 0; j < 4; ++j) inv[j] = mx[j] > 0.f ? 127.0f / mx[j] : 0.f;
    if (lane < 8) *(f32x4*)(SW + drow0 + 4 * lane) = mx * (1.0f / 127.0f);
    for (int kb2 = 0; kb2 < D / 64; kb2 += 2) {
        f32x4 v[2][8];
#pragma unroll
        for (int h = 0; h < 2; ++h)
#pragma unroll
            for (int i = 0; i < 8; ++i) v[h][i] = *(const f32x4*)(wp + (size_t)(64 * (kb2 + h) + 8 * i + rg) * N);
#pragma unroll
        for (int h = 0; h < 2; ++h) { const int kb = kb2 + h;
#pragma unroll
            for (int i = 0; i < 8; ++i) { LAS float* d = scr + (8 * i + rg) * 33 + 4 * cg; d[0] = v[h][i][0] * inv[0]; d[1] = v[h][i][1] * inv[1]; d[2] = v[h][i][2] * inv[2]; d[3] = v[h][i][3] * inv[3]; }
            asm volatile("s_waitcnt lgkmcnt(0)" ::: "memory");
            const int c = lane & 7;
#pragma unroll
            for (int j = 0; j < 4; ++j) { const int n = (lane >> 3) + 8 * j; const LAS float* sp = scr + (8 * c) * 33 + n;
                unsigned q[8];
#pragma unroll
                for (int t = 0; t < 8; ++t) q[t] = (unsigned)(int)rintf(sp[t * 33]) & 0xffu;
                u32x2 o; o.x = q[0] | (q[1] << 8) | (q[2] << 16) | (q[3] << 24); o.y = q[4] | (q[5] << 8) | (q[6] << 16) | (q[7] << 24);
                *(u32x2*)(WT + (size_t)(drow0 + n) * D + 64 * kb + 8 * c) = o; }
            asm volatile("s_waitcnt lgkmcnt(0)" ::: "memory"); }
    }
}
__device__ __forceinline__ void conv_i8_item_wg(const float* W, int N, signed char* WT, float* SW, int n0, int drow0, LAS float* scr, LAS float* mxs, int wave, int lane) {
    const int cg = lane & 7, rg = lane >> 3;
    const float* wp = W + n0 + 4 * cg;
    f32x4 mx = (f32x4){0.f, 0.f, 0.f, 0.f};
    f32x4 vv[16];
#pragma unroll
    for (int i = 0; i < 16; ++i) vv[i] = *(const f32x4*)(wp + (size_t)(128 * wave + 8 * i + rg) * N);
#pragma unroll
    for (int i = 0; i < 16; ++i) { const f32x4 v = vv[i]; mx[0] = fmaxf(mx[0], fabsf(v[0])); mx[1] = fmaxf(mx[1], fabsf(v[1])); mx[2] = fmaxf(mx[2], fabsf(v[2])); mx[3] = fmaxf(mx[3], fabsf(v[3])); }
#pragma unroll
    for (int o = 8; o < 64; o <<= 1) { mx[0] = fmaxf(mx[0], __shfl_xor(mx[0], o)); mx[1] = fmaxf(mx[1], __shfl_xor(mx[1], o)); mx[2] = fmaxf(mx[2], __shfl_xor(mx[2], o)); mx[3] = fmaxf(mx[3], __shfl_xor(mx[3], o)); }
    if (lane < 8) *(LAS f32x4*)(mxs + wave * 32 + 4 * lane) = mx;
    __syncthreads();
#pragma unroll
    for (int w = 0; w < 8; ++w) { const f32x4 o = *(const LAS f32x4*)(mxs + w * 32 + 4 * cg); mx[0] = fmaxf(mx[0], o[0]); mx[1] = fmaxf(mx[1], o[1]); mx[2] = fmaxf(mx[2], o[2]); mx[3] = fmaxf(mx[3], o[3]); }
    f32x4 inv;
#pragma unroll
    for (int j = 0; j < 4; ++j) inv[j] = mx[j] > 0.f ? 127.0f / mx[j] : 0.f;
    if (wave == 0 && lane < 8) *(f32x4*)(SW + drow0 + 4 * lane) = mx * (1.0f / 127.0f);
#pragma unroll
    for (int h = 0; h < 2; ++h) { const int kb = 2 * wave + h;
#pragma unroll
        for (int i = 0; i < 8; ++i) { LAS float* d = scr + (8 * i + rg) * 33 + 4 * cg; d[0] = vv[8 * h + i][0] * inv[0]; d[1] = vv[8 * h + i][1] * inv[1]; d[2] = vv[8 * h + i][2] * inv[2]; d[3] = vv[8 * h + i][3] * inv[3]; }
        asm volatile("s_waitcnt lgkmcnt(0)" ::: "memory");
        const int c = lane & 7;
#pragma unroll
        for (int j = 0; j < 4; ++j) { const int n = (lane >> 3) + 8 * j; const LAS float* sp = scr + (8 * c) * 33 + n;
            unsigned q[8];
#pragma unroll
            for (int t = 0; t < 8; ++t) q[t] = (unsigned)(int)rintf(sp[t * 33]) & 0xffu;
            u32x2 o; o.x = q[0] | (q[1] << 8) | (q[2] << 16) | (q[3] << 24); o.y = q[4] | (q[5] << 8) | (q[6] << 16) | (q[7] << 24);
            *(u32x2*)(WT + (size_t)(drow0 + n) * D + 64 * kb + 8 * c) = o; }
        asm volatile("s_waitcnt lgkmcnt(0)" ::: "memory");
    }
    __syncthreads();
}
template <bool FP8>
__device__ __forceinline__ void transpose_quad(const float* W, int N, void* WTv, int Kp, int k0, int n0, int drow0, float sc, LAS float* scr, int lane) {
    f32x4 v[4][8];
#pragma unroll
    for (int q = 0; q < 4; ++q)
#pragma unroll
        for (int i = 0; i < 8; ++i) v[q][i] = *(const f32x4*)(W + (size_t)(k0 + 8 * i + (lane >> 3)) * N + n0 + 32 * q + 4 * (lane & 7));
    const int c = lane & 7;
#pragma unroll
    for (int q = 0; q < 4; ++q) {
#pragma unroll
        for (int i = 0; i < 8; ++i) { LAS float* d = scr + (8 * i + (lane >> 3)) * 33 + 4 * (lane & 7); d[0] = v[q][i][0]; d[1] = v[q][i][1]; d[2] = v[q][i][2]; d[3] = v[q][i][3]; }
        asm volatile("s_waitcnt lgkmcnt(0)" ::: "memory");
#pragma unroll
        for (int j = 0; j < 4; ++j) { const int n = (lane >> 3) + 8 * j; const LAS float* sp = scr + (8 * c) * 33 + n;
            if constexpr (FP8) {
                u32x2 o; unsigned t = 0u; float q8[8];
#pragma unroll
                for (int k = 0; k < 8; ++k) q8[k] = __builtin_amdgcn_fmed3f(sp[k * 33] * sc, -448.0f, 448.0f);
                t = __builtin_amdgcn_cvt_pk_fp8_f32(q8[0], q8[1], t, false); t = __builtin_amdgcn_cvt_pk_fp8_f32(q8[2], q8[3], t, true); o.x = t;
                t = __builtin_amdgcn_cvt_pk_fp8_f32(q8[4], q8[5], t, false); t = __builtin_amdgcn_cvt_pk_fp8_f32(q8[6], q8[7], t, true); o.y = t;
                *(u32x2*)((unsigned char*)WTv + (size_t)(drow0 + 32 * q + n) * Kp + k0 + 8 * c) = o;
            } else {
                u32x4 o; o.x = pk2(sp[0 * 33], sp[1 * 33]); o.y = pk2(sp[2 * 33], sp[3 * 33]); o.z = pk2(sp[4 * 33], sp[5 * 33]); o.w = pk2(sp[6 * 33], sp[7 * 33]);
                *(u32x4*)((bf16*)WTv + (size_t)(drow0 + 32 * q + n) * Kp + k0 + 8 * c) = o; } }
        asm volatile("s_waitcnt lgkmcnt(0)" ::: "memory");
    }
}
__device__ __forceinline__ void conv_plain(const float* W, int K, int N, bf16* WT, int item, LAS float* scr, int lane) {
    const int nblk = N / 32, kb = item / nblk, nb = item % nblk;
    transpose_item(W, N, WT, K, 64 * kb, 32 * nb, 32 * nb, scr, lane);
}
__device__ __forceinline__ void conv_w2(const float* W, unsigned char* WT, int item, LAS float* scr, int lane) {
    const int nblk = D / 32, kb = item / nblk, nb = item % nblk;
    transpose_item8(W, D, WT, DFF, 64 * kb, 32 * nb, 32 * nb, WSC2, scr, lane);
}

struct Params {
    const float* in[31];
    float* out;
    unsigned char* ws;
    int l_lo, l_hi, ph_lo, ph_hi, bar_region, slab_cap;
};

template <int MODE, bool XIN32>
__device__ __forceinline__ void row_issue(int m, const void* xin_ctx, const void* xin_lat, const bf16* Y, const bf16* yslot, int2 sl, int lane, f32x4 (&x)[4], u32x2 (&xb)[4], u32x2 (&ya)[4], u32x2 (&yb)[4]) {
    if (XIN32) { const float* xi = (m < MC) ? (const float*)xin_ctx + (size_t)m * D : (const float*)xin_lat + (size_t)(m - MC) * D;
#pragma unroll
        for (int j = 0; j < 4; ++j) x[j] = __builtin_nontemporal_load((const f32x4*)(xi + 4 * lane + 256 * j)); }
    else { const bf16* xi = (m < MC) ? (const bf16*)xin_ctx + (size_t)m * D : (const bf16*)xin_lat + (size_t)(m - MC) * D;
#pragma unroll
        for (int j = 0; j < 4; ++j) xb[j] = __builtin_nontemporal_load((const u32x2*)(xi + 4 * lane + 256 * j)); }
    if (MODE == 1) { const bf16* yr = Y + (size_t)m * D;
#pragma unroll
        for (int j = 0; j < 4; ++j) ya[j] = __builtin_nontemporal_load((const u32x2*)(yr + 4 * lane + 256 * j)); }
    if (MODE == 2) { const bf16* y1 = yslot + (size_t)sl.x * D; const bf16* y2 = yslot + (size_t)sl.y * D;
#pragma unroll
        for (int j = 0; j < 4; ++j) { ya[j] = __builtin_nontemporal_load((const u32x2*)(y1 + 4 * lane + 256 * j)); yb[j] = __builtin_nontemporal_load((const u32x2*)(y2 + 4 * lane + 256 * j)); } }
}
template <int MODE, bool ROUTER, bool WRITE_H, bool XIN32, bool XOUT32>
__device__ __forceinline__ void row_phase(float* SA, const void* xin_ctx, const void* xin_lat, void* xo_ctx, void* xo_lat,
                                          const bf16* Y, const bf16* yslot, const uint4* tokinfo, const int2* tokslot,
                                          const float* gpost, const float* gpre, const float* modl, int o_gt, int o_sh, int o_sc,
                                          bf16* Aout, const float* router_w, uint4* tokinfo_out, LAS unsigned* lcnt, unsigned* gcnt,
                                          int m_lo, int m_hi, int G, int bid, int wave, int lane, int tid, LAS unsigned char* rw_lds = nullptr) {
    const int nw = G * NWAVES, gw = bid * NWAVES + wave;
    const int per = (m_hi - m_lo) / nw;
    const int mbase = m_lo + gw * per;
    f32x4 gq[4], gp[4];
#pragma unroll
    for (int j = 0; j < 4; ++j) { gp[j] = (f32x4){0.f, 0.f, 0.f, 0.f}; gq[j] = gp[j]; }
    extern __shared__ __attribute__((aligned(16))) unsigned char lds_dyn_rp[];
    LAS float* VEC = (LAS float*)((LAS unsigned char*)lds_dyn_rp + 40960);
    const int m_first = m_lo + bid * NWAVES * per; const int mrow_wg = (m_first < MC) ? 32 : ((m_first - MC) >> 11);
    { const float* mpw = modl + (size_t)mrow_wg * 6144;
      for (int i = tid; i < D; i += NTHR) { VEC[i] = gpre[i]; VEC[D + i] = (MODE != 0) ? gpost[i] : 0.f; VEC[2 * D + i] = (MODE != 0) ? mpw[o_gt + i] : 0.f; VEC[3 * D + i] = mpw[o_sh + i]; VEC[4 * D + i] = mpw[o_sc + i]; } }
    LAS float* RW = (LAS float*)rw_lds;
    if (ROUTER) { if (tid < 8) lcnt[tid] = 0u;
        for (int i = tid; i < D * 8; i += NTHR) RW[(i & 7) * D + (i >> 3)] = router_w[i]; }
    __syncthreads();
#pragma unroll
    for (int j = 0; j < 4; ++j) { gp[j] = *(const LAS f32x4*)(VEC + 4 * lane + 256 * j); if (MODE != 0) gq[j] = *(const LAS f32x4*)(VEC + D + 4 * lane + 256 * j); }
    int mrow_cur = -1; f32x4 vgt[4], vsh[4], vsc[4];
#pragma unroll
    for (int j = 0; j < 4; ++j) { vgt[j] = (f32x4){0.f, 0.f, 0.f, 0.f}; vsh[j] = vgt[j]; vsc[j] = vgt[j]; }
    f32x4 xn[4]; u32x2 xbn[4], yan[4], ybn[4]; int2 sl_n2 = make_int2(0, 0); uint4 ti_c = make_uint4(0, 0, 0, 0), ti_n = ti_c;
#pragma unroll
    for (int j = 0; j < 4; ++j) { xn[j] = (f32x4){0.f, 0.f, 0.f, 0.f}; yan[j] = (u32x2){0u, 0u}; ybn[j] = yan[j]; xbn[j] = yan[j]; }
    { int2 sl0 = make_int2(0, 0); if (MODE == 2) { sl0 = tokslot[mbase]; ti_n = tokinfo[mbase]; if (per > 1) sl_n2 = tokslot[mbase + 1]; }
      row_issue<MODE, XIN32>(mbase, xin_ctx, xin_lat, Y, yslot, sl0, lane, xn, xbn, yan, ybn); }
    for (int i = 0; i < per; ++i) {
        const int m = mbase + i;
        f32x4 x[4]; u32x2 ya[4], yb[4];
#pragma unroll
        for (int j = 0; j < 4; ++j) { if (XIN32) x[j] = xn[j]; else x[j] = (f32x4){bf_lo(xbn[j].x), bf_hi(xbn[j].x), bf_lo(xbn[j].y), bf_hi(xbn[j].y)}; ya[j] = yan[j]; yb[j] = ybn[j]; }
        ti_c = ti_n;
        if (i + 1 < per) { const int2 sl1 = sl_n2; if (MODE == 2) { ti_n = tokinfo[m + 1]; if (i + 2 < per) sl_n2 = tokslot[m + 2]; }
            row_issue<MODE, XIN32>(m + 1, xin_ctx, xin_lat, Y, yslot, sl1, lane, xn, xbn, yan, ybn); }
        const bool isctx = m < MC;
        const int mrow = isctx ? 32 : ((m - MC) >> 11);
        if (mrow != mrow_cur) { mrow_cur = mrow; const float* mp = modl + (size_t)mrow * 6144;
            if (mrow == mrow_wg) {
#pragma unroll
                for (int j = 0; j < 4; ++j) { if (MODE != 0) vgt[j] = *(const LAS f32x4*)(VEC + 2 * D + 4 * lane + 256 * j); vsh[j] = *(const LAS f32x4*)(VEC + 3 * D + 4 * lane + 256 * j); vsc[j] = *(const LAS f32x4*)(VEC + 4 * D + 4 * lane + 256 * j); }
            } else {
#pragma unroll
                for (int j = 0; j < 4; ++j) { if (MODE != 0) vgt[j] = *(const f32x4*)(mp + o_gt + 4 * lane + 256 * j); vsh[j] = *(const f32x4*)(mp + o_sh + 4 * lane + 256 * j); vsc[j] = *(const f32x4*)(mp + o_sc + 4 * lane + 256 * j); } } }
        if (MODE != 0) {
            f32x4 y[4];
            if (MODE == 1) {
#pragma unroll
                for (int j = 0; j < 4; ++j) y[j] = (f32x4){bf_lo(ya[j].x), bf_hi(ya[j].x), bf_lo(ya[j].y), bf_hi(ya[j].y)};
            } else {
                const float w1 = __uint_as_float(ti_c.z), w2 = __uint_as_float(ti_c.w);
#pragma unroll
                for (int j = 0; j < 4; ++j) y[j] = (f32x4){w1 * bf_lo(ya[j].x) + w2 * bf_lo(yb[j].x), w1 * bf_hi(ya[j].x) + w2 * bf_hi(yb[j].x), w1 * bf_lo(ya[j].y) + w2 * bf_lo(yb[j].y), w1 * bf_hi(ya[j].y) + w2 * bf_hi(yb[j].y)};
            }
            float ss = 0.f;
#pragma unroll
            for (int j = 0; j < 4; ++j) ss += (y[j][0] * y[j][0] + y[j][1] * y[j][1]) + (y[j][2] * y[j][2] + y[j][3] * y[j][3]);
            const float rs = 1.0f / sqrtf(wave_sum(ss) * (1.0f / D) + EPS);
#pragma unroll
            for (int j = 0; j < 4; ++j) x[j] = x[j] + vgt[j] * (y[j] * rs * gq[j]);
            if (XOUT32) { float* xo = isctx ? (float*)xo_ctx + (size_t)m * D : (float*)xo_lat + (size_t)(m - MC) * D;
#pragma unroll
                for (int j = 0; j < 4; ++j) __builtin_nontemporal_store(x[j], (f32x4*)(xo + 4 * lane + 256 * j)); }
            else { bf16* xo = isctx ? (bf16*)xo_ctx + (size_t)m * D : (bf16*)xo_lat + (size_t)(m - MC) * D;
#pragma unroll
                for (int j = 0; j < 4; ++j) { u32x2 w; w.x = pk2(x[j][0], x[j][1]); w.y = pk2(x[j][2], x[j][3]); __builtin_nontemporal_store(w, (u32x2*)(xo + 4 * lane + 256 * j));
                    x[j] = (f32x4){bf_lo(w.x), bf_hi(w.x), bf_lo(w.y), bf_hi(w.y)}; } }
        }
        if (WRITE_H) {
            float s2 = 0.f;
#pragma unroll
            for (int j = 0; j < 4; ++j) s2 += (x[j][0] * x[j][0] + x[j][1] * x[j][1]) + (x[j][2] * x[j][2] + x[j][3] * x[j][3]);
            const float r2 = 1.0f / sqrtf(wave_sum(s2) * (1.0f / D) + EPS);
            f32x4 h[4]; float amax = 0.f;
#pragma unroll
            for (int j = 0; j < 4; ++j) { h[j] = (x[j] * r2 * gp[j]) * (vsc[j] + 1.0f) + vsh[j]; amax = fmaxf(fmaxf(amax, fmaxf(fabsf(h[j][0]), fabsf(h[j][1]))), fmaxf(fabsf(h[j][2]), fabsf(h[j][3]))); }
            amax = wave_max(amax);
            const float qinv = amax > 0.f ? 127.0f / amax : 0.f;
            if (lane == 0) SA[m] = amax * (1.0f / 127.0f);
#pragma unroll
            for (int j = 0; j < 4; ++j) { const unsigned q0 = (unsigned)(int)rintf(h[j][0] * qinv) & 0xffu, q1 = (unsigned)(int)rintf(h[j][1] * qinv) & 0xffu, q2 = (unsigned)(int)rintf(h[j][2] * qinv) & 0xffu, q3 = (unsigned)(int)rintf(h[j][3] * qinv) & 0xffu;
                __builtin_nontemporal_store(q0 | (q1 << 8) | (q2 << 16) | (q3 << 24), (unsigned*)((unsigned char*)Aout + (size_t)m * D + 4 * lane + 256 * j)); }
            if (ROUTER) {
                float lg[8];
#pragma unroll
                for (int e = 0; e < 8; ++e) lg[e] = 0.f;
#pragma unroll
                for (int j = 0; j < 4; ++j)
#pragma unroll
                    for (int e = 0; e < 8; ++e) { const f32x4 r = *(const LAS f32x4*)(RW + e * D + 4 * lane + 256 * j);
                        lg[e] += (h[j][0] * r[0] + h[j][1] * r[1]) + (h[j][2] * r[2] + h[j][3] * r[3]); }
#pragma unroll
                for (int e = 0; e < 8; ++e) lg[e] = wave_sum(lg[e]);
                int e1 = 0; float l1 = lg[0];
#pragma unroll
                for (int e = 1; e < 8; ++e) if (lg[e] > l1) { l1 = lg[e]; e1 = e; }
                int e2 = -1; float l2 = -3.0e38f;
#pragma unroll
                for (int e = 0; e < 8; ++e) if (e != e1 && lg[e] > l2) { l2 = lg[e]; e2 = e; }
                const float w1 = 1.0f / (1.0f + expf(l2 - l1)), w2 = 1.0f - w1;
                if (lane == 0) { tokinfo_out[m] = make_uint4((unsigned)e1, (unsigned)e2, __float_as_uint(w1), __float_as_uint(w2));
                    __hip_atomic_fetch_add(lcnt + e1, 1u, __ATOMIC_RELAXED, __HIP_MEMORY_SCOPE_WORKGROUP); __hip_atomic_fetch_add(lcnt + e2, 1u, __ATOMIC_RELAXED, __HIP_MEMORY_SCOPE_WORKGROUP); }
            }
        }
    }
    if (ROUTER) {
        __syncthreads();
        if (tid < 8) { const unsigned c = lcnt[tid]; if (c) __hip_atomic_fetch_add(gcnt + tid, c, __ATOMIC_RELAXED, __HIP_MEMORY_SCOPE_AGENT); }
    }
}

__device__ __forceinline__ void lru_blk(int half, int s, int& isctx, int& bi) { isctx = s < 4; bi = (half == 0) ? (isctx ? s : s - 4) : (isctx ? 3 - s : 35 - s); }
__device__ __forceinline__ void lru_unit(LAS unsigned char* lds, const bf16* P, bf16* CAT, bf16* TL, const bf16* WaT, const bf16* WxT,
                                         const float* ba, const float* bx, const float* lam, const float* convw, const float* convb,
                                         int b, int hh, bool want_ctx, int tid) {
    const int wave = __builtin_amdgcn_readfirstlane(tid >> 6), lane = tid & 63, fr = lane & 15, fg = lane >> 4;
    const int half = wave >> 2, w4 = wave & 3, tidh = tid & 255;
    LAS unsigned char* hb = lds + half * 59136;
    LAS bf16* Xr = (LAS bf16*)hb;
    LAS bf16* Xc = (LAS bf16*)(hb + 17152);
    LAS f32x2* AU = (LAS f32x2*)(hb + 17152 + 9216);
    LAS float* CW = (LAS float*)(lds + 118272);
    if (tid < 320) CW[tid] = (tid < 256) ? convw[(tid >> 6) * 384 + hh * 64 + (tid & 63)] : convb[hh * 64 + (tid - 256)];
    const bf16* wa = WaT + (size_t)(half * 6 + hh) * 4096; const bf16* wx = WxT + (size_t)(half * 6 + hh) * 4096;
    bf16x8 Ba[4][2], Bx[4][2]; float bav[4], bxv[4], spv[4];
#pragma unroll
    for (int nt = 0; nt < 4; ++nt) {
#pragma unroll
        for (int ks = 0; ks < 2; ++ks) { Ba[nt][ks] = ld16g(wa + (nt * 16 + fr) * 64 + ks * 32 + fg * 8); Bx[nt][ks] = ld16g(wx + (nt * 16 + fr) * 64 + ks * 32 + fg * 8); }
        const int ch = (half * 6 + hh) * 64 + nt * 16 + fr;
        bav[nt] = -1.44269504f * ba[ch]; bxv[nt] = -1.44269504f * bx[ch]; const float lm = lam[ch]; spv[nt] = -8.0f * 1.44269504f * ((lm > 15.f) ? expf(-lm) : log1pf(expf(-lm)));
    }
    float hstate = 0.f;
    u32x4 rr[3];
#define LRU_RAW_LOAD(ISCTX, BI) do { const int seqlen_ = (ISCTX) ? CTXL : SEQ; const size_t m0_ = (ISCTX) ? (size_t)b * CTXL : (size_t)MC + (size_t)b * SEQ; \
        _Pragma("unroll") for (int k = 0; k < 3; ++k) { const int q = tidh + 256 * k, tp = (BI) * 64 - 2 + (q >> 3); rr[k] = (u32x4){0u, 0u, 0u, 0u}; \
            if (q < 536 && tp >= 0 && tp < seqlen_) rr[k] = *(const u32x4*)(P + (m0_ + tp) * INW + hh * 64 + (q & 7) * 8); } } while (0)
#define LRU_RAW_STORE(BUF) do { _Pragma("unroll") for (int k = 0; k < 3; ++k) { const int q = tidh + 256 * k; if (q < 536) *(LAS u32x4*)(Xr + (BUF) * 4288 + q * 8) = rr[k]; } } while (0)
    { int ic, bb; lru_blk(half, 0, ic, bb); LRU_RAW_LOAD(ic, bb); LRU_RAW_STORE(0); }
    __syncthreads();
    for (int s = 0; s < 36; ++s) {
        int isctx, bi; lru_blk(half, s, isctx, bi);
        const size_t m0 = isctx ? (size_t)b * CTXL : (size_t)MC + (size_t)b * SEQ;
        if (s + 1 < 36) { int ic, bb; lru_blk(half, s + 1, ic, bb); LRU_RAW_LOAD(ic, bb); }
        { const int pos = tidh >> 2, cq = tidh & 3; f32x2 acc[8]; const LAS bf16* xr = Xr + (s & 1) * 4288;
#pragma unroll
            for (int c = 0; c < 8; ++c) acc[c] = *(const LAS f32x2*)(CW + 256 + cq * 16 + 2 * c);
#pragma unroll
            for (int j = 0; j < 4; ++j) { const u32x4 a = *(const LAS u32x4*)(xr + (pos + j) * 64 + cq * 16), c2 = *(const LAS u32x4*)(xr + (pos + j) * 64 + cq * 16 + 8);
                const unsigned ww[8] = {a.x, a.y, a.z, a.w, c2.x, c2.y, c2.z, c2.w};
#pragma unroll
                for (int q = 0; q < 8; ++q) acc[q] += *(const LAS f32x2*)(CW + j * 64 + cq * 16 + 2 * q) * (f32x2){bf_lo(ww[q]), bf_hi(ww[q])}; }
            u32x4 o0, o1; o0.x = pk2(acc[0].x, acc[0].y); o0.y = pk2(acc[1].x, acc[1].y); o0.z = pk2(acc[2].x, acc[2].y); o0.w = pk2(acc[3].x, acc[3].y);
            o1.x = pk2(acc[4].x, acc[4].y); o1.y = pk2(acc[5].x, acc[5].y); o1.z = pk2(acc[6].x, acc[6].y); o1.w = pk2(acc[7].x, acc[7].y);
            *(LAS u32x4*)(Xc + pos * 72 + cq * 16) = o0; *(LAS u32x4*)(Xc + pos * 72 + cq * 16 + 8) = o1; }
        __syncthreads();
        const int nb_half = isctx ? 2 : 16; const bool second = (half == 0) ? (bi >= nb_half) : (bi < nb_half);
        const bool emit = want_ctx || !isctx;
        const int opos = tidh >> 2, ocq = tidh & 3; const size_t om = m0 + bi * 64 + opos;
        bf16* tp = TL + om * 384 + hh * 64 + ocq * 16;
        u32x4 t0 = (u32x4){0u, 0u, 0u, 0u}, t1 = t0, y0 = t0, y1 = t0;
        if (emit && second) { t0 = *(const u32x4*)tp; t1 = *(const u32x4*)(tp + 8); const bf16* lp = P + om * INW + 384 + hh * 64 + ocq * 16; y0 = *(const u32x4*)lp; y1 = *(const u32x4*)(lp + 8); }
        { const bf16x8 A0 = ld16l(Xc + (w4 * 16 + fr) * 72 + fg * 8), A1 = ld16l(Xc + (w4 * 16 + fr) * 72 + 32 + fg * 8);
#pragma unroll
            for (int nt = 0; nt < 4; ++nt) {
                f32x4 ga = (f32x4){0.f, 0.f, 0.f, 0.f}, gx = ga;
                ga = mfma16(A0, Ba[nt][0], ga); ga = mfma16(A1, Ba[nt][1], ga); gx = mfma16(A0, Bx[nt][0], gx); gx = mfma16(A1, Bx[nt][1], gx);
#pragma unroll
                for (int pr = 0; pr < 2; ++pr) { const int pos = w4 * 16 + fg * 4 + 2 * pr, ch = nt * 16 + fr;
                    const f32x2 ta = (f32x2){ga[2 * pr], ga[2 * pr + 1]} * (f32x2){-1.44269504f, -1.44269504f} + (f32x2){bav[nt], bav[nt]};
                    const f32x2 tx = (f32x2){gx[2 * pr], gx[2 * pr + 1]} * (f32x2){-1.44269504f, -1.44269504f} + (f32x2){bxv[nt], bxv[nt]};
                    const f32x2 e1 = (f32x2){fexp2(ta.x), fexp2(ta.y)} + (f32x2){1.0f, 1.0f}, e2 = (f32x2){fexp2(tx.x), fexp2(tx.y)} + (f32x2){1.0f, 1.0f};
                    const f32x2 rg = (f32x2){__builtin_amdgcn_rcpf(e1.x), __builtin_amdgcn_rcpf(e1.y)}, ig = (f32x2){__builtin_amdgcn_rcpf(e2.x), __builtin_amdgcn_rcpf(e2.y)};
                    const f32x2 la2 = rg * (f32x2){spv[nt], spv[nt]};
                    const f32x2 a = (f32x2){fexp2(la2.x), fexp2(la2.y)};
                    const f32x2 om1 = (f32x2){1.0f, 1.0f} - a * a;
                    const f32x2 xc = (f32x2){__uint_as_float(((unsigned)Xc[pos * 72 + ch]) << 16), __uint_as_float(((unsigned)Xc[(pos + 1) * 72 + ch]) << 16)};
                    const f32x2 u = (f32x2){__builtin_amdgcn_sqrtf(om1.x), __builtin_amdgcn_sqrtf(om1.y)} * (ig * xc);
                    AU[pos * 64 + ch] = (f32x2){a.x, u.x}; AU[(pos + 1) * 64 + ch] = (f32x2){a.y, u.y}; } } }
        __syncthreads();
        if (w4 == 0) {
            LAS f32x2* aup = AU + lane;
#define LRU_SCAN(POS) do { \
                _Pragma("unroll") for (int bb = 0; bb < 4; ++bb) { f32x2 cu[16]; float hs[16]; \
                    _Pragma("unroll") for (int k = 0; k < 16; ++k) cu[k] = aup[(POS(16 * bb + k)) * 64]; \
                    _Pragma("unroll") for (int k = 0; k < 16; ++k) { hstate = cu[k].x * hstate + cu[k].y; hs[k] = hstate; } \
                    _Pragma("unroll") for (int k = 0; k < 16; ++k) ((LAS float*)(aup + (POS(16 * bb + k)) * 64))[1] = hs[k]; } } while (0)
#define LRU_POS_F(k) (k)
#define LRU_POS_B(k) (63 - (k))
            if (half == 0) LRU_SCAN(LRU_POS_F); else LRU_SCAN(LRU_POS_B);
#undef LRU_SCAN
#undef LRU_POS_F
#undef LRU_POS_B
        }
        if (s + 1 < 36) LRU_RAW_STORE((s + 1) & 1);
        __syncthreads();
        if (emit) {
            float hv[16];
#pragma unroll
            for (int c = 0; c < 16; ++c) hv[c] = AU[opos * 64 + ocq * 16 + c].y;
            if (!second) {
                u32x4 o0, o1; o0.x = pk2(hv[0], hv[1]); o0.y = pk2(hv[2], hv[3]); o0.z = pk2(hv[4], hv[5]); o0.w = pk2(hv[6], hv[7]);
                o1.x = pk2(hv[8], hv[9]); o1.y = pk2(hv[10], hv[11]); o1.z = pk2(hv[12], hv[13]); o1.w = pk2(hv[14], hv[15]);
                *(u32x4*)tp = o0; *(u32x4*)(tp + 8) = o1;
            } else {
                const unsigned tw[8] = {t0.x, t0.y, t0.z, t0.w, t1.x, t1.y, t1.z, t1.w}, yw[8] = {y0.x, y0.y, y0.z, y0.w, y1.x, y1.y, y1.z, y1.w};
                float ov[16];
#pragma unroll
                for (int q = 0; q < 8; ++q) { ov[2 * q] = gelu_t(bf_lo(yw[q])) * (hv[2 * q] + bf_lo(tw[q])); ov[2 * q + 1] = gelu_t(bf_hi(yw[q])) * (hv[2 * q + 1] + bf_hi(tw[q])); }
                unsigned char* op = (unsigned char*)CAT + om * D + hh * 64 + ocq * 16;
                *(u32x4*)op = (u32x4){pk4f8(ov[0], ov[1], ov[2], ov[3], CSC), pk4f8(ov[4], ov[5], ov[6], ov[7], CSC), pk4f8(ov[8], ov[9], ov[10], ov[11], CSC), pk4f8(ov[12], ov[13], ov[14], ov[15], CSC)};
            }
        }
    }
#undef LRU_RAW_LOAD
#undef LRU_RAW_STORE
    __syncthreads();
}

__device__ __forceinline__ void retp1_unit(LAS unsigned char* lds, const bf16* P, bf16* SB, int b, int hh, float lgf2, float lgb2, bool want_ctx, int tid) {
    const int wave = __builtin_amdgcn_readfirstlane(tid >> 6), lane = tid & 63, fr = lane & 15, fg = lane >> 4;
    const int half = wave >> 2, w4 = wave & 3, tidh = tid & 255;
    const int jp = tidh >> 2, part = tidh & 3;
    const float lg2 = half ? lgb2 : lgf2; const float dec = fexp2(128.0f * lg2);
    const float wk0 = half ? fexp2((float)(2 * jp) * lg2) : fexp2((float)(127 - 2 * jp) * lg2), wk1 = half ? fexp2((float)(2 * jp + 1) * lg2) : fexp2((float)(126 - 2 * jp) * lg2);
    u32x4 ka[2], kb[2], va[2], vb[2];
#define RP1_CK(S) ((half == 0) ? (S) : ((S) < 2 ? 1 - (S) : 19 - (S)))
#define RP1_M0(CK) (((CK) < 2) ? (size_t)b * CTXL + (CK) * 128 : (size_t)MC + (size_t)b * SEQ + ((CK) - 2) * 128)
#define RP1_LOAD(S) do { const int ck_ = RP1_CK(S); const size_t m_ = RP1_M0(ck_) + 2 * jp; \
        const bf16* kp = P + m_ * INW + 1152 + hh * 64 + part * 16; const bf16* vp = P + m_ * INW + 1536 + hh * 64 + part * 16; \
        ka[0] = *(const u32x4*)kp; ka[1] = *(const u32x4*)(kp + 8); kb[0] = *(const u32x4*)(kp + INW); kb[1] = *(const u32x4*)(kp + INW + 8); \
        va[0] = *(const u32x4*)vp; va[1] = *(const u32x4*)(vp + 8); vb[0] = *(const u32x4*)(vp + INW); vb[1] = *(const u32x4*)(vp + INW + 8); } while (0)
#define RP1_PARK(BUF) do { LAS bf16* KT_ = (LAS bf16*)(lds + ((BUF) * 2 + half) * 34816); LAS bf16* VT_ = KT_ + 64 * 136; \
        _Pragma("unroll") for (int q = 0; q < 2; ++q) { const unsigned k0w[4] = {ka[q].x, ka[q].y, ka[q].z, ka[q].w}, k1w[4] = {kb[q].x, kb[q].y, kb[q].z, kb[q].w}, v0w[4] = {va[q].x, va[q].y, va[q].z, va[q].w}, v1w[4] = {vb[q].x, vb[q].y, vb[q].z, vb[q].w}; \
            _Pragma("unroll") for (int t = 0; t < 4; ++t) { const int d = part * 16 + 8 * q + 2 * t; \
                *(LAS unsigned*)(KT_ + d * 136 + 2 * jp) = pk2(bf_lo(k0w[t]) * wk0, bf_lo(k1w[t]) * wk1); *(LAS unsigned*)(KT_ + (d + 1) * 136 + 2 * jp) = pk2(bf_hi(k0w[t]) * wk0, bf_hi(k1w[t]) * wk1); \
                *(LAS unsigned*)(VT_ + d * 136 + 2 * jp) = (v0w[t] & 0xffffu) | (v1w[t] << 16); *(LAS unsigned*)(VT_ + (d + 1) * 136 + 2 * jp) = (v0w[t] >> 16) | (v1w[t] & 0xffff0000u); } } } while (0)
    f32x4 st[4];
#pragma unroll
    for (int nt = 0; nt < 4; ++nt) st[nt] = (f32x4){0.f, 0.f, 0.f, 0.f};
    RP1_LOAD(0); RP1_PARK(0);
    __syncthreads();
    for (int s = 0; s < 18; ++s) {
        if (s + 1 < 18) RP1_LOAD(s + 1);
        const int ck = RP1_CK(s);
        if (want_ctx || ck >= 2) { bf16* sp = SB + ((((size_t)b * 6 + hh) * 2 + half) * 18 + ck) * 4096;
#pragma unroll
            for (int nt = 0; nt < 4; ++nt) { u32x2 w; w.x = pk2(st[nt][0], st[nt][1]); w.y = pk2(st[nt][2], st[nt][3]); *(u32x2*)(sp + (nt * 16 + fr) * 64 + w4 * 16 + fg * 4) = w; } }
        const LAS bf16* KT = (const LAS bf16*)(lds + ((s & 1) * 2 + half) * 34816); const LAS bf16* VT = KT + 64 * 136;
#pragma unroll
        for (int nt = 0; nt < 4; ++nt) st[nt] = st[nt] * dec;
#pragma unroll
        for (int ks = 0; ks < 4; ++ks) { const bf16x8 af = ld16l(KT + (w4 * 16 + fr) * 136 + ks * 32 + fg * 8);
#pragma unroll
            for (int nt = 0; nt < 4; ++nt) { const bf16x8 bfr = ld16l(VT + (nt * 16 + fr) * 136 + ks * 32 + fg * 8); st[nt] = mfma16(af, bfr, st[nt]); } }
        if (s + 1 < 18) RP1_PARK((s + 1) & 1);
        __syncthreads();
    }
#undef RP1_CK
#undef RP1_M0
#undef RP1_LOAD
#undef RP1_PARK
}

__device__ __forceinline__ void gmlp_unit(LAS unsigned char* lds, const bf16* P, bf16* CAT, const bf16* WS, const float* WSUM, const float* lng, const float* lnb, const float* bs, int b, int ck, int tid) {
    const int wave = __builtin_amdgcn_readfirstlane(tid >> 6), lane = tid & 63, fr = lane & 15, fg = lane >> 4;
    const size_t m0 = (ck < 2) ? (size_t)b * CTXL + ck * 128 : (size_t)MC + (size_t)b * SEQ + (ck - 2) * 128;
    LAS bf16* VnT = (LAS bf16*)lds;
    LAS float* LN = (LAS float*)(lds + 69632);
    const int g2 = wave >> 1, ih = wave & 1; const bf16* wsg = WS + (size_t)g2 * 16384;
    bf16x8 wf[4][4]; float wsv[4], bsv[4];
#pragma unroll
    for (int it = 0; it < 4; ++it) { const int irow = ih * 64 + it * 16 + fr;
#pragma unroll
        for (int ks = 0; ks < 4; ++ks) wf[it][ks] = ld16g(wsg + irow * 128 + ks * 32 + fg * 8);
        wsv[it] = WSUM[g2 * 128 + irow]; bsv[it] = bs[g2 * 128 + irow]; }
    LN[tid] = (tid < 256) ? lng[tid] : lnb[tid - 256];
    { const int j = tid >> 2, g = tid & 3; const bf16* zp = P + (m0 + j) * INW + 2560 + g * 64; float v[64];
#pragma unroll
        for (int q = 0; q < 8; ++q) { const u32x4 w = *(const u32x4*)(zp + 8 * q); const unsigned ww[4] = {w.x, w.y, w.z, w.w};
#pragma unroll
            for (int t = 0; t < 4; ++t) { v[8 * q + 2 * t] = gelu_t(bf_lo(ww[t])); v[8 * q + 2 * t + 1] = gelu_t(bf_hi(ww[t])); } }
        float s = 0.f;
#pragma unroll
        for (int c = 0; c < 64; ++c) s += v[c];
        const float mu = s * (1.0f / 64.0f); float q2 = 0.f;
#pragma unroll
        for (int c = 0; c < 64; ++c) { v[c] -= mu; q2 += v[c] * v[c]; }
        const float rs = 1.0f / sqrtf(q2 * (1.0f / 64.0f) + EPS);
#pragma unroll
        for (int c = 0; c < 64; c += 2) { const unsigned w = pk2(v[c] * rs, v[c + 1] * rs);
            VnT[(g * 64 + c) * 136 + j] = (bf16)(w & 0xffffu); VnT[(g * 64 + c + 1) * 136 + j] = (bf16)(w >> 16); } }
    __syncthreads();
#pragma unroll
    for (int it = 0; it < 4; ++it) { const int irow = ih * 64 + it * 16 + fr; const size_t m = m0 + irow;
        u32x2 zu[4];
#pragma unroll
        for (int ct = 0; ct < 4; ++ct) zu[ct] = *(const u32x2*)(P + m * INW + 2304 + g2 * 64 + ct * 16 + fg * 4);
        f32x4 acc[4];
#pragma unroll
        for (int ct = 0; ct < 4; ++ct) { acc[ct] = (f32x4){0.f, 0.f, 0.f, 0.f};
#pragma unroll
            for (int ks = 0; ks < 4; ++ks) { const bf16x8 vf = ld16l(VnT + (g2 * 64 + ct * 16 + fr) * 136 + ks * 32 + fg * 8); acc[ct] = mfma16(vf, wf[it][ks], acc[ct]); } }
#pragma unroll
        for (int ct = 0; ct < 4; ++ct) { const int c = g2 * 64 + ct * 16 + fg * 4;
            const f32x4 gv = *(const LAS f32x4*)(LN + c), bv = *(const LAS f32x4*)(LN + 256 + c);
            const f32x4 sv = acc[ct] * gv + bv * wsv[it] + bsv[it];
            *(unsigned*)((unsigned char*)CAT + m * D + 768 + c) = pk4f8(gelu_t(bf_lo(zu[ct].x)) * sv[0], gelu_t(bf_hi(zu[ct].x)) * sv[1], gelu_t(bf_lo(zu[ct].y)) * sv[2], gelu_t(bf_hi(zu[ct].y)) * sv[3], CSC); } }
    __syncthreads();
}

__device__ __forceinline__ void retp2_phase(LAS unsigned char* lds, const bf16* P, const bf16* SB, bf16* CAT, const float* theta, bool want_ctx, int G, int bid, int tid) {
    const int wave = __builtin_amdgcn_readfirstlane(tid >> 6), lane = tid & 63, fr = lane & 15, fg = lane >> 4;
    const int nck = want_ctx ? 18 : 16, ck0 = want_ctx ? 0 : 2, NU = NB * nck * 6;
    const int lj = tid >> 2, lpart = tid & 3;
    u32x4 k0, k1, v0, v1, s0, s1;
#define RP2_DECODE(ID, B_, CK_, HH_) const int HH_ = (ID) % 6, CK_ = ck0 + ((ID) / 6) % nck, B_ = (ID) / (6 * nck)
#define RP2_M0(B_, CK_) (((CK_) < 2) ? (size_t)(B_) * CTXL + (CK_) * 128 : (size_t)MC + (size_t)(B_) * SEQ + ((CK_) - 2) * 128)
#define RP2_LOAD(ID) do { RP2_DECODE(ID, b_, ck_, hh_); const size_t m0_ = RP2_M0(b_, ck_); \
        const bf16* kp = P + (m0_ + lj) * INW + 1152 + hh_ * 64 + lpart * 16; const bf16* vp = P + (m0_ + lj) * INW + 1536 + hh_ * 64 + lpart * 16; \
        k0 = *(const u32x4*)kp; k1 = *(const u32x4*)(kp + 8); v0 = *(const u32x4*)vp; v1 = *(const u32x4*)(vp + 8); \
        const bf16* sp_ = SB + ((((size_t)b_ * 6 + hh_) * 2 + 0) * 18 + ck_) * 4096 + tid * 8; s0 = *(const u32x4*)sp_; s1 = *(const u32x4*)(sp_ + (size_t)18 * 4096); } while (0)
#define RP2_PARK(BUF) do { LAS bf16* Ks_ = (LAS bf16*)(lds + (BUF) * 35840); LAS bf16* VT_ = (LAS bf16*)(lds + (BUF) * 35840 + 18432); \
        *(LAS u32x4*)(Ks_ + lj * 72 + lpart * 16) = k0; *(LAS u32x4*)(Ks_ + lj * 72 + lpart * 16 + 8) = k1; \
        const unsigned vw_[8] = {v0.x, v0.y, v0.z, v0.w, v1.x, v1.y, v1.z, v1.w}; \
        _Pragma("unroll") for (int q = 0; q < 8; ++q) { const int e = lpart * 16 + 2 * q; VT_[e * 136 + lj] = (bf16)(vw_[q] & 0xffffu); VT_[(e + 1) * 136 + lj] = (bf16)(vw_[q] >> 16); } \
        LAS bf16* SF_ = (LAS bf16*)(lds + 73728 + (BUF) * 18432); *(LAS u32x4*)(SF_ + (tid >> 3) * 72 + (tid & 7) * 8) = s0; *(LAS u32x4*)(SF_ + 4608 + (tid >> 3) * 72 + (tid & 7) * 8) = s1; } while (0)
    LAS float* LG = (LAS float*)(lds + 2 * 35840);
    if (tid < 12) { const float t = theta[tid]; LG[tid] = -1.44269504f * ((t < -15.f) ? -t : log1pf(expf(-t))); }
    const int irow = wave * 16 + fr;
    bf16x8 qn0 = {}, qn1 = {};
#define RP2_LOADQ(ID) do { RP2_DECODE(ID, b_, ck_, hh_); const bf16* qp_ = P + (RP2_M0(b_, ck_) + irow) * INW + 768 + hh_ * 64 + fg * 8; qn0 = ld16g(qp_); qn1 = ld16g(qp_ + 32); } while (0)
    int id = bid, buf = 0;
    if (id < NU) { RP2_LOAD(id); RP2_LOADQ(id); RP2_PARK(0); }
    __syncthreads();
    for (; id < NU; id += G, buf ^= 1) {
        const int nid = id + G;
        const bf16x8 qf0 = qn0, qf1 = qn1;
        if (nid < NU) { RP2_LOAD(nid); RP2_LOADQ(nid); }
        RP2_DECODE(id, b, ck, hh);
        const size_t m0 = RP2_M0(b, ck);
        const float lgf2 = LG[hh], lgb2 = LG[6 + hh];
        const LAS bf16* Ks = (const LAS bf16*)(lds + buf * 35840); const LAS bf16* VT = (const LAS bf16*)(lds + buf * 35840 + 18432);
        const size_t mi = m0 + irow;
        const LAS bf16* SFl = (const LAS bf16*)(lds + 73728 + buf * 18432); const LAS bf16* SBl = SFl + 4608;
        u32x2 gw[4];
        f32x4 sc[8];
#pragma unroll
        for (int jt = 0; jt < 8; ++jt) { sc[jt] = (f32x4){0.f, 0.f, 0.f, 0.f};
            const bf16x8 kf0 = ld16l(Ks + (jt * 16 + fr) * 72 + fg * 8), kf1 = ld16l(Ks + (jt * 16 + fr) * 72 + 32 + fg * 8);
            sc[jt] = mfma16(kf0, qf0, sc[jt]); sc[jt] = mfma16(kf1, qf1, sc[jt]); }
#pragma unroll
        for (int jt = 0; jt < 8; ++jt)
#pragma unroll
            for (int r = 0; r < 4; ++r) { const int dd = irow - (jt * 16 + fg * 4 + r);
                const float w = dd > 0 ? fexp2((float)dd * lgf2) : (dd < 0 ? fexp2((float)(-dd) * lgb2) : 2.0f); sc[jt][r] *= w; }
#pragma unroll
        for (int et = 0; et < 4; ++et) gw[et] = *(const u32x2*)(P + mi * INW + 1920 + hh * 64 + et * 16 + fg * 4);
        bf16x8 pf[4];
#pragma unroll
        for (int s4 = 0; s4 < 4; ++s4) { u32x4 w; w.x = pk2(sc[2 * s4][0], sc[2 * s4][1]); w.y = pk2(sc[2 * s4][2], sc[2 * s4][3]); w.z = pk2(sc[2 * s4 + 1][0], sc[2 * s4 + 1][1]); w.w = pk2(sc[2 * s4 + 1][2], sc[2 * s4 + 1][3]); pf[s4] = __builtin_bit_cast(bf16x8, w); }
        f32x4 ao[4], af[4], ab[4];
#pragma unroll
        for (int et = 0; et < 4; ++et) { ao[et] = (f32x4){0.f, 0.f, 0.f, 0.f}; af[et] = ao[et]; ab[et] = ao[et];
#pragma unroll
            for (int s4 = 0; s4 < 4; ++s4) { const LAS bf16* vp = VT + (et * 16 + fr) * 136 + s4 * 32 + fg * 4; const u32x2 lo = *(const LAS u32x2*)vp, hi = *(const LAS u32x2*)(vp + 16);
                const bf16x8 vf = __builtin_bit_cast(bf16x8, ((u32x4){lo.x, lo.y, hi.x, hi.y})); ao[et] = mfma16(vf, pf[s4], ao[et]); }
            af[et] = mfma16(ld16l(SFl + (et * 16 + fr) * 72 + fg * 8), qf0, af[et]); af[et] = mfma16(ld16l(SFl + (et * 16 + fr) * 72 + 32 + fg * 8), qf1, af[et]);
            ab[et] = mfma16(ld16l(SBl + (et * 16 + fr) * 72 + fg * 8), qf0, ab[et]); ab[et] = mfma16(ld16l(SBl + (et * 16 + fr) * 72 + 32 + fg * 8), qf1, ab[et]); }
        const float sfw = fexp2((float)(irow + 1) * lgf2), sbw = fexp2((float)(128 - irow) * lgb2);
        float ss = 0.f; f32x4 o[4];
#pragma unroll
        for (int et = 0; et < 4; ++et) { o[et] = ao[et] + af[et] * sfw + ab[et] * sbw; ss += (o[et][0] * o[et][0] + o[et][1] * o[et][1]) + (o[et][2] * o[et][2] + o[et][3] * o[et][3]); }
        ss += __shfl_xor(ss, 16); ss += __shfl_xor(ss, 32);
        const float rs = 1.0f / sqrtf(ss * (1.0f / 64.0f) + EPS);
#pragma unroll
        for (int et = 0; et < 4; ++et) { const int c = hh * 64 + et * 16 + fg * 4;
            *(unsigned*)((unsigned char*)CAT + mi * D + 384 + c) = pk4f8(silu_f(bf_lo(gw[et].x)) * o[et][0] * rs, silu_f(bf_hi(gw[et].x)) * o[et][1] * rs, silu_f(bf_lo(gw[et].y)) * o[et][2] * rs, silu_f(bf_hi(gw[et].y)) * o[et][3] * rs, CSC); }
        if (nid < NU) RP2_PARK(buf ^ 1);
        __syncthreads();
    }
#undef RP2_DECODE
#undef RP2_M0
#undef RP2_LOAD
#undef RP2_PARK
#undef RP2_LOADQ
}

__global__ void __launch_bounds__(NTHR, 2) fwd_kernel(Params p) {
    extern __shared__ __attribute__((aligned(16))) unsigned char lds_raw[];
    LAS unsigned char* lds = (LAS unsigned char*)lds_raw;
    volatile LAS unsigned* MISC = (volatile LAS unsigned*)(lds + MISC_OFF);
    const int tid = threadIdx.x;
    const int G = gridDim.x, bid = blockIdx.x;
    if (tid < 128) MISC[tid] = 0u;
    __syncthreads();
    (void)xcd_barrier_post((unsigned*)(p.ws + WS_CTL) + CW_BAR + (size_t)p.bar_region * XCD_BAR_WORDS, MISC);

    { const int w_ = __builtin_amdgcn_readfirstlane(tid >> 6); if ((tid & 63) == 0) MISC[64 + (__builtin_amdgcn_s_getreg((5 << 11) | 4) & 63)] = (unsigned)w_; }
    __syncthreads();
#define PHASE_BEGIN \
    const int wave0 = __builtin_amdgcn_readfirstlane((int)MISC[64 + (__builtin_amdgcn_s_getreg((5 << 11) | 4) & 63)]); \
    int lane_v; asm volatile("v_mbcnt_lo_u32_b32 %0, -1, 0\n\tv_mbcnt_hi_u32_b32 %0, -1, %0" : "=v"(lane_v)); const int lane = lane_v; const int wave = wave0; const int tid = wave0 * 64 + lane; \
    size_t zoff = 0; asm volatile("" : "+s"(zoff)); unsigned char* ws = p.ws + zoff; float* out = p.out + zoff; \
    unsigned* ctl = (unsigned*)(ws + WS_CTL); (void)ctl; (void)lane; (void)wave; (void)out; \
    const float* x_in = p.in[0]; const float* c_in = p.in[1]; const float* ctx_in = p.in[2]; const float* cctx_in = p.in[3]; const float* w_mod = p.in[4]; const float* b_mod = p.in[5]; \
    (void)x_in; (void)c_in; (void)ctx_in; (void)cctx_in; (void)w_mod; (void)b_mod; \
    float* MOD = (float*)(ws + WS_MOD); float* ROPE = (float*)(ws + WS_ROPE); (void)MOD; (void)ROPE; \
    bf16* WAT = (bf16*)(ws + WS_SMALLW); bf16* WXT = WAT + (size_t)DEPTH * 2 * 6 * 4096; bf16* WSB = WXT + (size_t)DEPTH * 2 * 6 * 4096; float* WSUM = (float*)(WSB + (size_t)DEPTH * 4 * 16384); (void)WAT; (void)WXT; (void)WSB; (void)WSUM; \
    uint4* TOKINFO = (uint4*)(ws + WS_TOKINFO); int2* TOKSLOT = (int2*)(ws + WS_TOKSLOT); int* SLOTTOK = (int*)(ws + WS_SLOTTOK); (void)TOKINFO; (void)TOKSLOT; (void)SLOTTOK; \
    bf16* XCTX = (bf16*)(ws + WS_XCTX); bf16* XLAT = (bf16*)(ws + WS_XL); (void)XCTX; (void)XLAT; \
    float* SAB = (float*)(ws + WS_ROPE + 512 * 1024); float* SASLOT = (float*)(ws + WS_TOKINFO + 1280 * 1024); float* SWIN = (float*)(ws + WS_TOKSLOT + 640 * 1024); float* SW13 = SWIN + 4096; (void)SAB; (void)SASLOT; (void)SWIN; (void)SW13; \
    bf16* WIN_T = (bf16*)(ws + WS_W + W_WIN); bf16* WOUT_T = (bf16*)(ws + WS_W + W_WOUT); bf16* WFFN = (bf16*)(ws + WS_W + W_FFN); (void)WIN_T; (void)WOUT_T; (void)WFFN; \
    bf16* ABUF = (bf16*)(ws + WS_A); bf16* RBUF = (bf16*)(ws + WS_R); bf16* BBUF = (bf16*)(ws + WS_B); bf16* YBUF = (bf16*)(ws + WS_Y); (void)ABUF; (void)RBUF; (void)BBUF; (void)YBUF; \
    bf16* SBUF = (bf16*)(ws + WS_Y + Y_SBUF); bf16* TLRU = (bf16*)(ws + WS_Y + Y_TLRU); (void)SBUF; (void)TLRU; \
    bf16* YSLOT = (bf16*)(ws + MOE_YSLOT); bf16* HIDS = (bf16*)(ws + MOE_HID); (void)YSLOT; (void)HIDS; \
    const float* modl = MOD + (size_t)l * 33 * 6144; (void)modl;

#define CONV_NI8(LA, HAS_IN) (((HAS_IN) ? 88 : 0) + ((((LA) & 1) != 0) ? NE : 1) * 176)
#define CONV_NTQ(LA) ((512 + ((((LA) & 1) != 0) ? NE : 1) * 1408) / 4)
#define CONVERT_I8(IT, LA, HAS_IN) do { \
            LAS float* scr = (LAS float*)(lds + wave * 16384); LAS float* mxs_ = (LAS float*)(lds + 8 * 16384); \
            const bool moe_ = (((LA) & 1) != 0); const int jf_ = (LA) >> 1; \
            int r = (IT); const int nin = (HAS_IN) ? 88 : 0; \
            if (r < nin) { conv_i8_item_wg(p.in[10] + (size_t)((LA) + 1) * D * INW, INW, (signed char*)WIN_T, SWIN, 32 * r, 32 * r, scr, mxs_, wave, lane); } \
            else { r -= nin; const int e = r / 176, rr = r % 176, is3 = rr >= 88 ? 1 : 0, n0 = 32 * (rr % 88); \
                const float* wsrc = is3 ? (moe_ ? p.in[29] + ((size_t)jf_ * NE + e) * D * DFF : p.in[25] + (size_t)jf_ * D * DFF) : (moe_ ? p.in[28] + ((size_t)jf_ * NE + e) * D * DFF : p.in[24] + (size_t)jf_ * D * DFF); \
                unsigned char* w13t = (unsigned char*)WFFN + (moe_ ? (size_t)e * W13_BYTES : 0); \
                conv_i8_item_wg(wsrc, DFF, (signed char*)w13t, SW13 + (size_t)(moe_ ? e : 0) * 2 * DFF, n0, 256 * (n0 >> 7) + 128 * is3 + (n0 & 127), scr, mxs_, wave, lane); } \
        } while (0)
#define CONVERT_TQ(GQ, LA) do { \
            LAS float* scr = (LAS float*)(lds + wave * 16384); \
            const bool moe_ = (((LA) & 1) != 0); const int jf_ = (LA) >> 1; \
            int r = 4 * (GQ); \
            if (r < 512) { transpose_quad<true>(p.in[11] + (size_t)(LA) * D * D, D, WOUT_T, D, 64 * (r / 32), 32 * (r % 32), 32 * (r % 32), WSCO, scr, lane); } \
            else { r -= 512; const int e = r / 1408, rr = r % 1408; \
                const float* w2 = moe_ ? p.in[30] + ((size_t)jf_ * NE + e) * DFF * D : p.in[26] + (size_t)jf_ * DFF * D; \
                unsigned char* w2t = (unsigned char*)WFFN + (moe_ ? (size_t)NE * W13_BYTES + (size_t)e * W2_BYTES : W13_BYTES); \
                transpose_quad<true>(w2, D, w2t, DFF, 64 * (rr / 32), 32 * (rr % 32), 32 * (rr % 32), WSC2, scr, lane); } \
        } while (0)
#if MK_PER_PHASE
#define IN(k) (p.ph_lo <= (k) && (k) < p.ph_hi)
#define PH_HI p.ph_hi
#define L_LO p.l_lo
#define L_HI p.l_hi
#else
#define IN(k) (true)
#define PH_HI NPH
#define L_LO 0
#define L_HI DEPTH
#endif
#define BARRIER_NOW() do { XcdBarrier b_; b_.bar = (unsigned*)(p.ws + WS_CTL) + CW_BAR + (size_t)p.bar_region * XCD_BAR_WORDS; b_.x = xb_xcc_id(); b_.st = MISC; xcd_barrier(b_, fresh_t0(wave0)); } while (0)
#define SEAM(l, k) do { if (((k) + 1 < PH_HI) || ((l) + 1 < L_HI)) { XcdBarrier b_; b_.bar = (unsigned*)(p.ws + WS_CTL) + CW_BAR + (size_t)p.bar_region * XCD_BAR_WORDS; b_.x = xb_xcc_id(); b_.st = MISC; xcd_barrier(b_, fresh_t0(wave0)); } } while (0)

    for (int l = L_LO; l < L_HI; ++l) {
        const bool want_ctx = l < DEPTH - 1;
        const bool moe = (l & 1) != 0; const int jf = l >> 1;
        if (IN(0) && l == 0) {
            PHASE_BEGIN
            const int gw = bid * NWAVES + wave, NGW = G * NWAVES;
            for (int rep = 0; rep < NREP_P0; ++rep) {
            if (l == 0) {
                {
                LAS bf16* Sb = (LAS bf16*)lds; LAS float* red = (LAS float*)(lds + 99328);
#pragma unroll
                for (int q = 0; q < 17; ++q) { const int o = tid + q * NTHR; if (o >= 33 * 256) break; const int r = o >> 8, k = (o & 255) * 4;
                    const f32x4 v = (r < 32) ? *(const f32x4*)(c_in + r * D + k) : *(const f32x4*)(cctx_in + k);
                    *(LAS u32x2*)(Sb + r * 1032 + k) = (u32x2){pk2(silu_f(v[0]), silu_f(v[1])), pk2(silu_f(v[2]), silu_f(v[3]))}; }
                for (int o = tid; o < 15 * 256; o += NTHR) { const int r = 33 + (o >> 8), k = (o & 255) * 4; *(LAS u32x2*)(Sb + r * 1032 + k) = (u32x2){0u, 0u}; }
                __syncthreads();
                const int ct = wave & 1, kq = wave >> 1, fr0 = lane & 15, fg0 = lane >> 4;
                for (int it = bid; it < DEPTH * 192; it += G) {
                    const int ll = it / 192, cb = it % 192;
                    const float* wp = w_mod + (size_t)ll * D * 6144 + cb * 32 + ct * 16 + fr0 + (size_t)(kq * 256 + fg0 * 8) * 6144;
                    float wv[64];
#pragma unroll
                    for (int ks = 0; ks < 8; ++ks)
#pragma unroll
                        for (int j = 0; j < 8; ++j) wv[ks * 8 + j] = wp[(size_t)(ks * 32 + j) * 6144];
                    f32x4 acc3[3] = {(f32x4){0.f, 0.f, 0.f, 0.f}, (f32x4){0.f, 0.f, 0.f, 0.f}, (f32x4){0.f, 0.f, 0.f, 0.f}};
#pragma unroll
                    for (int ks = 0; ks < 8; ++ks) {
                        const bf16x8 bfrag = __builtin_bit_cast(bf16x8, ((u32x4){pk2(wv[ks * 8 + 0], wv[ks * 8 + 1]), pk2(wv[ks * 8 + 2], wv[ks * 8 + 3]), pk2(wv[ks * 8 + 4], wv[ks * 8 + 5]), pk2(wv[ks * 8 + 6], wv[ks * 8 + 7])}));
#pragma unroll
                        for (int mt = 0; mt < 3; ++mt) acc3[mt] = mfma16(ld16l(Sb + (mt * 16 + fr0) * 1032 + kq * 256 + ks * 32 + fg0 * 8), bfrag, acc3[mt]); }
#pragma unroll
                    for (int mt = 0; mt < 3; ++mt)
#pragma unroll
                        for (int j = 0; j < 4; ++j) red[(wave * 12 + mt * 4 + j) * 64 + lane] = acc3[mt][j];
                    __syncthreads();
                    if (wave < 2) {
                        const int cc = cb * 32 + wave * 16 + fr0; const float bm = b_mod[(size_t)ll * 6144 + cc];
#pragma unroll
                        for (int mt = 0; mt < 3; ++mt)
#pragma unroll
                            for (int j = 0; j < 4; ++j) { const int r = mt * 16 + fg0 * 4 + j; float sm = 0.f;
#pragma unroll
                                for (int q = 0; q < 4; ++q) sm += red[((q * 2 + wave) * 12 + mt * 4 + j) * 64 + lane];
                                if (r < 33) MOD[((size_t)ll * 33 + r) * 6144 + cc] = sm + bm; } }
                    __syncthreads();
                }
                }
                for (int idx = bid * NTHR + tid; idx < SEQ * 32; idx += G * NTHR) { const int pos = idx >> 5, i = idx & 31;
                    const float fq = expf(-(float)(i & 15) * (4.605170186f / 16.0f)); const float ang = (float)((i < 16) ? (pos >> 6) : (pos & 63)) * fq;
                    ROPE[(size_t)idx * 2] = __cosf(ang); ROPE[(size_t)idx * 2 + 1] = __sinf(ang); }
                for (int idx = bid * NTHR + tid; idx < DEPTH * 2 * 6 * 4096; idx += G * NTHR) { const int blk = idx >> 12, j = (idx >> 6) & 63, i = idx & 63;
                    const float a = p.in[14][(size_t)blk * 4096 + i * 64 + j], xx = p.in[16][(size_t)blk * 4096 + i * 64 + j];
                    WAT[idx] = (bf16)(pk2(a, 0.f) & 0xffffu); WXT[idx] = (bf16)(pk2(xx, 0.f) & 0xffffu); }
                for (int idx = bid * NTHR + tid; idx < DEPTH * 4 * 16384; idx += G * NTHR) WSB[idx] = (bf16)(pk2(p.in[22][idx], 0.f) & 0xffffu);
                for (int idx = gw; idx < DEPTH * 4 * 128; idx += NGW) {
                    const float sm = wave_sum(bf_lo(pk2(p.in[22][(size_t)idx * 128 + lane], 0.f)) + bf_lo(pk2(p.in[22][(size_t)idx * 128 + 64 + lane], 0.f)));
                    if (lane == 0) WSUM[idx] = sm; }
            }
            { LAS float* scr0 = (LAS float*)(lds + wave * 16384);
              for (int it = bid; it < 88; it += G) conv_i8_item_wg(p.in[10], INW, (signed char*)WIN_T, SWIN, 32 * it, 32 * it, scr0, (LAS float*)(lds + 8 * 16384), wave, lane); }
            __syncthreads();
            }
            SEAM(l, 0);
        }
        if (IN(1) && l == 0) {
            PHASE_BEGIN
            for (int rep = 0; rep < NREP_N0; ++rep) row_phase<0, false, true, true, false>(SAB, ctx_in, x_in, nullptr, nullptr, nullptr, nullptr, nullptr, nullptr, nullptr, p.in[6], modl, 0, 0, 1024,
                                      ABUF, nullptr, nullptr, nullptr, nullptr, 0, MT, G, bid, wave, lane, tid);
            SEAM(l, 1);
        }
        if (IN(2)) {
            PHASE_BEGIN
            pg8::Gemm g{ABUF, WIN_T, MT, INW, D, 0, nullptr}; pg8::StaticOrder S; S.init(MT, INW, G, bid);
            pg8::EpiInProj E{RBUF, INW, ROPE, SAB, SWIN};
            for (int rep = 0; rep < NREP_IN; ++rep) { int lane3; asm volatile("v_mbcnt_lo_u32_b32 %0, -1, 0\n\tv_mbcnt_hi_u32_b32 %0, -1, %0" : "=v"(lane3)); const int tid = wave0 * 64 + lane3; pg8::gemm_phase<pg8::EpiInProj, pg8::StaticOrder, true, false, 2>(lds, g, S, E, tid); if (rep + 1 < NREP_IN) BARRIER_NOW(); }
            SEAM(l, 2);
        }
        if (IN(3)) {
            PHASE_BEGIN
#define FRESH_TID(T) int T; { int l_; asm volatile("v_mbcnt_lo_u32_b32 %0, -1, 0\n\tv_mbcnt_hi_u32_b32 %0, -1, %0" : "=v"(l_)); T = wave0 * 64 + l_; }
            for (int rep = 0; rep < NREP_LRU; ++rep)
            for (;;) {
                FRESH_TID(tq);
                if (tq == 0) MISC[8] = __hip_atomic_fetch_add(ctl + CW_QUEUE + (rep * 16 + l * 4 + 0) * 64, 1u, __ATOMIC_RELAXED, __HIP_MEMORY_SCOPE_AGENT);
                __syncthreads(); const int id = (int)MISC[8]; __syncthreads();
                if (id >= NB * 6) break;
                lru_unit(lds, RBUF, BBUF, TLRU, WAT + (size_t)l * 2 * 6 * 4096, WXT + (size_t)l * 2 * 6 * 4096, p.in[15] + (size_t)l * 768, p.in[17] + (size_t)l * 768, p.in[18] + (size_t)l * 768,
                         p.in[12] + (size_t)l * 4 * 384, p.in[13] + (size_t)l * 384, id / 6, id % 6, want_ctx, tq);
            }
            { for (;;) {
                FRESH_TID(tq);
                if (tq == 0) MISC[8] = __hip_atomic_fetch_add(ctl + CW_QUEUE + (l * 4 + 3) * 64, 1u, __ATOMIC_RELAXED, __HIP_MEMORY_SCOPE_AGENT);
                __syncthreads(); const int id = (int)MISC[8]; __syncthreads();
                const int has_in = (l + 1 < DEPTH) ? 1 : 0; const int ni8 = CONV_NI8(l, has_in), ci8 = (ni8 + 7) >> 3, ntq = CONV_NTQ(l), nchunks = ci8 + ((ntq + 7) >> 3);
                if (id >= nchunks) break;
                if (id < ci8) { for (int k8 = 0; k8 < 8; ++k8) { const int it = id * 8 + k8; if (it < ni8) CONVERT_I8(it, l, has_in); } }
                else { const int gq = (id - ci8) * 8 + wave; if (gq < ntq) CONVERT_TQ(gq, l); }
              } }
            for (int rep = 0; rep < NREP_RP1; ++rep)
            for (;;) {
                FRESH_TID(tq);
                if (tq == 0) MISC[8] = __hip_atomic_fetch_add(ctl + CW_QUEUE + (rep * 16 + l * 4 + 1) * 64, 1u, __ATOMIC_RELAXED, __HIP_MEMORY_SCOPE_AGENT);
                __syncthreads(); const int id = (int)MISC[8]; __syncthreads();
                if (id >= NB * 6) break;
                const int hh = id % 6; const float tf = p.in[19][l * 12 + hh], tb = p.in[19][l * 12 + 6 + hh];
                const float lgf2 = -1.44269504f * ((tf < -15.f) ? -tf : log1pf(expf(-tf))), lgb2 = -1.44269504f * ((tb < -15.f) ? -tb : log1pf(expf(-tb)));
                retp1_unit(lds, RBUF, SBUF, id / 6, hh, lgf2, lgb2, want_ctx, tq);
            }
            for (int rep = 0; rep < NREP_GM; ++rep)
            for (;;) {
                FRESH_TID(tq);
                if (tq == 0) MISC[8] = __hip_atomic_fetch_add(ctl + CW_QUEUE + (rep * 16 + l * 4 + 2) * 64, 1u, __ATOMIC_RELAXED, __HIP_MEMORY_SCOPE_AGENT);
                __syncthreads(); const int id = (int)MISC[8]; __syncthreads();
                if (id >= NB * 18) break;
                const int ck = id % 18;
                if (!want_ctx && ck < 2) continue;
                gmlp_unit(lds, RBUF, BBUF, WSB + (size_t)l * 4 * 16384, WSUM + (size_t)l * 512, p.in[20] + (size_t)l * 256, p.in[21] + (size_t)l * 256, p.in[23] + (size_t)l * 512, id / 18, ck, tq);
            }
#undef FRESH_TID
            SEAM(l, 3);
        }
        if (IN(4)) {
            PHASE_BEGIN
            for (int rep = 0; rep < NREP_MB; ++rep) retp2_phase(lds, RBUF, SBUF, BBUF, p.in[19] + l * 12, want_ctx, G, bid, tid);
            SEAM(l, 4);
        }
        const int m_lo = want_ctx ? 0 : MC; const int m_n = MT - m_lo;
        if (IN(5)) {
            PHASE_BEGIN
            pg8::Gemm g{(const unsigned char*)BBUF + (size_t)m_lo * D, WOUT_T, m_n, D, D, 0, nullptr}; pg8::StaticOrder S; S.init(m_n, D, G, bid);
            pg8::EpiBf16 E{YBUF + (size_t)m_lo * D, D, 1.0f / (CSC * WSCO)};
            for (int rep = 0; rep < NREP_OUT; ++rep) { int lane3; asm volatile("v_mbcnt_lo_u32_b32 %0, -1, 0\n\tv_mbcnt_hi_u32_b32 %0, -1, %0" : "=v"(lane3)); const int tid = wave0 * 64 + lane3; pg8::gemm_phase<pg8::EpiBf16, pg8::StaticOrder, true, false, 1>(lds, g, S, E, tid); if (rep + 1 < NREP_OUT) BARRIER_NOW(); }
            SEAM(l, 5);
        }
        if (IN(6)) {
            PHASE_BEGIN
            if (l == 0) {
                row_phase<1, false, true, true, false>(SAB, ctx_in, x_in, XCTX, XLAT, YBUF, nullptr, nullptr, nullptr, p.in[7] + (size_t)l * D, p.in[8] + (size_t)l * D, modl, 2048, 3072, 4096,
                                                       ABUF, nullptr, nullptr, nullptr, nullptr, m_lo, MT, G, bid, wave, lane, tid);
            } else if (moe) {
                row_phase<1, true, true, false, false>(SAB, XCTX, XLAT, XCTX, XLAT, YBUF, nullptr, nullptr, nullptr, p.in[7] + (size_t)l * D, p.in[8] + (size_t)l * D, modl, 2048, 3072, 4096,
                                                       ABUF, p.in[27] + (size_t)jf * D * NE, TOKINFO, (LAS unsigned*)(lds + MISC_OFF) + 16, ctl + CW_GCNT + jf * 64, m_lo, MT, G, bid, wave, lane, tid, lds);
            } else {
                row_phase<1, false, true, false, false>(SAB, XCTX, XLAT, XCTX, XLAT, YBUF, nullptr, nullptr, nullptr, p.in[7] + (size_t)l * D, p.in[8] + (size_t)l * D, modl, 2048, 3072, 4096,
                                                        ABUF, nullptr, nullptr, nullptr, nullptr, m_lo, MT, G, bid, wave, lane, tid);
            }
            SEAM(l, 6);
        }
        if (IN(7)) {
            PHASE_BEGIN
            if (!moe) {
                pg8::Gemm g{(const unsigned char*)ABUF + (size_t)m_lo * D, WFFN, m_n, 2 * DFF, D, 0, nullptr}; pg8::StaticOrder S; S.init(m_n, 2 * DFF, G, bid);
                pg8::EpiSwiGLU E{(unsigned char*)RBUF + (size_t)m_lo * DFF, DFF, SAB + m_lo, SW13, HSC};
                for (int rep = 0; rep < NREP_DG1; ++rep) { int lane3; asm volatile("v_mbcnt_lo_u32_b32 %0, -1, 0\n\tv_mbcnt_hi_u32_b32 %0, -1, %0" : "=v"(lane3)); const int tid = wave0 * 64 + lane3; pg8::gemm_phase<pg8::EpiSwiGLU, pg8::StaticOrder, true, false, 2>(lds, g, S, E, tid); if (rep + 1 < NREP_DG1) BARRIER_NOW(); }
            } else {
                LAS unsigned* T = (LAS unsigned*)(lds + MISC_OFF) + 32;
                if (tid == 0) { unsigned s = 0; for (int e = 0; e < 8; ++e) { T[e] = s; const unsigned c = __hip_atomic_load(ctl + CW_GCNT + jf * 64 + e, __ATOMIC_RELAXED, __HIP_MEMORY_SCOPE_AGENT); s += (c + 255u) & ~255u; } T[8] = s; }
                if (tid < 8) T[16 + tid] = 0u;
                __syncthreads();
                const int per = m_n / G; const int mb = m_lo + bid * per;
                unsigned e1 = 0, e2 = 0, p1 = 0, p2 = 0;
                if (tid < per) { const uint4 ti = TOKINFO[mb + tid]; e1 = ti.x; e2 = ti.y;
                    p1 = __hip_atomic_fetch_add(T + 16 + e1, 1u, __ATOMIC_RELAXED, __HIP_MEMORY_SCOPE_WORKGROUP); p2 = __hip_atomic_fetch_add(T + 16 + e2, 1u, __ATOMIC_RELAXED, __HIP_MEMORY_SCOPE_WORKGROUP); }
                __syncthreads();
                if (tid < 8) T[24 + tid] = __hip_atomic_fetch_add(ctl + CW_GPOS + jf * 64 + tid, T[16 + tid], __ATOMIC_RELAXED, __HIP_MEMORY_SCOPE_AGENT);
                __syncthreads();
                if (tid < per) { const int s1 = (int)(T[e1] + T[24 + e1] + p1), s2 = (int)(T[e2] + T[24 + e2] + p2);
                    SLOTTOK[s1] = mb + tid; SLOTTOK[s2] = mb + tid; TOKSLOT[mb + tid] = make_int2(s1, s2); const float sv = SAB[mb + tid]; SASLOT[s1] = sv; SASLOT[s2] = sv; }
                for (int idx = bid * NTHR + tid; idx < 8 * 256; idx += G * NTHR) { const int e = idx >> 8, k = idx & 255;
                    const unsigned c = __hip_atomic_load(ctl + CW_GCNT + jf * 64 + e, __ATOMIC_RELAXED, __HIP_MEMORY_SCOPE_AGENT); const unsigned s = T[e] + c + k;
                    if (s < T[e + 1]) { SLOTTOK[s] = m_lo; SASLOT[s] = 0.f; } }
                __syncthreads();
            }
            SEAM(l, 7);
        }
        if (IN(8)) {
            PHASE_BEGIN
            if (!moe) {
                pg8::Gemm g{(const unsigned char*)RBUF + (size_t)m_lo * DFF, (const unsigned char*)WFFN + W13_BYTES, m_n, D, DFF, 0, nullptr}; pg8::StaticOrder S; S.init(m_n, D, G, bid);
                pg8::EpiBf16 E{YBUF + (size_t)m_lo * D, D, 1.0f / (WSC2 * HSC)};
                for (int rep = 0; rep < NREP_DG2; ++rep) { int lane3; asm volatile("v_mbcnt_lo_u32_b32 %0, -1, 0\n\tv_mbcnt_hi_u32_b32 %0, -1, %0" : "=v"(lane3)); const int tid = wave0 * 64 + lane3; pg8::gemm_phase<pg8::EpiBf16, pg8::StaticOrder, true, false, 1>(lds, g, S, E, tid); if (rep + 1 < NREP_DG2) BARRIER_NOW(); }
            } else {
                LAS int* SEGT = (LAS int*)(lds + MISC_OFF) + 48;
                if (tid == 0) { unsigned s = 0; for (int e = 0; e < 8; ++e) { SEGT[e] = (int)(s >> 8); const unsigned c = __hip_atomic_load(ctl + CW_GCNT + jf * 64 + e, __ATOMIC_RELAXED, __HIP_MEMORY_SCOPE_AGENT); s += (c + 255u) & ~255u; } SEGT[8] = (int)(s >> 8); }
                __syncthreads();
                const int NT = __builtin_amdgcn_readfirstlane(SEGT[8]);
                const int slab = (NT <= p.slab_cap) ? NT : ((NT + 1) / 2 < SLAB_TILES ? (NT + 1) / 2 : SLAB_TILES);
                for (int t0 = 0; t0 < NT; t0 += slab) {
                    const int nT = (NT - t0) < slab ? (NT - t0) : slab;
                    { int lane2; asm volatile("v_mbcnt_lo_u32_b32 %0, -1, 0\n\tv_mbcnt_hi_u32_b32 %0, -1, %0" : "=v"(lane2)); const int tid = wave0 * 64 + lane2;
                      pg8::MoeOrder S; S.nM = nT; S.nN = 2 * DFF / 256; S.nwg = nT * S.nN; S.G = G; S.c = bid; S.t0 = t0;
                        S.segt = SEGT;
                        pg8::Gemm g{ABUF, WFFN, nT * 256, 2 * DFF, D, W13_BYTES, SLOTTOK};
                        pg8::EpiSwiGLU E{(unsigned char*)HIDS - (size_t)t0 * 256 * DFF, DFF, SASLOT, SW13, HSC};
                        for (int rep = 0; rep < NREP_MG1; ++rep) { int lane3; asm volatile("v_mbcnt_lo_u32_b32 %0, -1, 0\n\tv_mbcnt_hi_u32_b32 %0, -1, %0" : "=v"(lane3)); const int tid = wave0 * 64 + lane3; pg8::gemm_phase<pg8::EpiSwiGLU, pg8::MoeOrder, true, true, 2>(lds, g, S, E, tid); if (rep + 1 < NREP_MG1) BARRIER_NOW(); } }
                    BARRIER_NOW();
                    { int lane2; asm volatile("v_mbcnt_lo_u32_b32 %0, -1, 0\n\tv_mbcnt_hi_u32_b32 %0, -1, %0" : "=v"(lane2)); const int tid = wave0 * 64 + lane2;
                      pg8::MoeOrder S; S.nM = nT; S.nN = D / 256; S.nwg = nT * S.nN; S.G = G; S.c = bid; S.t0 = t0;
                        S.segt = SEGT;
                        pg8::Gemm g{(const unsigned char*)HIDS - (size_t)t0 * 256 * DFF, (const unsigned char*)WFFN + (size_t)NE * W13_BYTES, nT * 256, D, DFF, W2_BYTES, nullptr};
                        pg8::EpiBf16 E{YSLOT, D, 1.0f / (WSC2 * HSC)};
                        for (int rep = 0; rep < NREP_MG2; ++rep) { int lane3; asm volatile("v_mbcnt_lo_u32_b32 %0, -1, 0\n\tv_mbcnt_hi_u32_b32 %0, -1, %0" : "=v"(lane3)); const int tid = wave0 * 64 + lane3; pg8::gemm_phase<pg8::EpiBf16, pg8::MoeOrder, true, false, 1>(lds, g, S, E, tid); if (rep + 1 < NREP_MG2) BARRIER_NOW(); } }
                    if (t0 + slab < NT) BARRIER_NOW();
                }
            }
            SEAM(l, 8);
        }
        if (IN(9)) {
            PHASE_BEGIN
            const float* gpre_n = p.in[6] + (size_t)(l + 1 < DEPTH ? l + 1 : l) * D; const float* modn = MOD + (size_t)(l + 1 < DEPTH ? l + 1 : l) * 33 * 6144;
            const int o_sh = (int)(modn - modl) + 0, o_sc = (int)(modn - modl) + 1024;
            if (l + 1 < DEPTH) {
                if (moe) row_phase<2, false, true, false, false>(SAB, XCTX, XLAT, XCTX, XLAT, nullptr, YSLOT, TOKINFO, TOKSLOT, p.in[9] + (size_t)l * D, gpre_n, modl, 5120, o_sh, o_sc,
                                                                 ABUF, nullptr, nullptr, nullptr, nullptr, m_lo, MT, G, bid, wave, lane, tid);
                else row_phase<1, false, true, false, false>(SAB, XCTX, XLAT, XCTX, XLAT, YBUF, nullptr, nullptr, nullptr, p.in[9] + (size_t)l * D, gpre_n, modl, 5120, o_sh, o_sc,
                                                             ABUF, nullptr, nullptr, nullptr, nullptr, m_lo, MT, G, bid, wave, lane, tid);
            } else {
                row_phase<2, false, false, false, true>(SAB, XCTX, XLAT, XCTX, out, nullptr, YSLOT, TOKINFO, TOKSLOT, p.in[9] + (size_t)l * D, gpre_n, modl, 5120, o_sh, o_sc,
                                                        ABUF, nullptr, nullptr, nullptr, nullptr, m_lo, MT, G, bid, wave, lane, tid);
            }
            SEAM(l, 9);
        }
    }
#undef IN
#undef SEAM
}

extern "C" void kernel_launch(void* const* d_in, const int* in_sizes, int n_in, void* d_out, int out_size, void* d_ws, size_t ws_size, hipStream_t stream) {
    static int grid = 0;
    if (grid == 0) {
        if (n_in != 31 || out_size != ML * D || ws_size < WS_END) { fprintf(stderr, "kernel_launch: unexpected problem (n_in %d, out %d, ws %zu, need %zu)\n", n_in, out_size, ws_size, (size_t)WS_END); grid = -1; return; }
        int dev = 0, cus = 0, per_cu = 0;
        if (hipGetDevice(&dev) != hipSuccess || hipDeviceGetAttribute(&cus, hipDeviceAttributeMultiprocessorCount, dev) != hipSuccess) { grid = -1; return; }
        if (hipFuncSetAttribute((const void*)fwd_kernel, hipFuncAttributeMaxDynamicSharedMemorySize, LDS_BYTES) != hipSuccess) { fprintf(stderr, "kernel_launch: hipFuncSetAttribute failed\n"); grid = -1; return; }
        if (hipOccupancyMaxActiveBlocksPerMultiprocessor(&per_cu, (const void*)fwd_kernel, NTHR, LDS_BYTES) != hipSuccess || per_cu < 1) fprintf(stderr, "kernel_launch: occupancy query says %d\n", per_cu);
        (void)hipGetLastError();
        grid = cus;
        if (grid != 256) { fprintf(stderr, "kernel_launch: %d CUs (built for 256)\n", grid); grid = -1; return; }
    }
    if (grid < 0) return;
    (void)hipMemsetAsync((char*)d_ws + WS_CTL, 0, CTL_BYTES, stream);
    Params a{};
    for (int i = 0; i < 31; ++i) a.in[i] = (const float*)d_in[i];
    a.out = (float*)d_out; a.ws = (unsigned char*)d_ws;
    { const size_t cap = (ws_size - MOE_HID) / ((size_t)256 * DFF); a.slab_cap = cap >= 584 ? 584 : SLAB_TILES; }
#if MK_PER_PHASE
    int region = 0;
    for (int l = 0; l < DEPTH; ++l)
        for (int ph = 0; ph < NPH; ++ph) {
            if (ph == 1 && l != 0) continue;
            a.l_lo = l; a.l_hi = l + 1; a.ph_lo = ph; a.ph_hi = ph + 1; a.bar_region = region++;
            hipLaunchKernelGGL(fwd_kernel, dim3(grid), dim3(NTHR), LDS_BYTES, stream, a);
        }
#else
    a.l_lo = 0; a.l_hi = DEPTH; a.ph_lo = 0; a.ph_hi = NPH; a.bar_region = 0;
    hipLaunchKernelGGL(fwd_kernel, dim3(grid), dim3(NTHR), LDS_BYTES, stream, a);
#endif
    const hipError_t le = hipPeekAtLastError();
    if (le != hipSuccess) fprintf(stderr, "kernel_launch: launch failed: %s\n", hipGetErrorName(le));
}
```

```cpp
#include <hip/hip_runtime.h>
#include <cstdio>
#include <cstdint>

#ifndef NREP_G
#define NREP_G 1
#endif
#ifndef NREP_IN
#define NREP_IN NREP_G
#endif
#ifndef NREP_OUT
#define NREP_OUT NREP_G
#endif
#ifndef NREP_DG1
#define NREP_DG1 NREP_G
#endif
#ifndef NREP_DG2
#define NREP_DG2 NREP_G
#endif
#ifndef NREP_MG1
#define NREP_MG1 NREP_G
#endif
#ifndef NREP_MG2
#define NREP_MG2 NREP_G
#endif
#ifndef NREP_MB
#define NREP_MB 1
#endif
#ifndef NREP_MA
#define NREP_MA 1
#endif
#ifndef NREP_LRU
#define NREP_LRU NREP_MA
#endif
#ifndef NREP_RP1
#define NREP_RP1 NREP_MA
#endif
#ifndef NREP_GM
#define NREP_GM NREP_MA
#endif
#ifndef NREP_P0
#define NREP_P0 1
#endif
#ifndef NREP_N0
#define NREP_N0 1
#endif
#ifndef MK_PER_PHASE
#define MK_PER_PHASE 0
#endif

namespace pg8 {
#define PG8_LAS __attribute__((address_space(3)))
typedef unsigned short bf16_t;
typedef short bf16x8 __attribute__((ext_vector_type(8)));
typedef float f32x4 __attribute__((ext_vector_type(4)));
typedef float f32x2 __attribute__((ext_vector_type(2)));
typedef unsigned u32x4 __attribute__((ext_vector_type(4)));
typedef unsigned u32x2 __attribute__((ext_vector_type(2)));
constexpr int BM = 256, BK = 64, HALF = 128, HTB = HALF * BK * 2, STAGE_BYTES = 8 * HTB, NXCD = 8, WGM = 4;

__host__ __device__ __forceinline__ int lds_byte(int r, int c) { const int st = (r >> 4) * 2 + (c >> 5), rr = r & 15, cc = c & 31, ob = rr * 64 + cc * 2; return st * 1024 + (ob ^ (((ob >> 9) & 1) << 5)); }
__host__ __device__ __forceinline__ void stage_rc(int b, int& R, int& C) { const int st = b / 1024, sb = b % 1024, swz = sb ^ (((sb >> 9) & 1) << 5); R = (st >> 1) * 16 + swz / 64; C = (st & 1) * 32 + (swz % 64) / 2; }
__host__ __device__ __forceinline__ int perm32(int rho) { const int n = rho >> 4, i = rho & 15; return 8 * (i >> 2) + 4 * n + (i & 3); }

struct Unit { int pm, pn, e; };
struct Gemm { const void* A; const void* Bt; int M, N, Kb; size_t bstride; const int* rowidx; };

struct StaticOrder {
    int nM, nN, nwg, G, c;
    __host__ __device__ void init(int M, int N, int G_, int c_) { nM = M / BM; nN = N / BM; nwg = nM * nN; G = G_; c = c_; }
    __host__ __device__ bool next(int i, Unit& u) const {
        const long L = (long)i * G + c; if (L >= nwg) return false;
        int wgid = (int)L; { const int q = nwg / NXCD, r = nwg % NXCD, xcd = wgid % NXCD, off = wgid / NXCD; wgid = (xcd < r ? xcd * (q + 1) : r * (q + 1) + (xcd - r) * q) + off; }
        const int nig = WGM * nN, gid = wgid / nig, fm = gid * WGM, gsz = (nM - fm) < WGM ? (nM - fm) : WGM;
        u.pm = fm + ((wgid % nig) % gsz); u.pn = (wgid % nig) / gsz; u.e = 0; return true;
    }
    __device__ __forceinline__ void a_ready(const Unit&) const {}
    __device__ __forceinline__ void done(const Unit&) const {}
};
struct MoeOrder {
    int nM, nN, nwg, G, c, t0; const PG8_LAS int* segt;
    __device__ __forceinline__ bool next(int i, Unit& u) const {
        const long L = (long)i * G + c; if (L >= nwg) return false;
        int wgid = (int)L; { const int q = nwg / NXCD, r = nwg % NXCD, xcd = wgid % NXCD, off = wgid / NXCD; wgid = (xcd < r ? xcd * (q + 1) : r * (q + 1) + (xcd - r) * q) + off; }
        const int nig = WGM * nN, gid = wgid / nig, fm = gid * WGM, gsz = (nM - fm) < WGM ? (nM - fm) : WGM;
        u.pm = t0 + fm + ((wgid % nig) % gsz); u.pn = (wgid % nig) / gsz;
        int e = 0;
#pragma unroll
        for (int k = 1; k < 8; ++k) e += (u.pm >= segt[k]) ? 1 : 0;
        u.e = __builtin_amdgcn_readfirstlane(e); return true;
    }
    __device__ __forceinline__ void a_ready(const Unit&) const {}
    __device__ __forceinline__ void done(const Unit&) const {}
};

__device__ __forceinline__ unsigned cvt_pk_bf16(float lo, float hi) { unsigned r; asm volatile("v_cvt_pk_bf16_f32 %0, %1, %2" : "=v"(r) : "v"(lo), "v"(hi)); return r; }

struct EpiBf16 {
    static constexpr bool PERM = true, AFTER_DRAIN = false; static constexpr int NST = 16;
    bf16_t* O; int ldc; float scale;
    static constexpr bool SCALES = false;
    __device__ __forceinline__ void operator()(const f32x4 (&acc)[2][2][4][2], const Unit& u, int wr, int wc, int fr, int fq, const PG8_LAS unsigned char*) const {
        const int row0 = u.pm * BM + wr * 64 + fr; const int col0 = u.pn * BM + wc * 32 + 8 * fq;
#pragma unroll
        for (int ai = 0; ai < 2; ++ai)
#pragma unroll
            for (int m = 0; m < 4; ++m) { bf16_t* rowp = O + (size_t)(row0 + ai * HALF + m * 16) * ldc + col0;
#pragma unroll
                for (int bj = 0; bj < 2; ++bj) { const f32x4 v0 = acc[ai][bj][m][0] * scale, v1 = acc[ai][bj][m][1] * scale;
                    u32x4 w; w.x = cvt_pk_bf16(v0[0], v0[1]); w.y = cvt_pk_bf16(v0[2], v0[3]); w.z = cvt_pk_bf16(v1[0], v1[1]); w.w = cvt_pk_bf16(v1[2], v1[3]);
                    *(u32x4*)(rowp + bj * HALF) = w; } }
    }
};
struct EpiInProj {
    static constexpr bool PERM = true, AFTER_DRAIN = false; static constexpr int NST = 16;
    bf16_t* O; int ldc; const float* cs; const float* sa; const float* sw;
    static constexpr bool SCALES = true;
    __device__ __forceinline__ void prefetch(PG8_LAS unsigned char* sl, const Unit& u, int wr, int wc, int lane) const {
        const float* sap = sa + u.pm * BM + wr * 64 + lane;
        __builtin_amdgcn_global_load_lds((const unsigned*)sap, (PG8_LAS unsigned*)sl, 4, 0, 0); __builtin_amdgcn_global_load_lds((const unsigned*)(sap + HALF), (PG8_LAS unsigned*)(sl + 256), 4, 0, 0);
        const float* swp = sw + u.pn * BM + wc * 32 + (lane & 31) + (lane >> 5) * HALF;
        __builtin_amdgcn_global_load_lds((const unsigned*)swp, (PG8_LAS unsigned*)(sl + 512), 4, 0, 0);
    }
    __device__ __forceinline__ void operator()(const f32x4 (&acc)[2][2][4][2], const Unit& u, int wr, int wc, int fr, int fq, const PG8_LAS unsigned char* sl) const {
        const int row0 = u.pm * BM + wr * 64 + fr; const int col0 = u.pn * BM + wc * 32 + 8 * fq;
        const bool qk = (u.pn >= 3 && u.pn <= 5); const bool rope = qk && (u.pm >= 32);
        f32x4 swv[2][2];
#pragma unroll
        for (int bj = 0; bj < 2; ++bj) { swv[bj][0] = *(const PG8_LAS f32x4*)(sl + 512 + (bj * 32 + 8 * fq) * 4); swv[bj][1] = *(const PG8_LAS f32x4*)(sl + 512 + (bj * 32 + 8 * fq + 4) * 4); }
#pragma unroll
        for (int ai = 0; ai < 2; ++ai)
#pragma unroll
            for (int m = 0; m < 4; ++m) { const int row = row0 + ai * HALF + m * 16; bf16_t* rowp = O + (size_t)row * ldc + col0;
                const int pos = (row - 8192) & 2047; const float sar = *(const PG8_LAS float*)(sl + ai * 256 + (m * 16 + fr) * 4);
#pragma unroll
                for (int bj = 0; bj < 2; ++bj) { f32x4 v0 = acc[ai][bj][m][0] * swv[bj][0] * sar, v1 = acc[ai][bj][m][1] * swv[bj][1] * sar;
                    if (qk) { const float sc = (u.pn == 3 || (u.pn == 4 && bj == 0)) ? 0.125f : 1.0f; v0 = v0 * sc; v1 = v1 * sc; }
                    if (rope) { const int pr = ((col0 + bj * HALF) & 63) >> 1;
                        const f32x4 c0 = *(const f32x4*)(cs + ((size_t)pos * 32 + pr) * 2), c1 = *(const f32x4*)(cs + ((size_t)pos * 32 + pr) * 2 + 4);
                        f32x4 r0, r1;
                        r0[0] = v0[0] * c0[0] - v0[1] * c0[1]; r0[1] = v0[0] * c0[1] + v0[1] * c0[0]; r0[2] = v0[2] * c0[2] - v0[3] * c0[3]; r0[3] = v0[2] * c0[3] + v0[3] * c0[2];
                        r1[0] = v1[0] * c1[0] - v1[1] * c1[1]; r1[1] = v1[0] * c1[1] + v1[1] * c1[0]; r1[2] = v1[2] * c1[2] - v1[3] * c1[3]; r1[3] = v1[2] * c1[3] + v1[3] * c1[2];
                        v0 = r0; v1 = r1; }
                    u32x4 w; w.x = cvt_pk_bf16(v0[0], v0[1]); w.y = cvt_pk_bf16(v0[2], v0[3]); w.z = cvt_pk_bf16(v1[0], v1[1]); w.w = cvt_pk_bf16(v1[2], v1[3]);
                    *(u32x4*)(rowp + bj * HALF) = w; } }
    }
};
struct EpiSwiGLU {
    static constexpr bool PERM = true, AFTER_DRAIN = false; static constexpr int NST = 8;
    unsigned char* O; int ldc; const float* sa; const float* sw; float outscale;
    static constexpr bool SCALES = true;
    __device__ __forceinline__ void prefetch(PG8_LAS unsigned char* sl, const Unit& u, int wr, int wc, int lane) const {
        const float* sap = sa + u.pm * BM + wr * 64 + lane;
        __builtin_amdgcn_global_load_lds((const unsigned*)sap, (PG8_LAS unsigned*)sl, 4, 0, 0); __builtin_amdgcn_global_load_lds((const unsigned*)(sap + HALF), (PG8_LAS unsigned*)(sl + 256), 4, 0, 0);
        const float* swp = sw + (size_t)u.e * (2 * 2816) + u.pn * BM + wc * 32 + (lane & 31) + (lane >> 5) * HALF;
        __builtin_amdgcn_global_load_lds((const unsigned*)swp, (PG8_LAS unsigned*)(sl + 512), 4, 0, 0);
    }
    __device__ __forceinline__ void operator()(const f32x4 (&acc)[2][2][4][2], const Unit& u, int wr, int wc, int fr, int fq, const PG8_LAS unsigned char* sl) const {
        const int row0 = u.pm * BM + wr * 64 + fr; const int col0 = u.pn * HALF + wc * 32 + 8 * fq;
        f32x4 sw1[2], sw3[2];
#pragma unroll
        for (int n = 0; n < 2; ++n) { sw1[n] = *(const PG8_LAS f32x4*)(sl + 512 + (8 * fq + 4 * n) * 4); sw3[n] = *(const PG8_LAS f32x4*)(sl + 512 + (32 + 8 * fq + 4 * n) * 4) * outscale; }
#pragma unroll
        for (int ai = 0; ai < 2; ++ai)
#pragma unroll
            for (int m = 0; m < 4; ++m) { unsigned char* rowp = O + (size_t)(row0 + ai * HALF + m * 16) * ldc + col0; const float sar = *(const PG8_LAS float*)(sl + ai * 256 + (m * 16 + fr) * 4);
                f32x4 h[2];
#pragma unroll
                for (int n = 0; n < 2; ++n) { const f32x4 a = acc[ai][0][m][n] * sw1[n] * sar, b = acc[ai][1][m][n] * sw3[n] * sar;
#pragma unroll
                    for (int j = 0; j < 4; ++j) { const float sg = a[j] * __builtin_amdgcn_rcpf(1.0f + __builtin_amdgcn_exp2f(-1.44269504f * a[j])); h[n][j] = __builtin_amdgcn_fmed3f(sg * b[j], -448.0f, 448.0f); } }
                u32x2 w; unsigned t = 0u;
                t = __builtin_amdgcn_cvt_pk_fp8_f32(h[0][0], h[0][1], t, false); t = __builtin_amdgcn_cvt_pk_fp8_f32(h[0][2], h[0][3], t, true); w.x = t;
                t = __builtin_amdgcn_cvt_pk_fp8_f32(h[1][0], h[1][1], t, false); t = __builtin_amdgcn_cvt_pk_fp8_f32(h[1][2], h[1][3], t, true); w.y = t;
                *(u32x2*)rowp = w; }
    }
};

typedef int v4i_t __attribute__((ext_vector_type(4)));
typedef int v8i_t __attribute__((ext_vector_type(8)));
template <class Epi, class Sched, bool ALIGN_EPI, bool GATHER, int DT>
__device__ __forceinline__ void gemm_phase(PG8_LAS unsigned char* lds, const Gemm g, const Sched& S, const Epi& E, const int tid) {
    const int wid = __builtin_amdgcn_readfirstlane(tid >> 6), lane = tid & 63, wr = wid >> 2, wc = wid & 3, fr = lane & 15, fq = lane >> 4;
    const int Kb = g.Kb, nt = Kb / 128;
    unsigned voffA[2], voffB[2];
#pragma unroll
    for (int i = 0; i < 2; ++i) { int R, C; stage_rc(tid * 16 + i * 8192, R, C); const int Rb = Epi::PERM ? ((R & ~31) + perm32(R & 31)) : R;
        voffA[i] = (unsigned)(R * Kb + C * 2); voffB[i] = (unsigned)(Rb * Kb + C * 2); }
    const size_t kstep = (size_t)(BK * 2);
    const size_t hstep = (size_t)HALF * Kb;
    const size_t tstep = 2 * hstep;
    const unsigned ldsw = (unsigned)wid * 1024u;
    const int aoff = lds_byte(wr * 64 + fr, fq * 8), boff = lds_byte(wc * 32 + fr, fq * 8);
#define PG8_SA(b, h) (((b) * 2 + (h)) * HTB)
#define PG8_SB(b, h) ((4 + (b) * 2 + (h)) * HTB)
#define PG8_STAGE(bufoff, gbase, voff) do { _Pragma("unroll") for (int _i = 0; _i < 2; ++_i) \
        __builtin_amdgcn_global_load_lds((const unsigned*)((const char*)(gbase) + (voff)[_i]), (PG8_LAS unsigned*)(lds + (bufoff) + ldsw + _i * 8192), 16, 0, 0); } while (0)
#define PG8_STAGE_A(bufoff, ptr, h, AO0, AO1) do { if constexpr (GATHER) { if ((h) == 0) PG8_STAGE(bufoff, ptr, AO0); else PG8_STAGE(bufoff, ptr, AO1); } else PG8_STAGE(bufoff, (ptr) + (h) * hstep, voffA); } while (0)
#define PG8_LD8(p) __builtin_shufflevector(*(const PG8_LAS v4i_t*)(p), *(const PG8_LAS v4i_t*)((p) + 1024), 0, 1, 2, 3, 4, 5, 6, 7)
#define PG8_LO(x) __builtin_bit_cast(bf16x8, __builtin_shufflevector(x, x, 0, 1, 2, 3))
#define PG8_HI(x) __builtin_bit_cast(bf16x8, __builtin_shufflevector(x, x, 4, 5, 6, 7))
#define PG8_LDA(dst, b, h) do { _Pragma("unroll") for (int m = 0; m < 4; ++m) dst[m] = PG8_LD8(lds + PG8_SA(b, h) + aoff + m * 2048); } while (0)
#define PG8_LDB(dst, b, h) do { _Pragma("unroll") for (int n = 0; n < 2; ++n) dst[n] = PG8_LD8(lds + PG8_SB(b, h) + boff + n * 2048); } while (0)
#define PG8_MMA(ai, bj, At, Bt) do { __builtin_amdgcn_s_setprio(1); \
        if constexpr (DT == 1) { _Pragma("unroll") for (int m = 0; m < 4; ++m) _Pragma("unroll") for (int n = 0; n < 2; ++n) \
            asm volatile("v_mfma_scale_f32_16x16x128_f8f6f4 %0, %1, %2, %0, %3, %3 op_sel_hi:[0,0,0]" : "+v"(acc[ai][bj][m][n]) : "v"(Bt[n]), "v"(At[m]), "v"(f8one)); } \
        else if constexpr (DT == 2) { \
            _Pragma("unroll") for (int m = 0; m < 4; ++m) _Pragma("unroll") for (int n = 0; n < 2; ++n) \
                asm volatile("v_mfma_i32_16x16x64_i8 %0, %1, %2, %0" : "+v"(acc[ai][bj][m][n]) : "v"(__builtin_shufflevector(Bt[n], Bt[n], 0, 1, 2, 3)), "v"(__builtin_shufflevector(At[m], At[m], 0, 1, 2, 3))); \
            _Pragma("unroll") for (int m = 0; m < 4; ++m) _Pragma("unroll") for (int n = 0; n < 2; ++n) \
                asm volatile("v_mfma_i32_16x16x64_i8 %0, %1, %2, %0" : "+v"(acc[ai][bj][m][n]) : "v"(__builtin_shufflevector(Bt[n], Bt[n], 4, 5, 6, 7)), "v"(__builtin_shufflevector(At[m], At[m], 4, 5, 6, 7))); } \
        else { _Pragma("unroll") for (int m = 0; m < 4; ++m) _Pragma("unroll") for (int n = 0; n < 2; ++n) { \
               acc[ai][bj][m][n] = __builtin_amdgcn_mfma_f32_16x16x32_bf16(PG8_LO(Bt[n]), PG8_LO(At[m]), acc[ai][bj][m][n], 0, 0, 0); \
               acc[ai][bj][m][n] = __builtin_amdgcn_mfma_f32_16x16x32_bf16(PG8_HI(Bt[n]), PG8_HI(At[m]), acc[ai][bj][m][n], 0, 0, 0); } } \
        __builtin_amdgcn_s_setprio(0); } while (0)
#define PG8_WAIT_V(n) asm volatile("s_waitcnt vmcnt(" #n ")" ::: "memory")
#define PG8_WAIT_VN(n) asm volatile("s_waitcnt vmcnt(%0)" :: "n"(n) : "memory")
#define PG8_WAIT_L(n) asm volatile("s_waitcnt lgkmcnt(" #n ")" ::: "memory")
#define PG8_BAR __builtin_amdgcn_s_barrier()
#define PG8_SCHED __builtin_amdgcn_sched_barrier(0)
    Unit cur, nxt; int ui = 0;
    if (!S.next(0, cur)) return;
    f32x4 acc[2][2][4][2];
#pragma unroll
    for (int a = 0; a < 2; ++a)
#pragma unroll
        for (int b = 0; b < 2; ++b)
#pragma unroll
            for (int m = 0; m < 4; ++m)
#pragma unroll
                for (int n = 0; n < 2; ++n) { acc[a][b][m][n] = (f32x4){0.f, 0.f, 0.f, 0.f}; asm volatile("" : "+v"(acc[a][b][m][n])); }
    v8i_t At[4], B0[2], B1[2];
    const int f8one = 0x7f7f7f7f;
    unsigned aoC0[2] = {0u, 0u}, aoC1[2] = {0u, 0u};
    PG8_LAS unsigned char* idx_lds = lds + STAGE_BYTES + wid * 1024;
    if constexpr (GATHER) {
#pragma unroll
        for (int i = 0; i < 2; ++i) { int R, C; stage_rc(tid * 16 + i * 8192, R, C); const int r0 = g.rowidx[cur.pm * BM + R], r1 = g.rowidx[cur.pm * BM + HALF + R];
            aoC0[i] = (unsigned)r0 * (unsigned)Kb + (unsigned)(C * 2); aoC1[i] = (unsigned)r1 * (unsigned)Kb + (unsigned)(C * 2); }
    }
    const char* cA = GATHER ? (const char*)g.A : (const char*)g.A + (size_t)cur.pm * tstep; const char* cB = (const char*)g.Bt + (size_t)cur.e * g.bstride + (size_t)cur.pn * tstep;
    S.a_ready(cur);
    PG8_STAGE(PG8_SB(0, 0), cB, voffB); PG8_STAGE(PG8_SB(0, 1), cB + hstep, voffB); PG8_STAGE_A(PG8_SA(0, 0), cA, 0, aoC0, aoC1); PG8_STAGE_A(PG8_SA(0, 1), cA, 1, aoC0, aoC1);
    if (wr == 1) PG8_BAR;
    PG8_WAIT_V(2); PG8_BAR;
    PG8_STAGE(PG8_SB(1, 0), cB + kstep, voffB); PG8_STAGE_A(PG8_SA(1, 0), cA + kstep, 0, aoC0, aoC1); PG8_STAGE(PG8_SB(1, 1), cB + hstep + kstep, voffB);
    PG8_WAIT_V(6); PG8_BAR;
    PG8_LAS unsigned char* scal_lds = lds + STAGE_BYTES + 8192 + wid * 1024;
    for (;;) {
        const bool has_next = S.next(ui + 1, nxt);
        if constexpr (Epi::SCALES) E.prefetch(scal_lds, cur, wr, wc, lane);
        const char* nA = GATHER ? (const char*)g.A : (has_next ? (const char*)g.A + (size_t)nxt.pm * tstep : cA);
        const char* nB = has_next ? (const char*)g.Bt + (size_t)nxt.e * g.bstride + (size_t)nxt.pn * tstep : cB;
        if constexpr (GATHER) { if (has_next) {
#pragma unroll
            for (int i = 0; i < 2; ++i) { int R, C; stage_rc(tid * 16 + i * 8192, R, C);
                __builtin_amdgcn_global_load_lds((const unsigned*)(g.rowidx + nxt.pm * BM + R), (PG8_LAS unsigned*)(idx_lds + (2 * i) * 256), 4, 0, 0);
                __builtin_amdgcn_global_load_lds((const unsigned*)(g.rowidx + nxt.pm * BM + HALF + R), (PG8_LAS unsigned*)(idx_lds + (2 * i + 1) * 256), 4, 0, 0); } } }
#define PG8_TRIP(t, W1, W2, W3, NOSP1) do { \
            const bool last = ((t) == nt - 2); \
            const char* a1 = cA + (size_t)((t) + 1) * kstep; \
            const char* a2 = last ? nA : cA + (size_t)((t) + 2) * kstep; const char* b2 = last ? nB : cB + (size_t)((t) + 2) * kstep; \
            const char* a3 = a2 + kstep; const char* b3 = b2 + kstep; \
            if (last && has_next) S.a_ready(nxt); \
            PG8_LDB(B0, 0, 0); PG8_LDB(B1, 0, 1); PG8_SCHED; PG8_LDA(At, 0, 0); if (!(NOSP1)) PG8_STAGE_A(PG8_SA(1, 1), a1, 1, aoC0, aoC1); \
            if constexpr (GATHER) { if (last && has_next) { \
                _Pragma("unroll") for (int i = 0; i < 2; ++i) { int R, C; stage_rc(tid * 16 + i * 8192, R, C); \
                    const unsigned i0 = *(const PG8_LAS unsigned*)(idx_lds + (2 * i) * 256 + lane * 4), i1 = *(const PG8_LAS unsigned*)(idx_lds + (2 * i + 1) * 256 + lane * 4); \
                    aoC0[i] = i0 * (unsigned)Kb + (unsigned)(C * 2); aoC1[i] = i1 * (unsigned)Kb + (unsigned)(C * 2); } } } \
            PG8_WAIT_VN(W1); PG8_WAIT_L(0); PG8_BAR; PG8_MMA(0, 0, At, B0); PG8_MMA(0, 1, At, B1); PG8_BAR; PG8_SCHED; \
            PG8_LDA(At, 0, 1); PG8_STAGE(PG8_SB(0, 0), b2, voffB); PG8_STAGE(PG8_SB(0, 1), b2 + hstep, voffB); PG8_STAGE_A(PG8_SA(0, 0), a2, 0, aoC0, aoC1); \
            PG8_WAIT_VN(W2); PG8_WAIT_L(0); PG8_BAR; PG8_MMA(1, 0, At, B0); PG8_MMA(1, 1, At, B1); PG8_BAR; PG8_SCHED; \
            PG8_LDB(B0, 1, 0); PG8_LDB(B1, 1, 1); PG8_SCHED; PG8_LDA(At, 1, 0); PG8_STAGE_A(PG8_SA(0, 1), a2, 1, aoC0, aoC1); \
            PG8_WAIT_VN(W3); PG8_WAIT_L(0); PG8_BAR; PG8_MMA(0, 0, At, B0); PG8_MMA(0, 1, At, B1); PG8_BAR; PG8_SCHED; \
            PG8_LDA(At, 1, 1); PG8_STAGE(PG8_SB(1, 0), b3, voffB); PG8_STAGE(PG8_SB(1, 1), b3 + hstep, voffB); PG8_STAGE_A(PG8_SA(1, 0), a3, 0, aoC0, aoC1); \
            PG8_WAIT_VN(8); PG8_WAIT_L(0); PG8_BAR; PG8_MMA(1, 0, At, B0); PG8_MMA(1, 1, At, B1); PG8_BAR; PG8_SCHED; \
            if (last && has_next) PG8_STAGE_A(PG8_SA(1, 1), a3, 1, aoC0, aoC1);        \
        } while (0)
        int tbeg = 0;
        if (ui > 0) { PG8_TRIP(0, 8 + Epi::NST, 8 + Epi::NST, 8 + Epi::NST, true); tbeg = 2; }
#pragma clang loop unroll(disable)
        for (int t = tbeg; t < nt; t += 2) { PG8_TRIP(t, 8, 8, 8, false); }
#undef PG8_TRIP
        if constexpr (ALIGN_EPI) { if (wr == 0) PG8_BAR; }
        if constexpr (DT != 0) asm volatile("s_nop 15\n\ts_nop 15" ::: "memory");
        if constexpr (DT == 2) {
#pragma unroll
            for (int a = 0; a < 2; ++a)
#pragma unroll
                for (int b = 0; b < 2; ++b)
#pragma unroll
                    for (int m = 0; m < 4; ++m)
#pragma unroll
                        for (int n = 0; n < 2; ++n) { const v4i_t ci = __builtin_bit_cast(v4i_t, acc[a][b][m][n]); acc[a][b][m][n] = (f32x4){(float)ci[0], (float)ci[1], (float)ci[2], (float)ci[3]}; } }
        if constexpr (!Epi::AFTER_DRAIN) { E(acc, cur, wr, wc, fr, fq, scal_lds); S.done(cur); }
        if (!has_next) break;
#pragma unroll
        for (int a = 0; a < 2; ++a)
#pragma unroll
            for (int b = 0; b < 2; ++b)
#pragma unroll
                for (int m = 0; m < 4; ++m)
#pragma unroll
                    for (int n = 0; n < 2; ++n) { acc[a][b][m][n] = (f32x4){0.f, 0.f, 0.f, 0.f}; asm volatile("" : "+v"(acc[a][b][m][n])); }
        cur = nxt; cA = nA; cB = nB; ++ui;
        if constexpr (DT != 0) asm volatile("s_nop 7" ::: "memory");
        if constexpr (ALIGN_EPI) { if (wr == 1) PG8_BAR; }
    }
    PG8_WAIT_V(0);
    if constexpr (!ALIGN_EPI) { if (wr == 0) PG8_BAR; }
    PG8_BAR;
#undef PG8_SA
#undef PG8_SB
#undef PG8_STAGE
#undef PG8_STAGE_A
#undef PG8_LDA
#undef PG8_LDB
#undef PG8_MMA
#undef PG8_LD8
#undef PG8_LO
#undef PG8_HI
#undef PG8_WAIT_V
#undef PG8_WAIT_VN
#undef PG8_WAIT_L
#undef PG8_BAR
#undef PG8_SCHED
}
}

using pg8::bf16x8; using pg8::f32x4; using pg8::f32x2; using pg8::u32x4; using pg8::u32x2;
typedef unsigned short bf16;
#define LAS __attribute__((address_space(3)))
constexpr int D = 1024, NB = 32, SEQ = 2048, CTXL = 256, DEPTH = 4;
constexpr int MC = NB * CTXL, ML = NB * SEQ, MT = MC + ML;
constexpr int INW = 2816, DFF = 2816, NE = 8;
constexpr int NWAVES = 8, NTHR = 512;
constexpr float EPS = 1e-6f;
constexpr int NPH = 10;
constexpr int SLAB_TILES = 292;
constexpr float CSC = 8.0f, WSCO = 64.0f;
constexpr float WSC2 = 64.0f, HSC = 4.0f;
constexpr int MAX_SLOTS = 2 * MT + 8 * 256;

constexpr size_t MiB = 1u << 20;
constexpr size_t WS_CTL = 0, CTL_BYTES = 2 * MiB;
constexpr size_t WS_MOD = 2 * MiB;
constexpr size_t WS_ROPE = 6 * MiB;
constexpr size_t WS_SMALLW = 7 * MiB;
constexpr size_t WS_TOKINFO = 9 * MiB;
constexpr size_t WS_TOKSLOT = 11 * MiB;
constexpr size_t WS_SLOTTOK = 12 * MiB;
constexpr size_t WS_XCTX = 13 * MiB;
constexpr size_t WS_W = 45 * MiB;
constexpr size_t W_WIN = 0, W_WOUT = 3 * MiB, W_FFN = 5 * MiB;
constexpr size_t W13_BYTES = (size_t)2 * DFF * D, W2_BYTES = (size_t)D * DFF;
constexpr size_t WS_A = 119 * MiB;
constexpr size_t WS_XL = 191 * MiB;
constexpr size_t WS_A_OLD_UNUSED = 0;
constexpr size_t WS_R = 319 * MiB;
constexpr size_t WS_B = 715 * MiB;
constexpr size_t WS_Y = 859 * MiB;
constexpr size_t WS_END = 1003 * MiB;
constexpr size_t Y_SBUF = 0, Y_TLRU = 56 * MiB;
constexpr size_t MOE_YSLOT = WS_R, MOE_HID = WS_R + 292 * MiB;
static_assert(W_FFN + 8 * (W13_BYTES + W2_BYTES) <= WS_A - WS_W, "weights region");
static_assert((size_t)MAX_SLOTS * D * 2 <= 292 * MiB && MOE_HID + (size_t)SLAB_TILES * 256 * DFF <= WS_END, "moe scratch");
static_assert((size_t)NB * 6 * 2 * 18 * 4096 * 2 <= 56 * MiB && Y_TLRU + (size_t)MT * 384 * 2 <= 144 * MiB, "mixer scratch in Y");

constexpr int CW_QUEUE = 64;
constexpr int CW_GCNT = 3072;
constexpr int CW_GPOS = 3328;
constexpr int CW_BAR = 4096;

constexpr int RING_BYTES = 131072;
constexpr int LDS_BYTES = 155648;
constexpr int MISC_OFF = LDS_BYTES - 512;

__device__ __forceinline__ float bf_lo(unsigned w) { return __uint_as_float(w << 16); }
__device__ __forceinline__ float bf_hi(unsigned w) { return __uint_as_float(w & 0xffff0000u); }
__device__ __forceinline__ unsigned pk2(float lo, float hi) { return pg8::cvt_pk_bf16(lo, hi); }
__device__ __forceinline__ float fexp2(float x) { return __builtin_amdgcn_exp2f(x); }
__device__ __forceinline__ float fexp(float x) { return __builtin_amdgcn_exp2f(1.44269504f * x); }
__device__ __forceinline__ float sigm(float x) { return __builtin_amdgcn_rcpf(1.0f + fexp(-x)); }
__device__ __forceinline__ float silu_f(float x) { return x * sigm(x); }
__device__ __forceinline__ float gelu_t(float x) { const float u = 0.7978845608f * (x + 0.044715f * x * x * x); return x * sigm(2.0f * u); }
__device__ __forceinline__ unsigned pk4f8(float a, float b, float c, float d, float sc) {
    unsigned t = 0u;
    t = __builtin_amdgcn_cvt_pk_fp8_f32(__builtin_amdgcn_fmed3f(a * sc, -448.0f, 448.0f), __builtin_amdgcn_fmed3f(b * sc, -448.0f, 448.0f), t, false);
    t = __builtin_amdgcn_cvt_pk_fp8_f32(__builtin_amdgcn_fmed3f(c * sc, -448.0f, 448.0f), __builtin_amdgcn_fmed3f(d * sc, -448.0f, 448.0f), t, true);
    return t;
}
template <int CTRL> __device__ __forceinline__ float dpp_mov(float v) { return __builtin_bit_cast(float, __builtin_amdgcn_update_dpp(0, __builtin_bit_cast(int, v), CTRL, 0xF, 0xF, false)); }
__device__ __forceinline__ float lane_rd(float v, int l) { return __builtin_bit_cast(float, __builtin_amdgcn_readlane(__builtin_bit_cast(int, v), l)); }
__device__ __forceinline__ float wave_sum(float v) {
    v += dpp_mov<0xB1>(v); v += dpp_mov<0x4E>(v); v += dpp_mov<0x141>(v); v += dpp_mov<0x140>(v);
    return (lane_rd(v, 0) + lane_rd(v, 16)) + (lane_rd(v, 32) + lane_rd(v, 48));
}
__device__ __forceinline__ float wave_max(float v) {
    v = fmaxf(v, dpp_mov<0xB1>(v)); v = fmaxf(v, dpp_mov<0x4E>(v)); v = fmaxf(v, dpp_mov<0x141>(v)); v = fmaxf(v, dpp_mov<0x140>(v));
    return fmaxf(fmaxf(lane_rd(v, 0), lane_rd(v, 16)), fmaxf(lane_rd(v, 32), lane_rd(v, 48)));
}
__device__ __forceinline__ f32x4 mfma16(bf16x8 a, bf16x8 b, f32x4 c) { return __builtin_amdgcn_mfma_f32_16x16x32_bf16(a, b, c, 0, 0, 0); }
__device__ __forceinline__ bf16x8 ld16g(const bf16* p) { return __builtin_bit_cast(bf16x8, *(const u32x4*)p); }
__device__ __forceinline__ bf16x8 ld16l(const LAS bf16* p) { return __builtin_bit_cast(bf16x8, *(const LAS u32x4*)p); }

#define XB_TMO      128
#define XB_XCNT(j)  (256  + 64 * (j))
#define XB_XSUB(j)  (1280 + 64 * (j))
#define XB_XGEN(j)  (2304 + 64 * (j))
#define XB_TOP      3328
#define XB_TOPGEN   3392
#define XCD_BAR_WORDS 3456
#define XB_SPIN_CAP (1u << 18)
__device__ __forceinline__ unsigned xb_ld(unsigned* p)              { return __hip_atomic_load(p, __ATOMIC_RELAXED, __HIP_MEMORY_SCOPE_AGENT); }
__device__ __forceinline__ unsigned xb_add(unsigned* p, unsigned v) { return __hip_atomic_fetch_add(p, v, __ATOMIC_RELAXED, __HIP_MEMORY_SCOPE_AGENT); }
__device__ __forceinline__ unsigned xb_xcc_id() { return (unsigned)__builtin_amdgcn_s_getreg((3 << 11) | 20) & 0xFu; }
#define XB_SPIN(cond, bar) do { unsigned _sp = 0; while (cond) { __builtin_amdgcn_s_sleep(1); \
    if ((++_sp & 255u) == 0u) { if (xb_ld(&(bar)[XB_TMO])) break; if (_sp > XB_SPIN_CAP) { atomicAdd(&(bar)[XB_TMO], 1u); break; } } } } while (0)
struct XcdBarrier { unsigned* bar; unsigned x; volatile LAS unsigned* st; };
__device__ __forceinline__ bool fresh_t0(int wave0) { int l; asm volatile("v_mbcnt_lo_u32_b32 %0, -1, 0\n\tv_mbcnt_hi_u32_b32 %0, -1, %0" : "=v"(l)); return wave0 == 0 && l == 0; }
__device__ __forceinline__ XcdBarrier xcd_barrier_post(unsigned* bar, volatile LAS unsigned* st) {
    XcdBarrier b; b.bar = bar; b.x = xb_xcc_id(); b.st = st;
    if (threadIdx.x == 0) (void)xb_add(&bar[XB_XCNT(b.x)], 1u);
    return b;
}
__device__ __forceinline__ void xcd_barrier_complete(unsigned* bar, unsigned x, unsigned& nloc, unsigned& nx) {
    const unsigned G = gridDim.x * gridDim.y * gridDim.z;
    unsigned sum, cnt, mine, sp = 0u;
    for (;;) {
        sum = 0u; cnt = 0u; mine = 0u;
#pragma unroll
        for (unsigned j = 0; j < 16; ++j) { const unsigned c = xb_ld(&bar[XB_XCNT(j)]); sum += c; cnt += (c > 0u) ? 1u : 0u; mine = (j == x) ? c : mine; }
        if (sum == G) break;
        __builtin_amdgcn_s_sleep(1);
        if ((++sp & 255u) == 0u) { if (xb_ld(&bar[XB_TMO])) break; if (sp > XB_SPIN_CAP) { atomicAdd(&bar[XB_TMO], 1u); break; } }
    }
    nloc = mine > 0u ? mine : 1u; nx = cnt > 0u ? cnt : 1u;
}
__device__ __forceinline__ void xcd_barrier(const XcdBarrier& b, const bool t0) {
    asm volatile("s_waitcnt vmcnt(0)" ::: "memory");
    __syncthreads();
    if (t0) {
        unsigned* bar = b.bar;
        __builtin_amdgcn_s_waitcnt(0);
        unsigned nloc = b.st[0], nx = b.st[1];
        if (nloc == 0u) { xcd_barrier_complete(bar, b.x, nloc, nx); b.st[0] = nloc; b.st[1] = nx; }
        const unsigned old = xb_add(&bar[XB_XSUB(b.x)], 1u);
        const unsigned gen = old / nloc;
        if (old + 1u == (gen + 1u) * nloc) {
            __builtin_amdgcn_fence(__ATOMIC_RELEASE, "agent");
            asm volatile("s_waitcnt vmcnt(0)" ::: "memory");
            const unsigned og = xb_add(&bar[XB_TOP], 1u);
            const unsigned tg = og / nx;
            if (og + 1u == (tg + 1u) * nx) xb_add(&bar[XB_TOPGEN], 1u);
            else XB_SPIN(xb_ld(&bar[XB_TOPGEN]) == tg, bar);
            __builtin_amdgcn_fence(__ATOMIC_ACQUIRE, "agent");
            xb_add(&bar[XB_XGEN(b.x)], 1u);
            asm volatile("s_waitcnt vmcnt(0)" ::: "memory");
        } else {
            XB_SPIN(xb_ld(&bar[XB_XGEN(b.x)]) == gen, bar);
            __builtin_amdgcn_fence(__ATOMIC_ACQUIRE, "agent");
            asm volatile("s_waitcnt vmcnt(0)" ::: "memory");
        }
    }
    __syncthreads();
}

__device__ __forceinline__ void transpose_item(const float* W, int N, bf16* WT, int Kp, int k0, int n0, int drow0, LAS float* scr, int lane) {
    { f32x4 v[8];
#pragma unroll
      for (int i = 0; i < 8; ++i) v[i] = *(const f32x4*)(W + (size_t)(k0 + 8 * i + (lane >> 3)) * N + n0 + 4 * (lane & 7));
#pragma unroll
      for (int i = 0; i < 8; ++i) { LAS float* d = scr + (8 * i + (lane >> 3)) * 33 + 4 * (lane & 7); d[0] = v[i][0]; d[1] = v[i][1]; d[2] = v[i][2]; d[3] = v[i][3]; } }
    asm volatile("s_waitcnt lgkmcnt(0)" ::: "memory");
    const int c = lane & 7;
#pragma unroll
    for (int j = 0; j < 4; ++j) { const int n = (lane >> 3) + 8 * j; const LAS float* s = scr + (8 * c) * 33 + n;
        u32x4 o; o.x = pk2(s[0 * 33], s[1 * 33]); o.y = pk2(s[2 * 33], s[3 * 33]); o.z = pk2(s[4 * 33], s[5 * 33]); o.w = pk2(s[6 * 33], s[7 * 33]);
        *(u32x4*)(WT + (size_t)(drow0 + n) * Kp + k0 + 8 * c) = o; }
    asm volatile("s_waitcnt lgkmcnt(0)" ::: "memory");
}
__device__ __forceinline__ void transpose_item8(const float* W, int N, unsigned char* WT, int Kp, int k0, int n0, int drow0, float sc, LAS float* scr, int lane) {
    { f32x4 v[8];
#pragma unroll
      for (int i = 0; i < 8; ++i) v[i] = *(const f32x4*)(W + (size_t)(k0 + 8 * i + (lane >> 3)) * N + n0 + 4 * (lane & 7));
#pragma unroll
      for (int i = 0; i < 8; ++i) { LAS float* d = scr + (8 * i + (lane >> 3)) * 33 + 4 * (lane & 7); d[0] = v[i][0]; d[1] = v[i][1]; d[2] = v[i][2]; d[3] = v[i][3]; } }
    asm volatile("s_waitcnt lgkmcnt(0)" ::: "memory");
    const int c = lane & 7;
#pragma unroll
    for (int j = 0; j < 4; ++j) { const int n = (lane >> 3) + 8 * j; const LAS float* sp = scr + (8 * c) * 33 + n;
        u32x2 o; unsigned t = 0u;
        float q8[8];
#pragma unroll
        for (int k = 0; k < 8; ++k) q8[k] = __builtin_amdgcn_fmed3f(sp[k * 33] * sc, -448.0f, 448.0f);
        t = __builtin_amdgcn_cvt_pk_fp8_f32(q8[0], q8[1], t, false); t = __builtin_amdgcn_cvt_pk_fp8_f32(q8[2], q8[3], t, true); o.x = t;
        t = __builtin_amdgcn_cvt_pk_fp8_f32(q8[4], q8[5], t, false); t = __builtin_amdgcn_cvt_pk_fp8_f32(q8[6], q8[7], t, true); o.y = t;
        *(u32x2*)(WT + (size_t)(drow0 + n) * Kp + k0 + 8 * c) = o; }
    asm volatile("s_waitcnt lgkmcnt(0)" ::: "memory");
}
__device__ __forceinline__ void conv_i8_item(const float* W, int N, signed char* WT, float* SW, int n0, int drow0, LAS float* scr, int lane) {
    const int cg = lane & 7, rg = lane >> 3;
    const float* wp = W + n0 + 4 * cg;
    f32x4 mx = (f32x4){0.f, 0.f, 0.f, 0.f};
#pragma unroll 16
    for (int i = 0; i < D / 8; ++i) { const f32x4 v = *(const f32x4*)(wp + (size_t)(8 * i + rg) * N); mx[0] = fmaxf(mx[0], fabsf(v[0])); mx[1] = fmaxf(mx[1], fabsf(v[1])); mx[2] = fmaxf(mx[2], fabsf(v[2])); mx[3] = fmaxf(mx[3], fabsf(v[3])); }
#pragma unroll
    for (int o = 8; o < 64; o <<= 1) { mx[0] = fmaxf(mx[0], __shfl_xor(mx[0], o)); mx[1] = fmaxf(mx[1], __shfl_xor(mx[1], o)); mx[2] = fmaxf(mx[2], __shfl_xor(mx[2], o)); mx[3] = fmaxf(mx[3], __shfl_xor(mx[3], o)); }
    f32x4 inv;
#pragma unroll
    for (int j = 0; j < 4; ++j) inv[j] = mx[j] > 0.f ? 127.0f / mx[j] : 0.f;
    if (lane < 8) *(f32x4*)(SW + drow0 + 4 * lane) = mx * (1.0f / 127.0f);
    for (int kb2 = 0; kb2 < D / 64; kb2 += 2) {
        f32x4 v[2][8];
#pragma unroll
        for (int h = 0; h < 2; ++h)
#pragma unroll
            for (int i = 0; i < 8; ++i) v[h][i] = *(const f32x4*)(wp + (size_t)(64 * (kb2 + h) + 8 * i + rg) * N);
#pragma unroll
        for (int h = 0; h < 2; ++h) { const int kb = kb2 + h;
#pragma unroll
            for (int i = 0; i < 8; ++i) { LAS float* d = scr + (8 * i + rg) * 33 + 4 * cg; d[0] = v[h][i][0] * inv[0]; d[1] = v[h][i][1] * inv[1]; d[2] = v[h][i][2] * inv[2]; d[3] = v[h][i][3] * inv[3]; }
            asm volatile("s_waitcnt lgkmcnt(0)" ::: "memory");
            const int c = lane & 7;
#pragma unroll
            for (int j = 0; j < 4; ++j) { const int n = (lane >> 3) + 8 * j; const LAS float* sp = scr + (8 * c) * 33 + n;
                unsigned q[8];
#pragma unroll
                for (int t = 0; t < 8; ++t) q[t] = (unsigned)(int)rintf(sp[t * 33]) & 0xffu;
                u32x2 o; o.x = q[0] | (q[1] << 8) | (q[2] << 16) | (q[3] << 24); o.y = q[4] | (q[5] << 8) | (q[6] << 16) | (q[7] << 24);
                *(u32x2*)(WT + (size_t)(drow0 + n) * D + 64 * kb + 8 * c) = o; }
            asm volatile("s_waitcnt lgkmcnt(0)" ::: "memory"); }
    }
}
__device__ __forceinline__ void conv_i8_item_wg(const float* W, int N, signed char* WT, float* SW, int n0, int drow0, LAS float* scr, LAS float* mxs, int wave, int lane) {
    const int cg = lane & 7, rg = lane >> 3;
    const float* wp = W + n0 + 4 * cg;
    f32x4 mx = (f32x4){0.f, 0.f, 0.f, 0.f};
    f32x4 vv[16];
#pragma unroll
    for (int i = 0; i < 16; ++i) vv[i] = *(const f32x4*)(wp + (size_t)(128 * wave + 8 * i + rg) * N);
#pragma unroll
    for (int i = 0; i < 16; ++i) { const f32x4 v = vv[i]; mx[0] = fmaxf(mx[0], fabsf(v[0])); mx[1] = fmaxf(mx[1], fabsf(v[1])); mx[2] = fmaxf(mx[2], fabsf(v[2])); mx[3] = fmaxf(mx[3], fabsf(v[3])); }
#pragma unroll
    for (int o = 8; o < 64; o <<= 1) { mx[0] = fmaxf(mx[0], __shfl_xor(mx[0], o)); mx[1] = fmaxf(mx[1], __shfl_xor(mx[1], o)); mx[2] = fmaxf(mx[2], __shfl_xor(mx[2], o)); mx[3] = fmaxf(mx[3], __shfl_xor(mx[3], o)); }
    if (lane < 8) *(LAS f32x4*)(mxs + wave * 32 + 4 * lane) = mx;
    __syncthreads();
#pragma unroll
    for (int w = 0; w < 8; ++w) { const f32x4 o = *(const LAS f32x4*)(mxs + w * 32 + 4 * cg); mx[0] = fmaxf(mx[0], o[0]); mx[1] = fmaxf(mx[1], o[1]); mx[2] = fmaxf(mx[2], o[2]); mx[3] = fmaxf(mx[3], o[3]); }
    f32x4 inv;
#pragma unroll
    for (int j = 0; j < 4; ++j) inv[j] = mx[j] > 0.f ? 127.0f / mx[j] : 0.f;
    if (wave == 0 && lane < 8) *(f32x4*)(SW + drow0 + 4 * lane) = mx * (1.0f / 127.0f);
#pragma unroll
    for (int h = 0; h < 2; ++h) { const int kb = 2 * wave + h;
#pragma unroll
        for (int i = 0; i < 8; ++i) { LAS float* d = scr + (8 * i + rg) * 33 + 4 * cg; d[0] = vv[8 * h + i][0] * inv[0]; d[1] = vv[8 * h + i][1] * inv[1]; d[2] = vv[8 * h + i][2] * inv[2]; d[3] = vv[8 * h + i][3] * inv[3]; }
        asm volatile("s_waitcnt lgkmcnt(0)" ::: "memory");
        const int c = lane & 7;
#pragma unroll
        for (int j = 0; j < 4; ++j) { const int n = (lane >> 3) + 8 * j; const LAS float* sp = scr + (8 * c) * 33 + n;
            unsigned q[8];
#pragma unroll
            for (int t = 0; t < 8; ++t) q[t] = (unsigned)(int)rintf(sp[t * 33]) & 0xffu;
            u32x2 o; o.x = q[0] | (q[1] << 8) | (q[2] << 16) | (q[3] << 24); o.y = q[4] | (q[5] << 8) | (q[6] << 16) | (q[7] << 24);
            *(u32x2*)(WT + (size_t)(drow0 + n) * D + 64 * kb + 8 * c) = o; }
        asm volatile("s_waitcnt lgkmcnt(0)" ::: "memory");
    }
    __syncthreads();
}
template <bool FP8>
__device__ __forceinline__ void transpose_quad(const float* W, int N, void* WTv, int Kp, int k0, int n0, int drow0, float sc, LAS float* scr, int lane) {
    f32x4 v[4][8];
#pragma unroll
    for (int q = 0; q < 4; ++q)
#pragma unroll
        for (int i = 0; i < 8; ++i) v[q][i] = *(const f32x4*)(W + (size_t)(k0 + 8 * i + (lane >> 3)) * N + n0 + 32 * q + 4 * (lane & 7));
    const int c = lane & 7;
#pragma unroll
    for (int q = 0; q < 4; ++q) {
#pragma unroll
        for (int i = 0; i < 8; ++i) { LAS float* d = scr + (8 * i + (lane >> 3)) * 33 + 4 * (lane & 7); d[0] = v[q][i][0]; d[1] = v[q][i][1]; d[2] = v[q][i][2]; d[3] = v[q][i][3]; }
        asm volatile("s_waitcnt lgkmcnt(0)" ::: "memory");
#pragma unroll
        for (int j = 0; j < 4; ++j) { const int n = (lane >> 3) + 8 * j; const LAS float* sp = scr + (8 * c) * 33 + n;
            if constexpr (FP8) {
                u32x2 o; unsigned t = 0u; float q8[8];
#pragma unroll
                for (int k = 0; k < 8; ++k) q8[k] = __builtin_amdgcn_fmed3f(sp[k * 33] * sc, -448.0f, 448.0f);
                t = __builtin_amdgcn_cvt_pk_fp8_f32(q8[0], q8[1], t, false); t = __builtin_amdgcn_cvt_pk_fp8_f32(q8[2], q8[3], t, true); o.x = t;
                t = __builtin_amdgcn_cvt_pk_fp8_f32(q8[4], q8[5], t, false); t = __builtin_amdgcn_cvt_pk_fp8_f32(q8[6], q8[7], t, true); o.y = t;
                *(u32x2*)((unsigned char*)WTv + (size_t)(drow0 + 32 * q + n) * Kp + k0 + 8 * c) = o;
            } else {
                u32x4 o; o.x = pk2(sp[0 * 33], sp[1 * 33]); o.y = pk2(sp[2 * 33], sp[3 * 33]); o.z = pk2(sp[4 * 33], sp[5 * 33]); o.w = pk2(sp[6 * 33], sp[7 * 33]);
                *(u32x4*)((bf16*)WTv + (size_t)(drow0 + 32 * q + n) * Kp + k0 + 8 * c) = o; } }
        asm volatile("s_waitcnt lgkmcnt(0)" ::: "memory");
    }
}
__device__ __forceinline__ void conv_plain(const float* W, int K, int N, bf16* WT, int item, LAS float* scr, int lane) {
    const int nblk = N / 32, kb = item / nblk, nb = item % nblk;
    transpose_item(W, N, WT, K, 64 * kb, 32 * nb, 32 * nb, scr, lane);
}
__device__ __forceinline__ void conv_w2(const float* W, unsigned char* WT, int item, LAS float* scr, int lane) {
    const int nblk = D / 32, kb = item / nblk, nb = item % nblk;
    transpose_item8(W, D, WT, DFF, 64 * kb, 32 * nb, 32 * nb, WSC2, scr, lane);
}

struct Params {
    const float* in[31];
    float* out;
    unsigned char* ws;
    int l_lo, l_hi, ph_lo, ph_hi, bar_region, slab_cap;
};

template <int MODE, bool XIN32>
__device__ __forceinline__ void row_issue(int m, const void* xin_ctx, const void* xin_lat, const bf16* Y, const bf16* yslot, int2 sl, int lane, f32x4 (&x)[4], u32x2 (&xb)[4], u32x2 (&ya)[4], u32x2 (&yb)[4]) {
    if (XIN32) { const float* xi = (m < MC) ? (const float*)xin_ctx + (size_t)m * D : (const float*)xin_lat + (size_t)(m - MC) * D;
#pragma unroll
        for (int j = 0; j < 4; ++j) x[j] = __builtin_nontemporal_load((const f32x4*)(xi + 4 * lane + 256 * j)); }
    else { const bf16* xi = (m < MC) ? (const bf16*)xin_ctx + (size_t)m * D : (const bf16*)xin_lat + (size_t)(m - MC) * D;
#pragma unroll
        for (int j = 0; j < 4; ++j) xb[j] = __builtin_nontemporal_load((const u32x2*)(xi + 4 * lane + 256 * j)); }
    if (MODE == 1) { const bf16* yr = Y + (size_t)m * D;
#pragma unroll
        for (int j = 0; j < 4; ++j) ya[j] = __builtin_nontemporal_load((const u32x2*)(yr + 4 * lane + 256 * j)); }
    if (MODE == 2) { const bf16* y1 = yslot + (size_t)sl.x * D; const bf16* y2 = yslot + (size_t)sl.y * D;
#pragma unroll
        for (int j = 0; j < 4; ++j) { ya[j] = __builtin_nontemporal_load((const u32x2*)(y1 + 4 * lane + 256 * j)); yb[j] = __builtin_nontemporal_load((const u32x2*)(y2 + 4 * lane + 256 * j)); } }
}
template <int MODE, bool ROUTER, bool WRITE_H, bool XIN32, bool XOUT32>
__device__ __forceinline__ void row_phase(float* SA, const void* xin_ctx, const void* xin_lat, void* xo_ctx, void* xo_lat,
                                          const bf16* Y, const bf16* yslot, const uint4* tokinfo, const int2* tokslot,
                                          const float* gpost, const float* gpre, const float* modl, int o_gt, int o_sh, int o_sc,
                                          bf16* Aout, const float* router_w, uint4* tokinfo_out, LAS unsigned* lcnt, unsigned* gcnt,
                                          int m_lo, int m_hi, int G, int bid, int wave, int lane, int tid, LAS unsigned char* rw_lds = nullptr) {
    const int nw = G * NWAVES, gw = bid * NWAVES + wave;
    const int per = (m_hi - m_lo) / nw;
    const int mbase = m_lo + gw * per;
    f32x4 gq[4], gp[4];
#pragma unroll
    for (int j = 0; j < 4; ++j) { gp[j] = (f32x4){0.f, 0.f, 0.f, 0.f}; gq[j] = gp[j]; }
    extern __shared__ __attribute__((aligned(16))) unsigned char lds_dyn_rp[];
    LAS float* VEC = (LAS float*)((LAS unsigned char*)lds_dyn_rp + 40960);
    const int m_first = m_lo + bid * NWAVES * per; const int mrow_wg = (m_first < MC) ? 32 : ((m_first - MC) >> 11);
    { const float* mpw = modl + (size_t)mrow_wg * 6144;
      for (int i = tid; i < D; i += NTHR) { VEC[i] = gpre[i]; VEC[D + i] = (MODE != 0) ? gpost[i] : 0.f; VEC[2 * D + i] = (MODE != 0) ? mpw[o_gt + i] : 0.f; VEC[3 * D + i] = mpw[o_sh + i]; VEC[4 * D + i] = mpw[o_sc + i]; } }
    LAS float* RW = (LAS float*)rw_lds;
    if (ROUTER) { if (tid < 8) lcnt[tid] = 0u;
        for (int i = tid; i < D * 8; i += NTHR) RW[(i & 7) * D + (i >> 3)] = router_w[i]; }
    __syncthreads();
#pragma unroll
    for (int j = 0; j < 4; ++j) { gp[j] = *(const LAS f32x4*)(VEC + 4 * lane + 256 * j); if (MODE != 0) gq[j] = *(const LAS f32x4*)(VEC + D + 4 * lane + 256 * j); }
    int mrow_cur = -1; f32x4 vgt[4], vsh[4], vsc[4];
#pragma unroll
    for (int j = 0; j < 4; ++j) { vgt[j] = (f32x4){0.f, 0.f, 0.f, 0.f}; vsh[j] = vgt[j]; vsc[j] = vgt[j]; }
    f32x4 xn[4]; u32x2 xbn[4], yan[4], ybn[4]; int2 sl_n2 = make_int2(0, 0); uint4 ti_c = make_uint4(0, 0, 0, 0), ti_n = ti_c;
#pragma unroll
    for (int j = 0; j < 4; ++j) { xn[j] = (f32x4){0.f, 0.f, 0.f, 0.f}; yan[j] = (u32x2){0u, 0u}; ybn[j] = yan[j]; xbn[j] = yan[j]; }
    { int2 sl0 = make_int2(0, 0); if (MODE == 2) { sl0 = tokslot[mbase]; ti_n = tokinfo[mbase]; if (per > 1) sl_n2 = tokslot[mbase + 1]; }
      row_issue<MODE, XIN32>(mbase, xin_ctx, xin_lat, Y, yslot, sl0, lane, xn, xbn, yan, ybn); }
    for (int i = 0; i < per; ++i) {
        const int m = mbase + i;
        f32x4 x[4]; u32x2 ya[4], yb[4];
#pragma unroll
        for (int j = 0; j < 4; ++j) { if (XIN32) x[j] = xn[j]; else x[j] = (f32x4){bf_lo(xbn[j].x), bf_hi(xbn[j].x), bf_lo(xbn[j].y), bf_hi(xbn[j].y)}; ya[j] = yan[j]; yb[j] = ybn[j]; }
        ti_c = ti_n;
        if (i + 1 < per) { const int2 sl1 = sl_n2; if (MODE == 2) { ti_n = tokinfo[m + 1]; if (i + 2 < per) sl_n2 = tokslot[m + 2]; }
            row_issue<MODE, XIN32>(m + 1, xin_ctx, xin_lat, Y, yslot, sl1, lane, xn, xbn, yan, ybn); }
        const bool isctx = m < MC;
        const int mrow = isctx ? 32 : ((m - MC) >> 11);
        if (mrow != mrow_cur) { mrow_cur = mrow; const float* mp = modl + (size_t)mrow * 6144;
            if (mrow == mrow_wg) {
#pragma unroll
                for (int j = 0; j < 4; ++j) { if (MODE != 0) vgt[j] = *(const LAS f32x4*)(VEC + 2 * D + 4 * lane + 256 * j); vsh[j] = *(const LAS f32x4*)(VEC + 3 * D + 4 * lane + 256 * j); vsc[j] = *(const LAS f32x4*)(VEC + 4 * D + 4 * lane + 256 * j); }
            } else {
#pragma unroll
                for (int j = 0; j < 4; ++j) { if (MODE != 0) vgt[j] = *(const f32x4*)(mp + o_gt + 4 * lane + 256 * j); vsh[j] = *(const f32x4*)(mp + o_sh + 4 * lane + 256 * j); vsc[j] = *(const f32x4*)(mp + o_sc + 4 * lane + 256 * j); } } }
        if (MODE != 0) {
            f32x4 y[4];
            if (MODE == 1) {
#pragma unroll
                for (int j = 0; j < 4; ++j) y[j] = (f32x4){bf_lo(ya[j].x), bf_hi(ya[j].x), bf_lo(ya[j].y), bf_hi(ya[j].y)};
            } else {
                const float w1 = __uint_as_float(ti_c.z), w2 = __uint_as_float(ti_c.w);
#pragma unroll
                for (int j = 0; j < 4; ++j) y[j] = (f32x4){w1 * bf_lo(ya[j].x) + w2 * bf_lo(yb[j].x), w1 * bf_hi(ya[j].x) + w2 * bf_hi(yb[j].x), w1 * bf_lo(ya[j].y) + w2 * bf_lo(yb[j].y), w1 * bf_hi(ya[j].y) + w2 * bf_hi(yb[j].y)};
            }
            float ss = 0.f;
#pragma unroll
            for (int j = 0; j < 4; ++j) ss += (y[j][0] * y[j][0] + y[j][1] * y[j][1]) + (y[j][2] * y[j][2] + y[j][3] * y[j][3]);
            const float rs = 1.0f / sqrtf(wave_sum(ss) * (1.0f / D) + EPS);
#pragma unroll
            for (int j = 0; j < 4; ++j) x[j] = x[j] + vgt[j] * (y[j] * rs * gq[j]);
            if (XOUT32) { float* xo = isctx ? (float*)xo_ctx + (size_t)m * D : (float*)xo_lat + (size_t)(m - MC) * D;
#pragma unroll
                for (int j = 0; j < 4; ++j) __builtin_nontemporal_store(x[j], (f32x4*)(xo + 4 * lane + 256 * j)); }
            else { bf16* xo = isctx ? (bf16*)xo_ctx + (size_t)m * D : (bf16*)xo_lat + (size_t)(m - MC) * D;
#pragma unroll
                for (int j = 0; j < 4; ++j) { u32x2 w; w.x = pk2(x[j][0], x[j][1]); w.y = pk2(x[j][2], x[j][3]); __builtin_nontemporal_store(w, (u32x2*)(xo + 4 * lane + 256 * j));
                    x[j] = (f32x4){bf_lo(w.x), bf_hi(w.x), bf_lo(w.y), bf_hi(w.y)}; } }
        }
        if (WRITE_H) {
            float s2 = 0.f;
#pragma unroll
            for (int j = 0; j < 4; ++j) s2 += (x[j][0] * x[j][0] + x[j][1] * x[j][1]) + (x[j][2] * x[j][2] + x[j][3] * x[j][3]);
            const float r2 = 1.0f / sqrtf(wave_sum(s2) * (1.0f / D) + EPS);
            f32x4 h[4]; float amax = 0.f;
#pragma unroll
            for (int j = 0; j < 4; ++j) { h[j] = (x[j] * r2 * gp[j]) * (vsc[j] + 1.0f) + vsh[j]; amax = fmaxf(fmaxf(amax, fmaxf(fabsf(h[j][0]), fabsf(h[j][1]))), fmaxf(fabsf(h[j][2]), fabsf(h[j][3]))); }
            amax = wave_max(amax);
            const float qinv = amax > 0.f ? 127.0f / amax : 0.f;
            if (lane == 0) SA[m] = amax * (1.0f / 127.0f);
#pragma unroll
            for (int j = 0; j < 4; ++j) { const unsigned q0 = (unsigned)(int)rintf(h[j][0] * qinv) & 0xffu, q1 = (unsigned)(int)rintf(h[j][1] * qinv) & 0xffu, q2 = (unsigned)(int)rintf(h[j][2] * qinv) & 0xffu, q3 = (unsigned)(int)rintf(h[j][3] * qinv) & 0xffu;
                __builtin_nontemporal_store(q0 | (q1 << 8) | (q2 << 16) | (q3 << 24), (unsigned*)((unsigned char*)Aout + (size_t)m * D + 4 * lane + 256 * j)); }
            if (ROUTER) {
                float lg[8];
#pragma unroll
                for (int e = 0; e < 8; ++e) lg[e] = 0.f;
#pragma unroll
                for (int j = 0; j < 4; ++j)
#pragma unroll
                    for (int e = 0; e < 8; ++e) { const f32x4 r = *(const LAS f32x4*)(RW + e * D + 4 * lane + 256 * j);
                        lg[e] += (h[j][0] * r[0] + h[j][1] * r[1]) + (h[j][2] * r[2] + h[j][3] * r[3]); }
#pragma unroll
                for (int e = 0; e < 8; ++e) lg[e] = wave_sum(lg[e]);
                int e1 = 0; float l1 = lg[0];
#pragma unroll
                for (int e = 1; e < 8; ++e) if (lg[e] > l1) { l1 = lg[e]; e1 = e; }
                int e2 = -1; float l2 = -3.0e38f;
#pragma unroll
                for (int e = 0; e < 8; ++e) if (e != e1 && lg[e] > l2) { l2 = lg[e]; e2 = e; }
                const float w1 = 1.0f / (1.0f + expf(l2 - l1)), w2 = 1.0f - w1;
                if (lane == 0) { tokinfo_out[m] = make_uint4((unsigned)e1, (unsigned)e2, __float_as_uint(w1), __float_as_uint(w2));
                    __hip_atomic_fetch_add(lcnt + e1, 1u, __ATOMIC_RELAXED, __HIP_MEMORY_SCOPE_WORKGROUP); __hip_atomic_fetch_add(lcnt + e2, 1u, __ATOMIC_RELAXED, __HIP_MEMORY_SCOPE_WORKGROUP); }
            }
        }
    }
    if (ROUTER) {
        __syncthreads();
        if (tid < 8) { const unsigned c = lcnt[tid]; if (c) __hip_atomic_fetch_add(gcnt + tid, c, __ATOMIC_RELAXED, __HIP_MEMORY_SCOPE_AGENT); }
    }
}

__device__ __forceinline__ void lru_blk(int half, int s, int& isctx, int& bi) { isctx = s < 4; bi = (half == 0) ? (isctx ? s : s - 4) : (isctx ? 3 - s : 35 - s); }
__device__ __forceinline__ void lru_unit(LAS unsigned char* lds, const bf16* P, bf16* CAT, bf16* TL, const bf16* WaT, const bf16* WxT,
                                         const float* ba, const float* bx, const float* lam, const float* convw, const float* convb,
                                         int b, int hh, bool want_ctx, int tid) {
    const int wave = __builtin_amdgcn_readfirstlane(tid >> 6), lane = tid & 63, fr = lane & 15, fg = lane >> 4;
    const int half = wave >> 2, w4 = wave & 3, tidh = tid & 255;
    LAS unsigned char* hb = lds + half * 59136;
    LAS bf16* Xr = (LAS bf16*)hb;
    LAS bf16* Xc = (LAS bf16*)(hb + 17152);
    LAS f32x2* AU = (LAS f32x2*)(hb + 17152 + 9216);
    LAS float* CW = (LAS float*)(lds + 118272);
    if (tid < 320) CW[tid] = (tid < 256) ? convw[(tid >> 6) * 384 + hh * 64 + (tid & 63)] : convb[hh * 64 + (tid - 256)];
    const bf16* wa = WaT + (size_t)(half * 6 + hh) * 4096; const bf16* wx = WxT + (size_t)(half * 6 + hh) * 4096;
    bf16x8 Ba[4][2], Bx[4][2]; float bav[4], bxv[4], spv[4];
#pragma unroll
    for (int nt = 0; nt < 4; ++nt) {
#pragma unroll
        for (int ks = 0; ks < 2; ++ks) { Ba[nt][ks] = ld16g(wa + (nt * 16 + fr) * 64 + ks * 32 + fg * 8); Bx[nt][ks] = ld16g(wx + (nt * 16 + fr) * 64 + ks * 32 + fg * 8); }
        const int ch = (half * 6 + hh) * 64 + nt * 16 + fr;
        bav[nt] = -1.44269504f * ba[ch]; bxv[nt] = -1.44269504f * bx[ch]; const float lm = lam[ch]; spv[nt] = -8.0f * 1.44269504f * ((lm > 15.f) ? expf(-lm) : log1pf(expf(-lm)));
    }
    float hstate = 0.f;
    u32x4 rr[3];
#define LRU_RAW_LOAD(ISCTX, BI) do { const int seqlen_ = (ISCTX) ? CTXL : SEQ; const size_t m0_ = (ISCTX) ? (size_t)b * CTXL : (size_t)MC + (size_t)b * SEQ; \
        _Pragma("unroll") for (int k = 0; k < 3; ++k) { const int q = tidh + 256 * k, tp = (BI) * 64 - 2 + (q >> 3); rr[k] = (u32x4){0u, 0u, 0u, 0u}; \
            if (q < 536 && tp >= 0 && tp < seqlen_) rr[k] = *(const u32x4*)(P + (m0_ + tp) * INW + hh * 64 + (q & 7) * 8); } } while (0)
#define LRU_RAW_STORE(BUF) do { _Pragma("unroll") for (int k = 0; k < 3; ++k) { const int q = tidh + 256 * k; if (q < 536) *(LAS u32x4*)(Xr + (BUF) * 4288 + q * 8) = rr[k]; } } while (0)
    { int ic, bb; lru_blk(half, 0, ic, bb); LRU_RAW_LOAD(ic, bb); LRU_RAW_STORE(0); }
    __syncthreads();
    for (int s = 0; s < 36; ++s) {
        int isctx, bi; lru_blk(half, s, isctx, bi);
        const size_t m0 = isctx ? (size_t)b * CTXL : (size_t)MC + (size_t)b * SEQ;
        if (s + 1 < 36) { int ic, bb; lru_blk(half, s + 1, ic, bb); LRU_RAW_LOAD(ic, bb); }
        { const int pos = tidh >> 2, cq = tidh & 3; f32x2 acc[8]; const LAS bf16* xr = Xr + (s & 1) * 4288;
#pragma unroll
            for (int c = 0; c < 8; ++c) acc[c] = *(const LAS f32x2*)(CW + 256 + cq * 16 + 2 * c);
#pragma unroll
            for (int j = 0; j < 4; ++j) { const u32x4 a = *(const LAS u32x4*)(xr + (pos + j) * 64 + cq * 16), c2 = *(const LAS u32x4*)(xr + (pos + j) * 64 + cq * 16 + 8);
                const unsigned ww[8] = {a.x, a.y, a.z, a.w, c2.x, c2.y, c2.z, c2.w};
#pragma unroll
                for (int q = 0; q < 8; ++q) acc[q] += *(const LAS f32x2*)(CW + j * 64 + cq * 16 + 2 * q) * (f32x2){bf_lo(ww[q]), bf_hi(ww[q])}; }
            u32x4 o0, o1; o0.x = pk2(acc[0].x, acc[0].y); o0.y = pk2(acc[1].x, acc[1].y); o0.z = pk2(acc[2].x, acc[2].y); o0.w = pk2(acc[3].x, acc[3].y);
            o1.x = pk2(acc[4].x, acc[4].y); o1.y = pk2(acc[5].x, acc[5].y); o1.z = pk2(acc[6].x, acc[6].y); o1.w = pk2(acc[7].x, acc[7].y);
            *(LAS u32x4*)(Xc + pos * 72 + cq * 16) = o0; *(LAS u32x4*)(Xc + pos * 72 + cq * 16 + 8) = o1; }
        __syncthreads();
        const int nb_half = isctx ? 2 : 16; const bool second = (half == 0) ? (bi >= nb_half) : (bi < nb_half);
        const bool emit = want_ctx || !isctx;
        const int opos = tidh >> 2, ocq = tidh & 3; const size_t om = m0 + bi * 64 + opos;
        bf16* tp = TL + om * 384 + hh * 64 + ocq * 16;
        u32x4 t0 = (u32x4){0u, 0u, 0u, 0u}, t1 = t0, y0 = t0, y1 = t0;
        if (emit && second) { t0 = *(const u32x4*)tp; t1 = *(const u32x4*)(tp + 8); const bf16* lp = P + om * INW + 384 + hh * 64 + ocq * 16; y0 = *(const u32x4*)lp; y1 = *(const u32x4*)(lp + 8); }
        { const bf16x8 A0 = ld16l(Xc + (w4 * 16 + fr) * 72 + fg * 8), A1 = ld16l(Xc + (w4 * 16 + fr) * 72 + 32 + fg * 8);
#pragma unroll
            for (int nt = 0; nt < 4; ++nt) {
                f32x4 ga = (f32x4){0.f, 0.f, 0.f, 0.f}, gx = ga;
                ga = mfma16(A0, Ba[nt][0], ga); ga = mfma16(A1, Ba[nt][1], ga); gx = mfma16(A0, Bx[nt][0], gx); gx = mfma16(A1, Bx[nt][1], gx);
#pragma unroll
                for (int pr = 0; pr < 2; ++pr) { const int pos = w4 * 16 + fg * 4 + 2 * pr, ch = nt * 16 + fr;
                    const f32x2 ta = (f32x2){ga[2 * pr], ga[2 * pr + 1]} * (f32x2){-1.44269504f, -1.44269504f} + (f32x2){bav[nt], bav[nt]};
                    const f32x2 tx = (f32x2){gx[2 * pr], gx[2 * pr + 1]} * (f32x2){-1.44269504f, -1.44269504f} + (f32x2){bxv[nt], bxv[nt]};
                    const f32x2 e1 = (f32x2){fexp2(ta.x), fexp2(ta.y)} + (f32x2){1.0f, 1.0f}, e2 = (f32x2){fexp2(tx.x), fexp2(tx.y)} + (f32x2){1.0f, 1.0f};
                    const f32x2 rg = (f32x2){__builtin_amdgcn_rcpf(e1.x), __builtin_amdgcn_rcpf(e1.y)}, ig = (f32x2){__builtin_amdgcn_rcpf(e2.x), __builtin_amdgcn_rcpf(e2.y)};
                    const f32x2 la2 = rg * (f32x2){spv[nt], spv[nt]};
                    const f32x2 a = (f32x2){fexp2(la2.x), fexp2(la2.y)};
                    const f32x2 om1 = (f32x2){1.0f, 1.0f} - a * a;
                    const f32x2 xc = (f32x2){__uint_as_float(((unsigned)Xc[pos * 72 + ch]) << 16), __uint_as_float(((unsigned)Xc[(pos + 1) * 72 + ch]) << 16)};
                    const f32x2 u = (f32x2){__builtin_amdgcn_sqrtf(om1.x), __builtin_amdgcn_sqrtf(om1.y)} * (ig * xc);
                    AU[pos * 64 + ch] = (f32x2){a.x, u.x}; AU[(pos + 1) * 64 + ch] = (f32x2){a.y, u.y}; } } }
        __syncthreads();
        if (w4 == 0) {
            LAS f32x2* aup = AU + lane;
#define LRU_SCAN(POS) do { \
                _Pragma("unroll") for (int bb = 0; bb < 4; ++bb) { f32x2 cu[16]; float hs[16]; \
                    _Pragma("unroll") for (int k = 0; k < 16; ++k) cu[k] = aup[(POS(16 * bb + k)) * 64]; \
                    _Pragma("unroll") for (int k = 0; k < 16; ++k) { hstate = cu[k].x * hstate + cu[k].y; hs[k] = hstate; } \
                    _Pragma("unroll") for (int k = 0; k < 16; ++k) ((LAS float*)(aup + (POS(16 * bb + k)) * 64))[1] = hs[k]; } } while (0)
#define LRU_POS_F(k) (k)
#define LRU_POS_B(k) (63 - (k))
            if (half == 0) LRU_SCAN(LRU_POS_F); else LRU_SCAN(LRU_POS_B);
#undef LRU_SCAN
#undef LRU_POS_F
#undef LRU_POS_B
        }
        if (s + 1 < 36) LRU_RAW_STORE((s + 1) & 1);
        __syncthreads();
        if (emit) {
            float hv[16];
#pragma unroll
            for (int c = 0; c < 16; ++c) hv[c] = AU[opos * 64 + ocq * 16 + c].y;
            if (!second) {
                u32x4 o0, o1; o0.x = pk2(hv[0], hv[1]); o0.y = pk2(hv[2], hv[3]); o0.z = pk2(hv[4], hv[5]); o0.w = pk2(hv[6], hv[7]);
                o1.x = pk2(hv[8], hv[9]); o1.y = pk2(hv[10], hv[11]); o1.z = pk2(hv[12], hv[13]); o1.w = pk2(hv[14], hv[15]);
                *(u32x4*)tp = o0; *(u32x4*)(tp + 8) = o1;
            } else {
                const unsigned tw[8] = {t0.x, t0.y, t0.z, t0.w, t1.x, t1.y, t1.z, t1.w}, yw[8] = {y0.x, y0.y, y0.z, y0.w, y1.x, y1.y, y1.z, y1.w};
                float ov[16];
#pragma unroll
                for (int q = 0; q < 8; ++q) { ov[2 * q] = gelu_t(bf_lo(yw[q])) * (hv[2 * q] + bf_lo(tw[q])); ov[2 * q + 1] = gelu_t(bf_hi(yw[q])) * (hv[2 * q + 1] + bf_hi(tw[q])); }
                unsigned char* op = (unsigned char*)CAT + om * D + hh * 64 + ocq * 16;
                *(u32x4*)op = (u32x4){pk4f8(ov[0], ov[1], ov[2], ov[3], CSC), pk4f8(ov[4], ov[5], ov[6], ov[7], CSC), pk4f8(ov[8], ov[9], ov[10], ov[11], CSC), pk4f8(ov[12], ov[13], ov[14], ov[15], CSC)};
            }
        }
    }
#undef LRU_RAW_LOAD
#undef LRU_RAW_STORE
    __syncthreads();
}

__device__ __forceinline__ void retp1_unit(LAS unsigned char* lds, const bf16* P, bf16* SB, int b, int hh, float lgf2, float lgb2, bool want_ctx, int tid) {
    const int wave = __builtin_amdgcn_readfirstlane(tid >> 6), lane = tid & 63, fr = lane & 15, fg = lane >> 4;
    const int half = wave >> 2, w4 = wave & 3, tidh = tid & 255;
    const int jp = tidh >> 2, part = tidh & 3;
    const float lg2 = half ? lgb2 : lgf2; const float dec = fexp2(128.0f * lg2);
    const float wk0 = half ? fexp2((float)(2 * jp) * lg2) : fexp2((float)(127 - 2 * jp) * lg2), wk1 = half ? fexp2((float)(2 * jp + 1) * lg2) : fexp2((float)(126 - 2 * jp) * lg2);
    u32x4 ka[2], kb[2], va[2], vb[2];
#define RP1_CK(S) ((half == 0) ? (S) : ((S) < 2 ? 1 - (S) : 19 - (S)))
#define RP1_M0(CK) (((CK) < 2) ? (size_t)b * CTXL + (CK) * 128 : (size_t)MC + (size_t)b * SEQ + ((CK) - 2) * 128)
#define RP1_LOAD(S) do { const int ck_ = RP1_CK(S); const size_t m_ = RP1_M0(ck_) + 2 * jp; \
        const bf16* kp = P + m_ * INW + 1152 + hh * 64 + part * 16; const bf16* vp = P + m_ * INW + 1536 + hh * 64 + part * 16; \
        ka[0] = *(const u32x4*)kp; ka[1] = *(const u32x4*)(kp + 8); kb[0] = *(const u32x4*)(kp + INW); kb[1] = *(const u32x4*)(kp + INW + 8); \
        va[0] = *(const u32x4*)vp; va[1] = *(const u32x4*)(vp + 8); vb[0] = *(const u32x4*)(vp + INW); vb[1] = *(const u32x4*)(vp + INW + 8); } while (0)
#define RP1_PARK(BUF) do { LAS bf16* KT_ = (LAS bf16*)(lds + ((BUF) * 2 + half) * 34816); LAS bf16* VT_ = KT_ + 64 * 136; \
        _Pragma("unroll") for (int q = 0; q < 2; ++q) { const unsigned k0w[4] = {ka[q].x, ka[q].y, ka[q].z, ka[q].w}, k1w[4] = {kb[q].x, kb[q].y, kb[q].z, kb[q].w}, v0w[4] = {va[q].x, va[q].y, va[q].z, va[q].w}, v1w[4] = {vb[q].x, vb[q].y, vb[q].z, vb[q].w}; \
            _Pragma("unroll") for (int t = 0; t < 4; ++t) { const int d = part * 16 + 8 * q + 2 * t; \
                *(LAS unsigned*)(KT_ + d * 136 + 2 * jp) = pk2(bf_lo(k0w[t]) * wk0, bf_lo(k1w[t]) * wk1); *(LAS unsigned*)(KT_ + (d + 1) * 136 + 2 * jp) = pk2(bf_hi(k0w[t]) * wk0, bf_hi(k1w[t]) * wk1); \
                *(LAS unsigned*)(VT_ + d * 136 + 2 * jp) = (v0w[t] & 0xffffu) | (v1w[t] << 16); *(LAS unsigned*)(VT_ + (d + 1) * 136 + 2 * jp) = (v0w[t] >> 16) | (v1w[t] & 0xffff0000u); } } } while (0)
    f32x4 st[4];
#pragma unroll
    for (int nt = 0; nt < 4; ++nt) st[nt] = (f32x4){0.f, 0.f, 0.f, 0.f};
    RP1_LOAD(0); RP1_PARK(0);
    __syncthreads();
    for (int s = 0; s < 18; ++s) {
        if (s + 1 < 18) RP1_LOAD(s + 1);
        const int ck = RP1_CK(s);
        if (want_ctx || ck >= 2) { bf16* sp = SB + ((((size_t)b * 6 + hh) * 2 + half) * 18 + ck) * 4096;
#pragma unroll
            for (int nt = 0; nt < 4; ++nt) { u32x2 w; w.x = pk2(st[nt][0], st[nt][1]); w.y = pk2(st[nt][2], st[nt][3]); *(u32x2*)(sp + (nt * 16 + fr) * 64 + w4 * 16 + fg * 4) = w; } }
        const LAS bf16* KT = (const LAS bf16*)(lds + ((s & 1) * 2 + half) * 34816); const LAS bf16* VT = KT + 64 * 136;
#pragma unroll
        for (int nt = 0; nt < 4; ++nt) st[nt] = st[nt] * dec;
#pragma unroll
        for (int ks = 0; ks < 4; ++ks) { const bf16x8 af = ld16l(KT + (w4 * 16 + fr) * 136 + ks * 32 + fg * 8);
#pragma unroll
            for (int nt = 0; nt < 4; ++nt) { const bf16x8 bfr = ld16l(VT + (nt * 16 + fr) * 136 + ks * 32 + fg * 8); st[nt] = mfma16(af, bfr, st[nt]); } }
        if (s + 1 < 18) RP1_PARK((s + 1) & 1);
        __syncthreads();
    }
#undef RP1_CK
#undef RP1_M0
#undef RP1_LOAD
#undef RP1_PARK
}

__device__ __forceinline__ void gmlp_load_w(const bf16* WS, const float* WSUM, const float* bs, int tid, bf16x8 (&wf)[4][4], float (&wsv)[4], float (&bsv)[4]) {
    const int wave = __builtin_amdgcn_readfirstlane(tid >> 6), lane = tid & 63, fr = lane & 15, fg = lane >> 4;
    const int g2 = wave >> 1, ih = wave & 1; const bf16* wsg = WS + (size_t)g2 * 16384;
#pragma unroll
    for (int it = 0; it < 4; ++it) { const int irow = ih * 64 + it * 16 + fr;
#pragma unroll
        for (int ks = 0; ks < 4; ++ks) wf[it][ks] = ld16g(wsg + irow * 128 + ks * 32 + fg * 8);
        wsv[it] = WSUM[g2 * 128 + irow]; bsv[it] = bs[g2 * 128 + irow]; }
}
__device__ __forceinline__ void gmlp_unit(LAS unsigned char* lds, const bf16* P, bf16* CAT, const float* lng, const float* lnb, int b, int ck, int tid,
                                          const bf16x8 (&wf)[4][4], const float (&wsv)[4], const float (&bsv)[4]) {
    const int wave = __builtin_amdgcn_readfirstlane(tid >> 6), lane = tid & 63, fr = lane & 15, fg = lane >> 4;
    const size_t m0 = (ck < 2) ? (size_t)b * CTXL + ck * 128 : (size_t)MC + (size_t)b * SEQ + (ck - 2) * 128;
    LAS bf16* VnT = (LAS bf16*)lds;
    LAS float* LN = (LAS float*)(lds + 69632);
    const int g2 = wave >> 1, ih = wave & 1;
    LN[tid] = (tid < 256) ? lng[tid] : lnb[tid - 256];
    { const int j = tid >> 2, g = tid & 3; const bf16* zp = P + (m0 + j) * INW + 2560 + g * 64; float v[64];
#pragma unroll
        for (int q = 0; q < 8; ++q) { const u32x4 w = *(const u32x4*)(zp + 8 * q); const unsigned ww[4] = {w.x, w.y, w.z, w.w};
#pragma unroll
            for (int t = 0; t < 4; ++t) { v[8 * q + 2 * t] = gelu_t(bf_lo(ww[t])); v[8 * q + 2 * t + 1] = gelu_t(bf_hi(ww[t])); } }
        float s = 0.f;
#pragma unroll
        for (int c = 0; c < 64; ++c) s += v[c];
        const float mu = s * (1.0f / 64.0f); float q2 = 0.f;
#pragma unroll
        for (int c = 0; c < 64; ++c) { v[c] -= mu; q2 += v[c] * v[c]; }
        const float rs = 1.0f / sqrtf(q2 * (1.0f / 64.0f) + EPS);
#pragma unroll
        for (int c = 0; c < 64; c += 2) { const unsigned w = pk2(v[c] * rs, v[c + 1] * rs);
            VnT[(g * 64 + c) * 136 + j] = (bf16)(w & 0xffffu); VnT[(g * 64 + c + 1) * 136 + j] = (bf16)(w >> 16); } }
    __syncthreads();
#pragma unroll
    for (int it = 0; it < 4; ++it) { const int irow = ih * 64 + it * 16 + fr; const size_t m = m0 + irow;
        u32x2 zu[4];
#pragma unroll
        for (int ct = 0; ct < 4; ++ct) zu[ct] = *(const u32x2*)(P + m * INW + 2304 + g2 * 64 + ct * 16 + fg * 4);
        f32x4 acc[4];
#pragma unroll
        for (int ct = 0; ct < 4; ++ct) { acc[ct] = (f32x4){0.f, 0.f, 0.f, 0.f};
#pragma unroll
            for (int ks = 0; ks < 4; ++ks) { const bf16x8 vf = ld16l(VnT + (g2 * 64 + ct * 16 + fr) * 136 + ks * 32 + fg * 8); acc[ct] = mfma16(vf, wf[it][ks], acc[ct]); } }
#pragma unroll
        for (int ct = 0; ct < 4; ++ct) { const int c = g2 * 64 + ct * 16 + fg * 4;
            const f32x4 gv = *(const LAS f32x4*)(LN + c), bv = *(const LAS f32x4*)(LN + 256 + c);
            const f32x4 sv = acc[ct] * gv + bv * wsv[it] + bsv[it];
            *(unsigned*)((unsigned char*)CAT + m * D + 768 + c) = pk4f8(gelu_t(bf_lo(zu[ct].x)) * sv[0], gelu_t(bf_hi(zu[ct].x)) * sv[1], gelu_t(bf_lo(zu[ct].y)) * sv[2], gelu_t(bf_hi(zu[ct].y)) * sv[3], CSC); } }
    __syncthreads();
}

__device__ __forceinline__ void retp2_phase(LAS unsigned char* lds, const bf16* P, const bf16* SB, bf16* CAT, const float* theta, bool want_ctx, int G, int bid, int tid) {
    const int wave = __builtin_amdgcn_readfirstlane(tid >> 6), lane = tid & 63, fr = lane & 15, fg = lane >> 4;
    const int nck = want_ctx ? 18 : 16, ck0 = want_ctx ? 0 : 2, NU = NB * nck * 6;
    const int lj = tid >> 2, lpart = tid & 3;
    u32x4 k0, k1, v0, v1, s0, s1;
#define RP2_DECODE(ID, B_, CK_, HH_) const int HH_ = (ID) % 6, CK_ = ck0 + ((ID) / 6) % nck, B_ = (ID) / (6 * nck)
#define RP2_M0(B_, CK_) (((CK_) < 2) ? (size_t)(B_) * CTXL + (CK_) * 128 : (size_t)MC + (size_t)(B_) * SEQ + ((CK_) - 2) * 128)
#define RP2_LOAD(ID) do { RP2_DECODE(ID, b_, ck_, hh_); const size_t m0_ = RP2_M0(b_, ck_); \
        const bf16* kp = P + (m0_ + lj) * INW + 1152 + hh_ * 64 + lpart * 16; const bf16* vp = P + (m0_ + lj) * INW + 1536 + hh_ * 64 + lpart * 16; \
        k0 = *(const u32x4*)kp; k1 = *(const u32x4*)(kp + 8); v0 = *(const u32x4*)vp; v1 = *(const u32x4*)(vp + 8); \
        const bf16* sp_ = SB + ((((size_t)b_ * 6 + hh_) * 2 + 0) * 18 + ck_) * 4096 + tid * 8; s0 = *(const u32x4*)sp_; s1 = *(const u32x4*)(sp_ + (size_t)18 * 4096); } while (0)
#define RP2_PARK(BUF) do { LAS bf16* Ks_ = (LAS bf16*)(lds + (BUF) * 35840); LAS bf16* VT_ = (LAS bf16*)(lds + (BUF) * 35840 + 18432); \
        *(LAS u32x4*)(Ks_ + lj * 72 + lpart * 16) = k0; *(LAS u32x4*)(Ks_ + lj * 72 + lpart * 16 + 8) = k1; \
        const unsigned vw_[8] = {v0.x, v0.y, v0.z, v0.w, v1.x, v1.y, v1.z, v1.w}; \
        _Pragma("unroll") for (int q = 0; q < 8; ++q) { const int e = lpart * 16 + 2 * q; VT_[e * 136 + lj] = (bf16)(vw_[q] & 0xffffu); VT_[(e + 1) * 136 + lj] = (bf16)(vw_[q] >> 16); } \
        LAS bf16* SF_ = (LAS bf16*)(lds + 73728 + (BUF) * 18432); *(LAS u32x4*)(SF_ + (tid >> 3) * 72 + (tid & 7) * 8) = s0; *(LAS u32x4*)(SF_ + 4608 + (tid >> 3) * 72 + (tid & 7) * 8) = s1; } while (0)
    LAS float* LG = (LAS float*)(lds + 2 * 35840);
    if (tid < 12) { const float t = theta[tid]; LG[tid] = -1.44269504f * ((t < -15.f) ? -t : log1pf(expf(-t))); }
    const int irow = wave * 16 + fr;
    bf16x8 qn0 = {}, qn1 = {};
#define RP2_LOADQ(ID) do { RP2_DECODE(ID, b_, ck_, hh_); const bf16* qp_ = P + (RP2_M0(b_, ck_) + irow) * INW + 768 + hh_ * 64 + fg * 8; qn0 = ld16g(qp_); qn1 = ld16g(qp_ + 32); } while (0)
    int id = bid, buf = 0;
    if (id < NU) { RP2_LOAD(id); RP2_LOADQ(id); RP2_PARK(0); }
    __syncthreads();
    for (; id < NU; id += G, buf ^= 1) {
        const int nid = id + G;
        const bf16x8 qf0 = qn0, qf1 = qn1;
        if (nid < NU) { RP2_LOAD(nid); RP2_LOADQ(nid); }
        RP2_DECODE(id, b, ck, hh);
        const size_t m0 = RP2_M0(b, ck);
        const float lgf2 = LG[hh], lgb2 = LG[6 + hh];
        const LAS bf16* Ks = (const LAS bf16*)(lds + buf * 35840); const LAS bf16* VT = (const LAS bf16*)(lds + buf * 35840 + 18432);
        const size_t mi = m0 + irow;
        const LAS bf16* SFl = (const LAS bf16*)(lds + 73728 + buf * 18432); const LAS bf16* SBl = SFl + 4608;
        u32x2 gw[4];
        f32x4 sc[8];
#pragma unroll
        for (int jt = 0; jt < 8; ++jt) { sc[jt] = (f32x4){0.f, 0.f, 0.f, 0.f};
            const bf16x8 kf0 = ld16l(Ks + (jt * 16 + fr) * 72 + fg * 8), kf1 = ld16l(Ks + (jt * 16 + fr) * 72 + 32 + fg * 8);
            sc[jt] = mfma16(kf0, qf0, sc[jt]); sc[jt] = mfma16(kf1, qf1, sc[jt]); }
#pragma unroll
        for (int jt = 0; jt < 8; ++jt)
#pragma unroll
            for (int r = 0; r < 4; ++r) { const int dd = irow - (jt * 16 + fg * 4 + r);
                const float w = dd > 0 ? fexp2((float)dd * lgf2) : (dd < 0 ? fexp2((float)(-dd) * lgb2) : 2.0f); sc[jt][r] *= w; }
#pragma unroll
        for (int et = 0; et < 4; ++et) gw[et] = *(const u32x2*)(P + mi * INW + 1920 + hh * 64 + et * 16 + fg * 4);
        bf16x8 pf[4];
#pragma unroll
        for (int s4 = 0; s4 < 4; ++s4) { u32x4 w; w.x = pk2(sc[2 * s4][0], sc[2 * s4][1]); w.y = pk2(sc[2 * s4][2], sc[2 * s4][3]); w.z = pk2(sc[2 * s4 + 1][0], sc[2 * s4 + 1][1]); w.w = pk2(sc[2 * s4 + 1][2], sc[2 * s4 + 1][3]); pf[s4] = __builtin_bit_cast(bf16x8, w); }
        f32x4 ao[4], af[4], ab[4];
#pragma unroll
        for (int et = 0; et < 4; ++et) { ao[et] = (f32x4){0.f, 0.f, 0.f, 0.f}; af[et] = ao[et]; ab[et] = ao[et];
#pragma unroll
            for (int s4 = 0; s4 < 4; ++s4) { const LAS bf16* vp = VT + (et * 16 + fr) * 136 + s4 * 32 + fg * 4; const u32x2 lo = *(const LAS u32x2*)vp, hi = *(const LAS u32x2*)(vp + 16);
                const bf16x8 vf = __builtin_bit_cast(bf16x8, ((u32x4){lo.x, lo.y, hi.x, hi.y})); ao[et] = mfma16(vf, pf[s4], ao[et]); }
            af[et] = mfma16(ld16l(SFl + (et * 16 + fr) * 72 + fg * 8), qf0, af[et]); af[et] = mfma16(ld16l(SFl + (et * 16 + fr) * 72 + 32 + fg * 8), qf1, af[et]);
            ab[et] = mfma16(ld16l(SBl + (et * 16 + fr) * 72 + fg * 8), qf0, ab[et]); ab[et] = mfma16(ld16l(SBl + (et * 16 + fr) * 72 + 32 + fg * 8), qf1, ab[et]); }
        const float sfw = fexp2((float)(irow + 1) * lgf2), sbw = fexp2((float)(128 - irow) * lgb2);
        float ss = 0.f; f32x4 o[4];
#pragma unroll
        for (int et = 0; et < 4; ++et) { o[et] = ao[et] + af[et] * sfw + ab[et] * sbw; ss += (o[et][0] * o[et][0] + o[et][1] * o[et][1]) + (o[et][2] * o[et][2] + o[et][3] * o[et][3]); }
        ss += __shfl_xor(ss, 16); ss += __shfl_xor(ss, 32);
        const float rs = 1.0f / sqrtf(ss * (1.0f / 64.0f) + EPS);
#pragma unroll
        for (int et = 0; et < 4; ++et) { const int c = hh * 64 + et * 16 + fg * 4;
            *(unsigned*)((unsigned char*)CAT + mi * D + 384 + c) = pk4f8(silu_f(bf_lo(gw[et].x)) * o[et][0] * rs, silu_f(bf_hi(gw[et].x)) * o[et][1] * rs, silu_f(bf_lo(gw[et].y)) * o[et][2] * rs, silu_f(bf_hi(gw[et].y)) * o[et][3] * rs, CSC); }
        if (nid < NU) RP2_PARK(buf ^ 1);
        __syncthreads();
    }
#undef RP2_DECODE
#undef RP2_M0
#undef RP2_LOAD
#undef RP2_PARK
#undef RP2_LOADQ
}

__global__ void __launch_bounds__(NTHR, 2) fwd_kernel(Params p) {
    extern __shared__ __attribute__((aligned(16))) unsigned char lds_raw[];
    LAS unsigned char* lds = (LAS unsigned char*)lds_raw;
    volatile LAS unsigned* MISC = (volatile LAS unsigned*)(lds + MISC_OFF);
    const int tid = threadIdx.x;
    const int G = gridDim.x, bid = blockIdx.x;
    if (tid < 128) MISC[tid] = 0u;
    __syncthreads();
    (void)xcd_barrier_post((unsigned*)(p.ws + WS_CTL) + CW_BAR + (size_t)p.bar_region * XCD_BAR_WORDS, MISC);

    { const int w_ = __builtin_amdgcn_readfirstlane(tid >> 6); if ((tid & 63) == 0) MISC[64 + (__builtin_amdgcn_s_getreg((5 << 11) | 4) & 63)] = (unsigned)w_; }
    __syncthreads();
#define PHASE_BEGIN \
    const int wave0 = __builtin_amdgcn_readfirstlane((int)MISC[64 + (__builtin_amdgcn_s_getreg((5 << 11) | 4) & 63)]); \
    int lane_v; asm volatile("v_mbcnt_lo_u32_b32 %0, -1, 0\n\tv_mbcnt_hi_u32_b32 %0, -1, %0" : "=v"(lane_v)); const int lane = lane_v; const int wave = wave0; const int tid = wave0 * 64 + lane; \
    size_t zoff = 0; asm volatile("" : "+s"(zoff)); unsigned char* ws = p.ws + zoff; float* out = p.out + zoff; \
    unsigned* ctl = (unsigned*)(ws + WS_CTL); (void)ctl; (void)lane; (void)wave; (void)out; \
    const float* x_in = p.in[0]; const float* c_in = p.in[1]; const float* ctx_in = p.in[2]; const float* cctx_in = p.in[3]; const float* w_mod = p.in[4]; const float* b_mod = p.in[5]; \
    (void)x_in; (void)c_in; (void)ctx_in; (void)cctx_in; (void)w_mod; (void)b_mod; \
    float* MOD = (float*)(ws + WS_MOD); float* ROPE = (float*)(ws + WS_ROPE); (void)MOD; (void)ROPE; \
    bf16* WAT = (bf16*)(ws + WS_SMALLW); bf16* WXT = WAT + (size_t)DEPTH * 2 * 6 * 4096; bf16* WSB = WXT + (size_t)DEPTH * 2 * 6 * 4096; float* WSUM = (float*)(WSB + (size_t)DEPTH * 4 * 16384); (void)WAT; (void)WXT; (void)WSB; (void)WSUM; \
    uint4* TOKINFO = (uint4*)(ws + WS_TOKINFO); int2* TOKSLOT = (int2*)(ws + WS_TOKSLOT); int* SLOTTOK = (int*)(ws + WS_SLOTTOK); (void)TOKINFO; (void)TOKSLOT; (void)SLOTTOK; \
    bf16* XCTX = (bf16*)(ws + WS_XCTX); bf16* XLAT = (bf16*)(ws + WS_XL); (void)XCTX; (void)XLAT; \
    float* SAB = (float*)(ws + WS_ROPE + 512 * 1024); float* SASLOT = (float*)(ws + WS_TOKINFO + 1280 * 1024); float* SWIN = (float*)(ws + WS_TOKSLOT + 640 * 1024); float* SW13 = SWIN + 4096; (void)SAB; (void)SASLOT; (void)SWIN; (void)SW13; \
    bf16* WIN_T = (bf16*)(ws + WS_W + W_WIN); bf16* WOUT_T = (bf16*)(ws + WS_W + W_WOUT); bf16* WFFN = (bf16*)(ws + WS_W + W_FFN); (void)WIN_T; (void)WOUT_T; (void)WFFN; \
    bf16* ABUF = (bf16*)(ws + WS_A); bf16* RBUF = (bf16*)(ws + WS_R); bf16* BBUF = (bf16*)(ws + WS_B); bf16* YBUF = (bf16*)(ws + WS_Y); (void)ABUF; (void)RBUF; (void)BBUF; (void)YBUF; \
    bf16* SBUF = (bf16*)(ws + WS_Y + Y_SBUF); bf16* TLRU = (bf16*)(ws + WS_Y + Y_TLRU); (void)SBUF; (void)TLRU; \
    bf16* YSLOT = (bf16*)(ws + MOE_YSLOT); bf16* HIDS = (bf16*)(ws + MOE_HID); (void)YSLOT; (void)HIDS; \
    const float* modl = MOD + (size_t)l * 33 * 6144; (void)modl;

#define CONV_NI8(LA, HAS_IN) (((HAS_IN) ? 88 : 0) + ((((LA) & 1) != 0) ? NE : 1) * 176)
#define CONV_NTQ(LA) ((512 + ((((LA) & 1) != 0) ? NE : 1) * 1408) / 4)
#define CONVERT_I8(IT, LA, HAS_IN) do { \
            LAS float* scr = (LAS float*)(lds + wave * 16384); LAS float* mxs_ = (LAS float*)(lds + 8 * 16384); \
            const bool moe_ = (((LA) & 1) != 0); const int jf_ = (LA) >> 1; \
            int r = (IT); const int nin = (HAS_IN) ? 88 : 0; \
            if (r < nin) { conv_i8_item_wg(p.in[10] + (size_t)((LA) + 1) * D * INW, INW, (signed char*)WIN_T, SWIN, 32 * r, 32 * r, scr, mxs_, wave, lane); } \
            else { r -= nin; const int e = r / 176, rr = r % 176, is3 = rr >= 88 ? 1 : 0, n0 = 32 * (rr % 88); \
                const float* wsrc = is3 ? (moe_ ? p.in[29] + ((size_t)jf_ * NE + e) * D * DFF : p.in[25] + (size_t)jf_ * D * DFF) : (moe_ ? p.in[28] + ((size_t)jf_ * NE + e) * D * DFF : p.in[24] + (size_t)jf_ * D * DFF); \
                unsigned char* w13t = (unsigned char*)WFFN + (moe_ ? (size_t)e * W13_BYTES : 0); \
                conv_i8_item_wg(wsrc, DFF, (signed char*)w13t, SW13 + (size_t)(moe_ ? e : 0) * 2 * DFF, n0, 256 * (n0 >> 7) + 128 * is3 + (n0 & 127), scr, mxs_, wave, lane); } \
        } while (0)
#define CONVERT_TQ(GQ, LA) do { \
            LAS float* scr = (LAS float*)(lds + wave * 16384); \
            const bool moe_ = (((LA) & 1) != 0); const int jf_ = (LA) >> 1; \
            int r = 4 * (GQ); \
            if (r < 512) { transpose_quad<true>(p.in[11] + (size_t)(LA) * D * D, D, WOUT_T, D, 64 * (r / 32), 32 * (r % 32), 32 * (r % 32), WSCO, scr, lane); } \
            else { r -= 512; const int e = r / 1408, rr = r % 1408; \
                const float* w2 = moe_ ? p.in[30] + ((size_t)jf_ * NE + e) * DFF * D : p.in[26] + (size_t)jf_ * DFF * D; \
                unsigned char* w2t = (unsigned char*)WFFN + (moe_ ? (size_t)NE * W13_BYTES + (size_t)e * W2_BYTES : W13_BYTES); \
                transpose_quad<true>(w2, D, w2t, DFF, 64 * (rr / 32), 32 * (rr % 32), 32 * (rr % 32), WSC2, scr, lane); } \
        } while (0)
#if MK_PER_PHASE
#define IN(k) (p.ph_lo <= (k) && (k) < p.ph_hi)
#define PH_HI p.ph_hi
#define L_LO p.l_lo
#define L_HI p.l_hi
#else
#define IN(k) (true)
#define PH_HI NPH
#define L_LO 0
#define L_HI DEPTH
#endif
#define BARRIER_NOW() do { XcdBarrier b_; b_.bar = (unsigned*)(p.ws + WS_CTL) + CW_BAR + (size_t)p.bar_region * XCD_BAR_WORDS; b_.x = xb_xcc_id(); b_.st = MISC; xcd_barrier(b_, fresh_t0(wave0)); } while (0)
#define SEAM(l, k) do { if (((k) + 1 < PH_HI) || ((l) + 1 < L_HI)) { XcdBarrier b_; b_.bar = (unsigned*)(p.ws + WS_CTL) + CW_BAR + (size_t)p.bar_region * XCD_BAR_WORDS; b_.x = xb_xcc_id(); b_.st = MISC; xcd_barrier(b_, fresh_t0(wave0)); } } while (0)

    for (int l = L_LO; l < L_HI; ++l) {
        const bool want_ctx = l < DEPTH - 1;
        const bool moe = (l & 1) != 0; const int jf = l >> 1;
        if (IN(0) && l == 0) {
            PHASE_BEGIN
            const int gw = bid * NWAVES + wave, NGW = G * NWAVES;
            for (int rep = 0; rep < NREP_P0; ++rep) {
            if (l == 0) {
                {
                LAS bf16* Sb = (LAS bf16*)lds; LAS float* red = (LAS float*)(lds + 99328);
#pragma unroll
                for (int q = 0; q < 17; ++q) { const int o = tid + q * NTHR; if (o >= 33 * 256) break; const int r = o >> 8, k = (o & 255) * 4;
                    const f32x4 v = (r < 32) ? *(const f32x4*)(c_in + r * D + k) : *(const f32x4*)(cctx_in + k);
                    *(LAS u32x2*)(Sb + r * 1032 + k) = (u32x2){pk2(silu_f(v[0]), silu_f(v[1])), pk2(silu_f(v[2]), silu_f(v[3]))}; }
                for (int o = tid; o < 15 * 256; o += NTHR) { const int r = 33 + (o >> 8), k = (o & 255) * 4; *(LAS u32x2*)(Sb + r * 1032 + k) = (u32x2){0u, 0u}; }
                __syncthreads();
                const int ct = wave & 1, kq = wave >> 1, fr0 = lane & 15, fg0 = lane >> 4;
                for (int it = bid; it < DEPTH * 192; it += G) {
                    const int ll = it / 192, cb = it % 192;
                    const float* wp = w_mod + (size_t)ll * D * 6144 + cb * 32 + ct * 16 + fr0 + (size_t)(kq * 256 + fg0 * 8) * 6144;
                    float wv[64];
#pragma unroll
                    for (int ks = 0; ks < 8; ++ks)
#pragma unroll
                        for (int j = 0; j < 8; ++j) wv[ks * 8 + j] = wp[(size_t)(ks * 32 + j) * 6144];
                    f32x4 acc3[3] = {(f32x4){0.f, 0.f, 0.f, 0.f}, (f32x4){0.f, 0.f, 0.f, 0.f}, (f32x4){0.f, 0.f, 0.f, 0.f}};
#pragma unroll
                    for (int ks = 0; ks < 8; ++ks) {
                        const bf16x8 bfrag = __builtin_bit_cast(bf16x8, ((u32x4){pk2(wv[ks * 8 + 0], wv[ks * 8 + 1]), pk2(wv[ks * 8 + 2], wv[ks * 8 + 3]), pk2(wv[ks * 8 + 4], wv[ks * 8 + 5]), pk2(wv[ks * 8 + 6], wv[ks * 8 + 7])}));
#pragma unroll
                        for (int mt = 0; mt < 3; ++mt) acc3[mt] = mfma16(ld16l(Sb + (mt * 16 + fr0) * 1032 + kq * 256 + ks * 32 + fg0 * 8), bfrag, acc3[mt]); }
#pragma unroll
                    for (int mt = 0; mt < 3; ++mt)
#pragma unroll
                        for (int j = 0; j < 4; ++j) red[(wave * 12 + mt * 4 + j) * 64 + lane] = acc3[mt][j];
                    __syncthreads();
                    if (wave < 2) {
                        const int cc = cb * 32 + wave * 16 + fr0; const float bm = b_mod[(size_t)ll * 6144 + cc];
#pragma unroll
                        for (int mt = 0; mt < 3; ++mt)
#pragma unroll
                            for (int j = 0; j < 4; ++j) { const int r = mt * 16 + fg0 * 4 + j; float sm = 0.f;
#pragma unroll
                                for (int q = 0; q < 4; ++q) sm += red[((q * 2 + wave) * 12 + mt * 4 + j) * 64 + lane];
                                if (r < 33) MOD[((size_t)ll * 33 + r) * 6144 + cc] = sm + bm; } }
                    __syncthreads();
                }
                }
                for (int idx = bid * NTHR + tid; idx < SEQ * 32; idx += G * NTHR) { const int pos = idx >> 5, i = idx & 31;
                    const float fq = expf(-(float)(i & 15) * (4.605170186f / 16.0f)); const float ang = (float)((i < 16) ? (pos >> 6) : (pos & 63)) * fq;
                    ROPE[(size_t)idx * 2] = __cosf(ang); ROPE[(size_t)idx * 2 + 1] = __sinf(ang); }
                for (int idx = bid * NTHR + tid; idx < DEPTH * 2 * 6 * 4096; idx += G * NTHR) { const int blk = idx >> 12, j = (idx >> 6) & 63, i = idx & 63;
                    const float a = p.in[14][(size_t)blk * 4096 + i * 64 + j], xx = p.in[16][(size_t)blk * 4096 + i * 64 + j];
                    WAT[idx] = (bf16)(pk2(a, 0.f) & 0xffffu); WXT[idx] = (bf16)(pk2(xx, 0.f) & 0xffffu); }
                for (int idx = bid * NTHR + tid; idx < DEPTH * 4 * 16384; idx += G * NTHR) WSB[idx] = (bf16)(pk2(p.in[22][idx], 0.f) & 0xffffu);
                for (int idx = gw; idx < DEPTH * 4 * 128; idx += NGW) {
                    const float sm = wave_sum(bf_lo(pk2(p.in[22][(size_t)idx * 128 + lane], 0.f)) + bf_lo(pk2(p.in[22][(size_t)idx * 128 + 64 + lane], 0.f)));
                    if (lane == 0) WSUM[idx] = sm; }
            }
            { LAS float* scr0 = (LAS float*)(lds + wave * 16384);
              for (int it = bid; it < 88; it += G) conv_i8_item_wg(p.in[10], INW, (signed char*)WIN_T, SWIN, 32 * it, 32 * it, scr0, (LAS float*)(lds + 8 * 16384), wave, lane); }
            __syncthreads();
            }
            SEAM(l, 0);
        }
        if (IN(1) && l == 0) {
            PHASE_BEGIN
            for (int rep = 0; rep < NREP_N0; ++rep) row_phase<0, false, true, true, false>(SAB, ctx_in, x_in, nullptr, nullptr, nullptr, nullptr, nullptr, nullptr, nullptr, p.in[6], modl, 0, 0, 1024,
                                      ABUF, nullptr, nullptr, nullptr, nullptr, 0, MT, G, bid, wave, lane, tid);
            SEAM(l, 1);
        }
        if (IN(2)) {
            PHASE_BEGIN
            pg8::Gemm g{ABUF, WIN_T, MT, INW, D, 0, nullptr}; pg8::StaticOrder S; S.init(MT, INW, G, bid);
            pg8::EpiInProj E{RBUF, INW, ROPE, SAB, SWIN};
            for (int rep = 0; rep < NREP_IN; ++rep) { int lane3; asm volatile("v_mbcnt_lo_u32_b32 %0, -1, 0\n\tv_mbcnt_hi_u32_b32 %0, -1, %0" : "=v"(lane3)); const int tid = wave0 * 64 + lane3; pg8::gemm_phase<pg8::EpiInProj, pg8::StaticOrder, true, false, 2>(lds, g, S, E, tid); if (rep + 1 < NREP_IN) BARRIER_NOW(); }
            SEAM(l, 2);
        }
        if (IN(3)) {
            PHASE_BEGIN
#define FRESH_TID(T) int T; { int l_; asm volatile("v_mbcnt_lo_u32_b32 %0, -1, 0\n\tv_mbcnt_hi_u32_b32 %0, -1, %0" : "=v"(l_)); T = wave0 * 64 + l_; }
            for (int rep = 0; rep < NREP_LRU; ++rep)
            for (;;) {
                FRESH_TID(tq);
                if (tq == 0) MISC[8] = __hip_atomic_fetch_add(ctl + CW_QUEUE + (rep * 16 + l * 4 + 0) * 64, 1u, __ATOMIC_RELAXED, __HIP_MEMORY_SCOPE_AGENT);
                __syncthreads(); const int id = (int)MISC[8]; __syncthreads();
                if (id >= NB * 6) break;
                lru_unit(lds, RBUF, BBUF, TLRU, WAT + (size_t)l * 2 * 6 * 4096, WXT + (size_t)l * 2 * 6 * 4096, p.in[15] + (size_t)l * 768, p.in[17] + (size_t)l * 768, p.in[18] + (size_t)l * 768,
                         p.in[12] + (size_t)l * 4 * 384, p.in[13] + (size_t)l * 384, id / 6, id % 6, want_ctx, tq);
            }
            { for (;;) {
                FRESH_TID(tq);
                if (tq == 0) MISC[8] = __hip_atomic_fetch_add(ctl + CW_QUEUE + (l * 4 + 3) * 64, 1u, __ATOMIC_RELAXED, __HIP_MEMORY_SCOPE_AGENT);
                __syncthreads(); const int id = (int)MISC[8]; __syncthreads();
                const int has_in = (l + 1 < DEPTH) ? 1 : 0; const int ni8 = CONV_NI8(l, has_in), ci8 = (ni8 + 7) >> 3, ntq = CONV_NTQ(l), nchunks = ci8 + ((ntq + 7) >> 3);
                if (id >= nchunks) break;
                if (id < ci8) { for (int k8 = 0; k8 < 8; ++k8) { const int it = id * 8 + k8; if (it < ni8) CONVERT_I8(it, l, has_in); } }
                else { const int gq = (id - ci8) * 8 + wave; if (gq < ntq) CONVERT_TQ(gq, l); }
              } }
            for (int rep = 0; rep < NREP_RP1; ++rep)
            for (;;) {
                FRESH_TID(tq);
                if (tq == 0) MISC[8] = __hip_atomic_fetch_add(ctl + CW_QUEUE + (rep * 16 + l * 4 + 1) * 64, 1u, __ATOMIC_RELAXED, __HIP_MEMORY_SCOPE_AGENT);
                __syncthreads(); const int id = (int)MISC[8]; __syncthreads();
                if (id >= NB * 6) break;
                const int hh = id % 6; const float tf = p.in[19][l * 12 + hh], tb = p.in[19][l * 12 + 6 + hh];
                const float lgf2 = -1.44269504f * ((tf < -15.f) ? -tf : log1pf(expf(-tf))), lgb2 = -1.44269504f * ((tb < -15.f) ? -tb : log1pf(expf(-tb)));
                retp1_unit(lds, RBUF, SBUF, id / 6, hh, lgf2, lgb2, want_ctx, tq);
            }
            for (int rep = 0; rep < NREP_GM; ++rep) {
            bf16x8 gwf[4][4]; float gwsv[4], gbsv[4];
            { FRESH_TID(tw); gmlp_load_w(WSB + (size_t)l * 4 * 16384, WSUM + (size_t)l * 512, p.in[23] + (size_t)l * 512, tw, gwf, gwsv, gbsv); }
            for (;;) {
                FRESH_TID(tq);
                if (tq == 0) MISC[8] = __hip_atomic_fetch_add(ctl + CW_QUEUE + (rep * 16 + l * 4 + 2) * 64, 1u, __ATOMIC_RELAXED, __HIP_MEMORY_SCOPE_AGENT);
                __syncthreads(); const int id = (int)MISC[8]; __syncthreads();
                if (id >= NB * 18) break;
                const int ck = id % 18;
                if (!want_ctx && ck < 2) continue;
                gmlp_unit(lds, RBUF, BBUF, p.in[20] + (size_t)l * 256, p.in[21] + (size_t)l * 256, id / 18, ck, tq, gwf, gwsv, gbsv);
            } }
#undef FRESH_TID
            SEAM(l, 3);
        }
        if (IN(4)) {
            PHASE_BEGIN
            for (int rep = 0; rep < NREP_MB; ++rep) retp2_phase(lds, RBUF, SBUF, BBUF, p.in[19] + l * 12, want_ctx, G, bid, tid);
            SEAM(l, 4);
        }
        const int m_lo = want_ctx ? 0 : MC; const int m_n = MT - m_lo;
        if (IN(5)) {
            PHASE_BEGIN
            pg8::Gemm g{(const unsigned char*)BBUF + (size_t)m_lo * D, WOUT_T, m_n, D, D, 0, nullptr}; pg8::StaticOrder S; S.init(m_n, D, G, bid);
            pg8::EpiBf16 E{YBUF + (size_t)m_lo * D, D, 1.0f / (CSC * WSCO)};
            for (int rep = 0; rep < NREP_OUT; ++rep) { int lane3; asm volatile("v_mbcnt_lo_u32_b32 %0, -1, 0\n\tv_mbcnt_hi_u32_b32 %0, -1, %0" : "=v"(lane3)); const int tid = wave0 * 64 + lane3; pg8::gemm_phase<pg8::EpiBf16, pg8::StaticOrder, true, false, 1>(lds, g, S, E, tid); if (rep + 1 < NREP_OUT) BARRIER_NOW(); }
            SEAM(l, 5);
        }
        if (IN(6)) {
            PHASE_BEGIN
            if (l == 0) {
                row_phase<1, false, true, true, false>(SAB, ctx_in, x_in, XCTX, XLAT, YBUF, nullptr, nullptr, nullptr, p.in[7] + (size_t)l * D, p.in[8] + (size_t)l * D, modl, 2048, 3072, 4096,
                                                       ABUF, nullptr, nullptr, nullptr, nullptr, m_lo, MT, G, bid, wave, lane, tid);
            } else if (moe) {
                row_phase<1, true, true, false, false>(SAB, XCTX, XLAT, XCTX, XLAT, YBUF, nullptr, nullptr, nullptr, p.in[7] + (size_t)l * D, p.in[8] + (size_t)l * D, modl, 2048, 3072, 4096,
                                                       ABUF, p.in[27] + (size_t)jf * D * NE, TOKINFO, (LAS unsigned*)(lds + MISC_OFF) + 16, ctl + CW_GCNT + jf * 64, m_lo, MT, G, bid, wave, lane, tid, lds);
            } else {
                row_phase<1, false, true, false, false>(SAB, XCTX, XLAT, XCTX, XLAT, YBUF, nullptr, nullptr, nullptr, p.in[7] + (size_t)l * D, p.in[8] + (size_t)l * D, modl, 2048, 3072, 4096,
                                                        ABUF, nullptr, nullptr, nullptr, nullptr, m_lo, MT, G, bid, wave, lane, tid);
            }
            SEAM(l, 6);
        }
        if (IN(7)) {
            PHASE_BEGIN
            if (!moe) {
                pg8::Gemm g{(const unsigned char*)ABUF + (size_t)m_lo * D, WFFN, m_n, 2 * DFF, D, 0, nullptr}; pg8::StaticOrder S; S.init(m_n, 2 * DFF, G, bid);
                pg8::EpiSwiGLU E{(unsigned char*)RBUF + (size_t)m_lo * DFF, DFF, SAB + m_lo, SW13, HSC};
                for (int rep = 0; rep < NREP_DG1; ++rep) { int lane3; asm volatile("v_mbcnt_lo_u32_b32 %0, -1, 0\n\tv_mbcnt_hi_u32_b32 %0, -1, %0" : "=v"(lane3)); const int tid = wave0 * 64 + lane3; pg8::gemm_phase<pg8::EpiSwiGLU, pg8::StaticOrder, true, false, 2>(lds, g, S, E, tid); if (rep + 1 < NREP_DG1) BARRIER_NOW(); }
            } else {
                LAS unsigned* T = (LAS unsigned*)(lds + MISC_OFF) + 32;
                if (tid == 0) { unsigned s = 0; for (int e = 0; e < 8; ++e) { T[e] = s; const unsigned c = __hip_atomic_load(ctl + CW_GCNT + jf * 64 + e, __ATOMIC_RELAXED, __HIP_MEMORY_SCOPE_AGENT); s += (c + 255u) & ~255u; } T[8] = s; }
                if (tid < 8) T[16 + tid] = 0u;
                __syncthreads();
                const int per = m_n / G; const int mb = m_lo + bid * per;
                unsigned e1 = 0, e2 = 0, p1 = 0, p2 = 0;
                if (tid < per) { const uint4 ti = TOKINFO[mb + tid]; e1 = ti.x; e2 = ti.y;
                    p1 = __hip_atomic_fetch_add(T + 16 + e1, 1u, __ATOMIC_RELAXED, __HIP_MEMORY_SCOPE_WORKGROUP); p2 = __hip_atomic_fetch_add(T + 16 + e2, 1u, __ATOMIC_RELAXED, __HIP_MEMORY_SCOPE_WORKGROUP); }
                __syncthreads();
                if (tid < 8) T[24 + tid] = __hip_atomic_fetch_add(ctl + CW_GPOS + jf * 64 + tid, T[16 + tid], __ATOMIC_RELAXED, __HIP_MEMORY_SCOPE_AGENT);
                __syncthreads();
                if (tid < per) { const int s1 = (int)(T[e1] + T[24 + e1] + p1), s2 = (int)(T[e2] + T[24 + e2] + p2);
                    SLOTTOK[s1] = mb + tid; SLOTTOK[s2] = mb + tid; TOKSLOT[mb + tid] = make_int2(s1, s2); const float sv = SAB[mb + tid]; SASLOT[s1] = sv; SASLOT[s2] = sv; }
                for (int idx = bid * NTHR + tid; idx < 8 * 256; idx += G * NTHR) { const int e = idx >> 8, k = idx & 255;
                    const unsigned c = __hip_atomic_load(ctl + CW_GCNT + jf * 64 + e, __ATOMIC_RELAXED, __HIP_MEMORY_SCOPE_AGENT); const unsigned s = T[e] + c + k;
                    if (s < T[e + 1]) { SLOTTOK[s] = m_lo; SASLOT[s] = 0.f; } }
                __syncthreads();
            }
            SEAM(l, 7);
        }
        if (IN(8)) {
            PHASE_BEGIN
            if (!moe) {
                pg8::Gemm g{(const unsigned char*)RBUF + (size_t)m_lo * DFF, (const unsigned char*)WFFN + W13_BYTES, m_n, D, DFF, 0, nullptr}; pg8::StaticOrder S; S.init(m_n, D, G, bid);
                pg8::EpiBf16 E{YBUF + (size_t)m_lo * D, D, 1.0f / (WSC2 * HSC)};
                for (int rep = 0; rep < NREP_DG2; ++rep) { int lane3; asm volatile("v_mbcnt_lo_u32_b32 %0, -1, 0\n\tv_mbcnt_hi_u32_b32 %0, -1, %0" : "=v"(lane3)); const int tid = wave0 * 64 + lane3; pg8::gemm_phase<pg8::EpiBf16, pg8::StaticOrder, true, false, 1>(lds, g, S, E, tid); if (rep + 1 < NREP_DG2) BARRIER_NOW(); }
            } else {
                LAS int* SEGT = (LAS int*)(lds + MISC_OFF) + 48;
                if (tid == 0) { unsigned s = 0; for (int e = 0; e < 8; ++e) { SEGT[e] = (int)(s >> 8); const unsigned c = __hip_atomic_load(ctl + CW_GCNT + jf * 64 + e, __ATOMIC_RELAXED, __HIP_MEMORY_SCOPE_AGENT); s += (c + 255u) & ~255u; } SEGT[8] = (int)(s >> 8); }
                __syncthreads();
                const int NT = __builtin_amdgcn_readfirstlane(SEGT[8]);
                const int slab = (NT <= p.slab_cap) ? NT : ((NT + 1) / 2 < SLAB_TILES ? (NT + 1) / 2 : SLAB_TILES);
                for (int t0 = 0; t0 < NT; t0 += slab) {
                    const int nT = (NT - t0) < slab ? (NT - t0) : slab;
                    { int lane2; asm volatile("v_mbcnt_lo_u32_b32 %0, -1, 0\n\tv_mbcnt_hi_u32_b32 %0, -1, %0" : "=v"(lane2)); const int tid = wave0 * 64 + lane2;
                      pg8::MoeOrder S; S.nM = nT; S.nN = 2 * DFF / 256; S.nwg = nT * S.nN; S.G = G; S.c = bid; S.t0 = t0;
                        S.segt = SEGT;
                        pg8::Gemm g{ABUF, WFFN, nT * 256, 2 * DFF, D, W13_BYTES, SLOTTOK};
                        pg8::EpiSwiGLU E{(unsigned char*)HIDS - (size_t)t0 * 256 * DFF, DFF, SASLOT, SW13, HSC};
                        for (int rep = 0; rep < NREP_MG1; ++rep) { int lane3; asm volatile("v_mbcnt_lo_u32_b32 %0, -1, 0\n\tv_mbcnt_hi_u32_b32 %0, -1, %0" : "=v"(lane3)); const int tid = wave0 * 64 + lane3; pg8::gemm_phase<pg8::EpiSwiGLU, pg8::MoeOrder, true, true, 2>(lds, g, S, E, tid); if (rep + 1 < NREP_MG1) BARRIER_NOW(); } }
                    BARRIER_NOW();
                    { int lane2; asm volatile("v_mbcnt_lo_u32_b32 %0, -1, 0\n\tv_mbcnt_hi_u32_b32 %0, -1, %0" : "=v"(lane2)); const int tid = wave0 * 64 + lane2;
                      pg8::MoeOrder S; S.nM = nT; S.nN = D / 256; S.nwg = nT * S.nN; S.G = G; S.c = bid; S.t0 = t0;
                        S.segt = SEGT;
                        pg8::Gemm g{(const unsigned char*)HIDS - (size_t)t0 * 256 * DFF, (const unsigned char*)WFFN + (size_t)NE * W13_BYTES, nT * 256, D, DFF, W2_BYTES, nullptr};
                        pg8::EpiBf16 E{YSLOT, D, 1.0f / (WSC2 * HSC)};
                        for (int rep = 0; rep < NREP_MG2; ++rep) { int lane3; asm volatile("v_mbcnt_lo_u32_b32 %0, -1, 0\n\tv_mbcnt_hi_u32_b32 %0, -1, %0" : "=v"(lane3)); const int tid = wave0 * 64 + lane3; pg8::gemm_phase<pg8::EpiBf16, pg8::MoeOrder, true, false, 1>(lds, g, S, E, tid); if (rep + 1 < NREP_MG2) BARRIER_NOW(); } }
                    if (t0 + slab < NT) BARRIER_NOW();
                }
            }
            SEAM(l, 8);
        }
        if (IN(9)) {
            PHASE_BEGIN
            const float* gpre_n = p.in[6] + (size_t)(l + 1 < DEPTH ? l + 1 : l) * D; const float* modn = MOD + (size_t)(l + 1 < DEPTH ? l + 1 : l) * 33 * 6144;
            const int o_sh = (int)(modn - modl) + 0, o_sc = (int)(modn - modl) + 1024;
            if (l + 1 < DEPTH) {
                if (moe) row_phase<2, false, true, false, false>(SAB, XCTX, XLAT, XCTX, XLAT, nullptr, YSLOT, TOKINFO, TOKSLOT, p.in[9] + (size_t)l * D, gpre_n, modl, 5120, o_sh, o_sc,
                                                                 ABUF, nullptr, nullptr, nullptr, nullptr, m_lo, MT, G, bid, wave, lane, tid);
                else row_phase<1, false, true, false, false>(SAB, XCTX, XLAT, XCTX, XLAT, YBUF, nullptr, nullptr, nullptr, p.in[9] + (size_t)l * D, gpre_n, modl, 5120, o_sh, o_sc,
                                                             ABUF, nullptr, nullptr, nullptr, nullptr, m_lo, MT, G, bid, wave, lane, tid);
            } else {
                row_phase<2, false, false, false, true>(SAB, XCTX, XLAT, XCTX, out, nullptr, YSLOT, TOKINFO, TOKSLOT, p.in[9] + (size_t)l * D, gpre_n, modl, 5120, o_sh, o_sc,
                                                        ABUF, nullptr, nullptr, nullptr, nullptr, m_lo, MT, G, bid, wave, lane, tid);
            }
            SEAM(l, 9);
        }
    }
#undef IN
#undef SEAM
}

extern "C" void kernel_launch(void* const* d_in, const int* in_sizes, int n_in, void* d_out, int out_size, void* d_ws, size_t ws_size, hipStream_t stream) {
    static int grid = 0;
    if (grid == 0) {
        if (n_in != 31 || out_size != ML * D || ws_size < WS_END) { fprintf(stderr, "kernel_launch: unexpected problem (n_in %d, out %d, ws %zu, need %zu)\n", n_in, out_size, ws_size, (size_t)WS_END); grid = -1; return; }
        int dev = 0, cus = 0, per_cu = 0;
        if (hipGetDevice(&dev) != hipSuccess || hipDeviceGetAttribute(&cus, hipDeviceAttributeMultiprocessorCount, dev) != hipSuccess) { grid = -1; return; }
        if (hipFuncSetAttribute((const void*)fwd_kernel, hipFuncAttributeMaxDynamicSharedMemorySize, LDS_BYTES) != hipSuccess) { fprintf(stderr, "kernel_launch: hipFuncSetAttribute failed\n"); grid = -1; return; }
        if (hipOccupancyMaxActiveBlocksPerMultiprocessor(&per_cu, (const void*)fwd_kernel, NTHR, LDS_BYTES) != hipSuccess || per_cu < 1) fprintf(stderr, "kernel_launch: occupancy query says %d\n", per_cu);
        (void)hipGetLastError();
        grid = cus;
        if (grid != 256) { fprintf(stderr, "kernel_launch: %d CUs (built for 256)\n", grid); grid = -1; return; }
    }
    if (grid < 0) return;
    (void)hipMemsetAsync((char*)d_ws + WS_CTL, 0, CTL_BYTES, stream);
    Params a{};
    for (int i = 0; i < 31; ++i) a.in[i] = (const float*)d_in[i];
    a.out = (float*)d_out; a.ws = (unsigned char*)d_ws;
    { const size_t cap = (ws_size - MOE_HID) / ((size_t)256 * DFF); a.slab_cap = cap >= 584 ? 584 : SLAB_TILES; }
#if MK_PER_PHASE
    int region = 0;
    for (int l = 0; l < DEPTH; ++l)
        for (int ph = 0; ph < NPH; ++ph) {
            if (ph == 1 && l != 0) continue;
            a.l_lo = l; a.l_hi = l + 1; a.ph_lo = ph; a.ph_hi = ph + 1; a.bar_region = region++;
            hipLaunchKernelGGL(fwd_kernel, dim3(grid), dim3(NTHR), LDS_BYTES, stream, a);
        }
#else
    a.l_lo = 0; a.l_hi = DEPTH; a.ph_lo = 0; a.ph_hi = NPH; a.bar_region = 0;
    hipLaunchKernelGGL(fwd_kernel, dim3(grid), dim3(NTHR), LDS_BYTES, stream, a);
#endif
    const hipError_t le = hipPeekAtLastError();
    if (le != hipSuccess) fprintf(stderr, "kernel_launch: launch failed: %s\n", hipGetErrorName(le));
}
```
